# Optimizing an MI355X kernel written in HIP

```python
import math
import jax, jax.numpy as jnp
from jax import lax
import numpy as np

D_MODEL = 1024
BATCH = 2
SEQ = 8192
DEPTH = 1

ATT_HEADS = 8
ATT_KV_HEADS = 2
HEAD_DIM = 64
WINDOW = 128
BLOCK = 128
ROPE_THETA = 10000.0
CONV_CH = 512
CONV_WIDTH = 31
MEM_LEN = 256
MEM_HEADS = 4
MEM_HEAD_DIM = 128
N_BRANCHES = 3
N_GROUPS = 4
EXPERTS_PER_GROUP = 4
N_EXPERTS = N_GROUPS * EXPERTS_PER_GROUP
TOP_K_IN_GROUP = 2
EXPERT_FF = 512
EPS = 1e-6
LN_EPS = 1e-5
NEG_INF = -1e30

Q_WIDTH = ATT_HEADS * HEAD_DIM
KV_WIDTH = ATT_KV_HEADS * HEAD_DIM
GLU_WIDTH = 2 * CONV_CH
XQ_WIDTH = MEM_HEADS * MEM_HEAD_DIM
GATE_WIDTH = N_BRANCHES * D_MODEL
IN_WIDTH = Q_WIDTH + 2 * KV_WIDTH + GLU_WIDTH + XQ_WIDTH + GATE_WIDTH

kernel_name = "hybrid_swa_conformer_memxattn_hiermoe"


def rms_norm(x, g):
    xf = x.astype(jnp.float32)
    y = xf * lax.rsqrt(jnp.mean(xf * xf, axis=-1, keepdims=True) + EPS)
    return (y * g.astype(jnp.float32)).astype(x.dtype)


def layer_norm(x, g, b):
    xf = x.astype(jnp.float32)
    mu = jnp.mean(xf, axis=-1, keepdims=True)
    var = jnp.mean(jnp.square(xf - mu), axis=-1, keepdims=True)
    y = (xf - mu) * lax.rsqrt(var + LN_EPS)
    return (y * g.astype(jnp.float32) + b.astype(jnp.float32)).astype(x.dtype)


def rope_tables(positions):
    inv_freq = 1.0 / (ROPE_THETA ** (jnp.arange(0, HEAD_DIM, 2, dtype=jnp.float32) / HEAD_DIM))
    ang = positions.astype(jnp.float32)[..., None] * inv_freq
    return jnp.cos(ang), jnp.sin(ang)


def apply_rope(t, cos, sin):
    tf = t.astype(jnp.float32)
    t1, t2 = jnp.split(tf, 2, axis=-1)
    c = cos[:, :, None, :]
    s = sin[:, :, None, :]
    out = jnp.concatenate([t1 * c - t2 * s, t2 * c + t1 * s], axis=-1)
    return out.astype(t.dtype)


def split_columns(proj, widths):
    points = []
    acc = 0
    for w in widths[:-1]:
        acc += w
        points.append(acc)
    return jnp.split(proj, points, axis=-1)


def sliding_window_attention(q, k, v, sinks):
    B, S, Hq, Dh = q.shape
    G = Hq // ATT_KV_HEADS
    nb = S // BLOCK
    qb = q.reshape(B, nb, BLOCK, ATT_KV_HEADS, G, Dh)

    def band(t):
        tb = t.reshape(B, nb, BLOCK, ATT_KV_HEADS, Dh)
        prev = jnp.pad(tb, ((0, 0), (1, 0), (0, 0), (0, 0), (0, 0)))[:, :nb]
        return jnp.concatenate([prev, tb], axis=2)

    kb, vb = band(k), band(v)
    s = jnp.einsum('bnqhgd,bnkhd->bnhgqk', qb, kb).astype(jnp.float32) * (Dh ** -0.5)
    q_pos = jnp.arange(nb)[:, None] * BLOCK + jnp.arange(BLOCK)[None, :]
    k_pos = (jnp.arange(nb)[:, None] - 1) * BLOCK + jnp.arange(2 * BLOCK)[None, :]
    delta = q_pos[:, :, None] - k_pos[:, None, :]
    valid = (delta >= 0) & (delta < WINDOW) & (k_pos[:, None, :] >= 0)
    s = jnp.where(valid[None, :, None, None], s, NEG_INF)
    sink = jnp.broadcast_to(sinks.astype(jnp.float32).reshape(1, 1, ATT_KV_HEADS, G, 1, 1),
                            s.shape[:-1] + (1,))
    p = jax.nn.softmax(jnp.concatenate([s, sink], axis=-1), axis=-1)[..., :-1]
    o = jnp.einsum('bnhgqk,bnkhd->bnqhgd', p.astype(v.dtype), vb)
    return o.reshape(B, S, Hq * Dh)


def causal_depthwise_conv(u, w, b):
    y = lax.conv_general_dilated(
        u, w[:, None, :].astype(u.dtype), window_strides=(1,),
        padding=[(CONV_WIDTH - 1, 0)], dimension_numbers=('NWC', 'WIO', 'NWC'),
        feature_group_count=CONV_CH)
    return y + b.astype(u.dtype)


def memory_cross_attention(xq, mem_n, w_kv, g_xq, g_xk):
    B, S, _ = xq.shape
    M = mem_n.shape[1]
    mk, mv = jnp.split(mem_n @ w_kv, 2, axis=-1)
    mk = rms_norm(mk.reshape(B, M, MEM_HEADS, MEM_HEAD_DIM), g_xk)
    mv = mv.reshape(B, M, MEM_HEADS, MEM_HEAD_DIM)
    qh = rms_norm(xq.reshape(B, S, MEM_HEADS, MEM_HEAD_DIM), g_xq)
    s = jnp.einsum('bshd,bmhd->bhsm', qh, mk).astype(jnp.float32) * (MEM_HEAD_DIM ** -0.5)
    p = jax.nn.softmax(s, axis=-1)
    o = jnp.einsum('bhsm,bmhd->bshd', p.astype(mv.dtype), mv)
    return o.reshape(B, S, XQ_WIDTH)


def hierarchical_moe(h, w_group, b_group, w_router, b_router, w_gate, w_up, w_down):
    B, S, D = h.shape
    t = h.reshape(-1, D)
    T = t.shape[0]
    gl = (t @ w_group).astype(jnp.float32) + b_group.astype(jnp.float32)
    gp = jax.nn.softmax(gl, axis=-1)
    g_idx = jnp.argmax(gl, axis=-1)
    p_g = jnp.take_along_axis(gp, g_idx[:, None], axis=1)
    el = ((t @ w_router).astype(jnp.float32) + b_router.astype(jnp.float32)).reshape(
        T, N_GROUPS, EXPERTS_PER_GROUP)
    el = jnp.take_along_axis(el, g_idx[:, None, None], axis=1)[:, 0]
    top_v, top_i = lax.top_k(el, TOP_K_IN_GROUP)
    p_e = jax.nn.softmax(top_v, axis=-1)
    ids = g_idx[:, None] * EXPERTS_PER_GROUP + top_i
    combine = jnp.sum(jax.nn.one_hot(ids, N_EXPERTS, dtype=jnp.float32) * (p_g * p_e)[..., None],
                      axis=1).astype(h.dtype)
    y = jnp.zeros_like(t)
    for e in range(N_EXPERTS):
        hid = jax.nn.silu(t @ w_gate[e]) * (t @ w_up[e])
        y = y + combine[:, e:e + 1] * (hid @ w_down[e])
    return y.reshape(B, S, D)


def setup_inputs(seed: int = 0) -> dict:
    key = jax.random.key(seed)
    ks = iter(jax.random.split(key, 40))
    f32 = jnp.float32
    L = DEPTH

    def nrm(shape, scale):
        return jax.random.normal(next(ks), shape, f32) * scale

    def gain(shape):
        return 1.0 + 0.05 * jax.random.normal(next(ks), shape, f32)

    x = jax.random.normal(next(ks), (BATCH, SEQ, D_MODEL), f32)
    mem = jax.random.normal(next(ks), (BATCH, MEM_LEN, D_MODEL), f32)
    positions = jnp.broadcast_to(jnp.arange(SEQ, dtype=jnp.int32), (BATCH, SEQ))
    return {
        "x": x,
        "mem": mem,
        "positions": positions,
        "g_norm1": gain((L, D_MODEL)),
        "w_in": nrm((L, D_MODEL, IN_WIDTH), D_MODEL ** -0.5),
        "g_q": gain((L, HEAD_DIM)),
        "g_k": gain((L, HEAD_DIM)),
        "sinks": nrm((L, ATT_HEADS), 0.5),
        "w_o_attn": nrm((L, Q_WIDTH, D_MODEL), Q_WIDTH ** -0.5),
        "w_conv_dw": nrm((L, CONV_WIDTH, CONV_CH), CONV_WIDTH ** -0.5),
        "b_conv_dw": nrm((L, CONV_CH), 0.02),
        "g_conv_ln": gain((L, CONV_CH)),
        "b_conv_ln": nrm((L, CONV_CH), 0.02),
        "w_conv_out": nrm((L, CONV_CH, D_MODEL), CONV_CH ** -0.5),
        "g_mem": gain((L, D_MODEL)),
        "w_kv_mem": nrm((L, D_MODEL, 2 * XQ_WIDTH), D_MODEL ** -0.5),
        "g_xq": gain((L, MEM_HEAD_DIM)),
        "g_xk": gain((L, MEM_HEAD_DIM)),
        "w_o_mem": nrm((L, XQ_WIDTH, D_MODEL), XQ_WIDTH ** -0.5),
        "w_out": nrm((L, D_MODEL, D_MODEL), D_MODEL ** -0.5),
        "g_norm2": gain((L, D_MODEL)),
        "w_group": nrm((L, D_MODEL, N_GROUPS), D_MODEL ** -0.5),
        "b_group": nrm((L, N_GROUPS), 0.01),
        "w_router": nrm((L, D_MODEL, N_EXPERTS), D_MODEL ** -0.5),
        "b_router": nrm((L, N_EXPERTS), 0.01),
        "w_gate": nrm((L, N_EXPERTS, D_MODEL, EXPERT_FF), D_MODEL ** -0.5),
        "w_up": nrm((L, N_EXPERTS, D_MODEL, EXPERT_FF), D_MODEL ** -0.5),
        "w_down": nrm((L, N_EXPERTS, EXPERT_FF, D_MODEL), EXPERT_FF ** -0.5),
    }


def reference(x, mem, positions, g_norm1, w_in, g_q, g_k, sinks, w_o_attn, w_conv_dw, b_conv_dw,
              g_conv_ln, b_conv_ln, w_conv_out, g_mem, w_kv_mem, g_xq, g_xk, w_o_mem, w_out,
              g_norm2, w_group, b_group, w_router, b_router, w_gate, w_up, w_down):
    B, S, D = x.shape
    cos, sin = rope_tables(positions)
    for l in range(DEPTH):
        h = rms_norm(x, g_norm1[l])
        q, k, v, glu_in, xq, gate_logits = split_columns(
            h @ w_in[l], (Q_WIDTH, KV_WIDTH, KV_WIDTH, GLU_WIDTH, XQ_WIDTH, GATE_WIDTH))

        q = apply_rope(rms_norm(q.reshape(B, S, ATT_HEADS, HEAD_DIM), g_q[l]), cos, sin)
        k = apply_rope(rms_norm(k.reshape(B, S, ATT_KV_HEADS, HEAD_DIM), g_k[l]), cos, sin)
        v = v.reshape(B, S, ATT_KV_HEADS, HEAD_DIM)
        y_attn = sliding_window_attention(q, k, v, sinks[l]) @ w_o_attn[l]

        ga, gb = jnp.split(glu_in, 2, axis=-1)
        u = ga * jax.nn.sigmoid(gb)
        u = causal_depthwise_conv(u, w_conv_dw[l], b_conv_dw[l])
        u = jax.nn.silu(layer_norm(u, g_conv_ln[l], b_conv_ln[l]))
        y_conv = u @ w_conv_out[l]

        mem_n = rms_norm(mem, g_mem[l])
        y_mem = memory_cross_attention(xq, mem_n, w_kv_mem[l], g_xq[l], g_xk[l]) @ w_o_mem[l]

        gates = jax.nn.sigmoid(gate_logits.astype(jnp.float32)).astype(x.dtype).reshape(
            B, S, N_BRANCHES, D)
        merged = gates[:, :, 0] * y_attn + gates[:, :, 1] * y_conv + gates[:, :, 2] * y_mem
        x = x + merged @ w_out[l]

        h2 = rms_norm(x, g_norm2[l])
        x = x + hierarchical_moe(h2, w_group[l], b_group[l], w_router[l], b_router[l],
                                 w_gate[l], w_up[l], w_down[l])
    return x
```

```cpp
#include <hip/hip_runtime.h>
#include <cstdint>
#include <cstdio>

typedef unsigned short bf16;
__device__ __forceinline__ float bf2f(bf16 v) { return __uint_as_float((unsigned)v << 16); }
__device__ __forceinline__ bf16 f2bf(float f) { unsigned u = __float_as_uint(f); return (bf16)((u + 0x7fffu + ((u >> 16) & 1u)) >> 16); }
__device__ __forceinline__ float wave_sum(float v) {
#pragma unroll
    for (int o = 1; o < 64; o <<= 1) v += __shfl_xor(v, o);
    return v;
}
__device__ __forceinline__ float wave_max(float v) {
#pragma unroll
    for (int o = 1; o < 64; o <<= 1) v = fmaxf(v, __shfl_xor(v, o));
    return v;
}
__device__ __forceinline__ float sigmoidf_(float x) { return 1.f / (1.f + __expf(-x)); }

constexpr int T = 16384, SEQ = 8192, D = 1024, INW = 5376;
constexpr size_t MiB = 1u << 20;

__global__ void __launch_bounds__(256) n_rmsnorm(const float* x, const float* g, bf16* out, int rows, int pad) {
    const int row = (blockIdx.x * 256 + threadIdx.x) >> 6, lane = threadIdx.x & 63;
    if (row >= rows) return;
    const float4* xr = (const float4*)(x + (size_t)row * 1024);
    float4 v[4]; float s = 0.f;
#pragma unroll
    for (int j = 0; j < 4; ++j) { v[j] = xr[lane + 64 * j]; s += v[j].x * v[j].x + v[j].y * v[j].y + v[j].z * v[j].z + v[j].w * v[j].w; }
    s = wave_sum(s);
    const float r = rsqrtf(s * (1.f / 1024.f) + 1e-6f);
#pragma unroll
    for (int j = 0; j < 4; ++j) {
        const int c = 4 * (lane + 64 * j); const float4 gg = *(const float4*)(g + c);
        bf16* o = out + (size_t)row * 1024 + c;
        o[0] = f2bf(v[j].x * r * gg.x); o[1] = f2bf(v[j].y * r * gg.y); o[2] = f2bf(v[j].z * r * gg.z); o[3] = f2bf(v[j].w * r * gg.w);
    }
}

template <bool DUAL, class Epi>
__global__ void __launch_bounds__(256) n_gemm(const bf16* A, const float* B0, const float* B1, int lda, int ldb, int K, int pad, Epi epi) {
    __shared__ float As[16][65];
    __shared__ float Bs0[16][64];
    __shared__ float Bs1[16][64];
    const int tx = threadIdx.x & 15, ty = threadIdx.x >> 4;
    const int row0 = blockIdx.y * 64, col0 = blockIdx.x * 64;
    float acc0[4][4], acc1[4][4];
#pragma unroll
    for (int i = 0; i < 4; ++i)
#pragma unroll
        for (int j = 0; j < 4; ++j) { acc0[i][j] = 0.f; acc1[i][j] = 0.f; }
    for (int k0 = 0; k0 < K; k0 += 16) {
        { const int r = threadIdx.x >> 2, kk = (threadIdx.x & 3) * 4; const bf16* p = A + (size_t)(row0 + r) * lda + k0 + kk;
#pragma unroll
          for (int i = 0; i < 4; ++i) As[kk + i][r] = bf2f(p[i]); }
        { const int kk = threadIdx.x >> 4, c = (threadIdx.x & 15) * 4;
          const float4 b = *(const float4*)(B0 + (size_t)(k0 + kk) * ldb + col0 + c);
          Bs0[kk][c] = b.x; Bs0[kk][c + 1] = b.y; Bs0[kk][c + 2] = b.z; Bs0[kk][c + 3] = b.w;
          if (DUAL) { const float4 b1 = *(const float4*)(B1 + (size_t)(k0 + kk) * ldb + col0 + c);
              Bs1[kk][c] = b1.x; Bs1[kk][c + 1] = b1.y; Bs1[kk][c + 2] = b1.z; Bs1[kk][c + 3] = b1.w; } }
        __syncthreads();
#pragma unroll
        for (int kk = 0; kk < 16; ++kk) {
            float a[4], b[4], c1[4];
#pragma unroll
            for (int i = 0; i < 4; ++i) { a[i] = As[kk][ty * 4 + i]; b[i] = Bs0[kk][tx * 4 + i]; c1[i] = DUAL ? Bs1[kk][tx * 4 + i] : 0.f; }
#pragma unroll
            for (int i = 0; i < 4; ++i)
#pragma unroll
                for (int j = 0; j < 4; ++j) { acc0[i][j] += a[i] * b[j]; if (DUAL) acc1[i][j] += a[i] * c1[j]; }
        }
        __syncthreads();
    }
#pragma unroll
    for (int i = 0; i < 4; ++i)
#pragma unroll
        for (int j = 0; j < 4; ++j) epi(row0 + ty * 4 + i, col0 + tx * 4 + j, acc0[i][j], acc1[i][j]);
}
struct EpiBf { bf16* out; int ldo; int pad; __device__ void operator()(int r, int c, float a, float) const { out[(size_t)r * ldo + c] = f2bf(a); } };
struct EpiF32 { float* out; int ldo; int pad; __device__ void operator()(int r, int c, float a, float) const { out[(size_t)r * ldo + c] = a; } };
struct EpiGlu { bf16* out; int ldo; int pad; __device__ void operator()(int r, int c, float a, float b) const { out[(size_t)r * ldo + c] = f2bf(a * sigmoidf_(b)); } };
struct EpiSig { bf16* out; int ldo; int pad; __device__ void operator()(int r, int c, float a, float) const { out[(size_t)r * ldo + c] = f2bf(sigmoidf_(a)); } };
struct EpiGate { const bf16* gates; float* merged; bf16* mbf; int mode; int pad;
    __device__ void operator()(int r, int c, float a, float) const {
        const float g = bf2f(gates[(size_t)r * 3072 + c]); float v = g * a; const size_t o = (size_t)r * 1024 + c;
        if (mode > 0) v += merged[o];
        if (mode < 2) merged[o] = v; else mbf[o] = f2bf(v);
    } };
struct EpiRes { const float* x; float* out; __device__ void operator()(int r, int c, float a, float) const { const size_t o = (size_t)r * 1024 + c; out[o] = x[o] + a; } };

__global__ void n_rope_table(const int* positions, float2* cs) {
    const int idx = blockIdx.x * 256 + threadIdx.x; if (idx >= T * 32) return;
    const int t = idx >> 5, i = idx & 31;
    const float inv = 1.0f / powf(10000.f, (float)(2 * i) / 64.f);
    const float ang = (float)positions[t] * inv;
    double s, c; sincos((double)ang, &s, &c);
    cs[idx] = make_float2((float)c, (float)s);
}
__global__ void __launch_bounds__(256) n_qkprep(bf16* q, const float* g, const float2* cs, int nheads, int pad) {
    const int w = (blockIdx.x * 256 + threadIdx.x) >> 6, lane = threadIdx.x & 63;
    if (w >= T * nheads) return;
    const int t = w / nheads, h = w % nheads;
    bf16* p = q + (size_t)t * (nheads * 64) + h * 64;
    const float v = bf2f(p[lane]);
    const float ss = wave_sum(v * v);
    const float y = v * rsqrtf(ss * (1.f / 64.f) + 1e-6f) * g[lane];
    const float other = __shfl_xor(y, 32);
    const float2 c = cs[(size_t)t * 32 + (lane & 31)];
    const float o = (lane < 32) ? (y * c.x - other * c.y) : (y * c.x + other * c.y);
    p[lane] = f2bf(o);
}
__global__ void __launch_bounds__(256) n_swa(const bf16* q, const bf16* k, const bf16* v, const float* sinks, bf16* out, int ldo, int pad) {
    const int w = (blockIdx.x * 256 + threadIdx.x) >> 6, lane = threadIdx.x & 63;
    if (w >= T * 8) return;
    const int t = w >> 3, h = w & 7, hk = h >> 2, s = t & (SEQ - 1);
    const bf16* qp = q + (size_t)t * 512 + h * 64;
    float sc[2];
#pragma unroll
    for (int j = 0; j < 2; ++j) {
        const int delta = lane + 64 * j, kp = s - delta;
        float a = -1e30f;
        if (kp >= 0) { const bf16* kr = k + (size_t)(t - delta) * 128 + hk * 64; a = 0.f;
            for (int d = 0; d < 64; ++d) a += bf2f(qp[d]) * bf2f(kr[d]);
            a *= 0.125f; }
        sc[j] = a;
    }
    const float sink = sinks[h];
    const float m = fmaxf(wave_max(fmaxf(sc[0], sc[1])), sink);
    const float p0 = __expf(sc[0] - m), p1 = __expf(sc[1] - m);
    const float den = wave_sum(p0 + p1) + __expf(sink - m);
    float o = 0.f;
    for (int j = 0; j < 2; ++j)
        for (int l = 0; l < 64; ++l) {
            const float p = __shfl(j == 0 ? p0 : p1, l); const int delta = l + 64 * j;
            if (s - delta >= 0) o += p * bf2f(v[(size_t)(t - delta) * 128 + hk * 64 + lane]);
        }
    out[(size_t)t * ldo + h * 64 + lane] = f2bf(o / den);
}
__global__ void __launch_bounds__(512) n_conv_ln(const bf16* u, const float* w, const float* b, const float* g, const float* be, bf16* out, int ldo, int pad) {
    __shared__ float red[16];
    const int t = blockIdx.x, c = threadIdx.x, s = t & (SEQ - 1);
    float y = b[c];
    for (int j = 0; j < 31; ++j) { const int sp = s - 30 + j; if (sp >= 0) y += w[j * 512 + c] * bf2f(u[(size_t)(t - 30 + j) * 512 + c]); }
    float sm = wave_sum(y);
    if ((c & 63) == 0) red[c >> 6] = sm;
    __syncthreads();
    float mean = 0.f;
    for (int i = 0; i < 8; ++i) mean += red[i];
    mean *= (1.f / 512.f);
    const float dv = y - mean;
    float sq = wave_sum(dv * dv);
    if ((c & 63) == 0) red[8 + (c >> 6)] = sq;
    __syncthreads();
    float var = 0.f;
    for (int i = 0; i < 8; ++i) var += red[8 + i];
    var *= (1.f / 512.f);
    const float z = dv * rsqrtf(var + 1e-5f) * g[c] + be[c];
    out[(size_t)t * ldo + c] = f2bf(z * sigmoidf_(z));
}
__global__ void __launch_bounds__(256) n_mkprep(const float* mkv, const float* g, float* mkn) {
    const int w = (blockIdx.x * 256 + threadIdx.x) >> 6, lane = threadIdx.x & 63;
    if (w >= 512 * 4) return;
    const int r = w >> 2, h = w & 3;
    const float* p = mkv + (size_t)r * 1024 + h * 128;
    const float a = p[lane], b2 = p[lane + 64];
    const float rr = rsqrtf(wave_sum(a * a + b2 * b2) * (1.f / 128.f) + 1e-6f);
    mkn[(size_t)r * 512 + h * 128 + lane] = a * rr * g[lane];
    mkn[(size_t)r * 512 + h * 128 + lane + 64] = b2 * rr * g[lane + 64];
}
__global__ void __launch_bounds__(256) n_xattn(const bf16* xq, const float* gxq, const float* mkn, const float* mkv, bf16* out, int ldo, int pad) {
    __shared__ float qs[4][128];
    const int wl = threadIdx.x >> 6, w = blockIdx.x * 4 + wl, lane = threadIdx.x & 63;
    const int t = w >> 2, h = w & 3, b = t / SEQ;
    const bf16* qp = xq + (size_t)t * 512 + h * 128;
    const float a = bf2f(qp[lane]), b2 = bf2f(qp[lane + 64]);
    const float rr = rsqrtf(wave_sum(a * a + b2 * b2) * (1.f / 128.f) + 1e-6f);
    qs[wl][lane] = a * rr * gxq[lane]; qs[wl][lane + 64] = b2 * rr * gxq[lane + 64];
    __syncthreads();
    float sc[4];
#pragma unroll
    for (int j = 0; j < 4; ++j) { const float* kr = mkn + (size_t)(b * 256 + lane + 64 * j) * 512 + h * 128; float s = 0.f;
        for (int d = 0; d < 128; ++d) s += qs[wl][d] * kr[d];
        sc[j] = s * 0.08838834764831845f; }
    const float m = wave_max(fmaxf(fmaxf(sc[0], sc[1]), fmaxf(sc[2], sc[3])));
    float p[4]; float ps = 0.f;
#pragma unroll
    for (int j = 0; j < 4; ++j) { p[j] = __expf(sc[j] - m); ps += p[j]; }
    const float den = wave_sum(ps);
    float o0 = 0.f, o1 = 0.f;
#pragma unroll
    for (int j = 0; j < 4; ++j)
        for (int l = 0; l < 64; ++l) { const float pp = __shfl(p[j], l); const float* vr = mkv + (size_t)(b * 256 + l + 64 * j) * 1024 + 512 + h * 128;
            o0 += pp * vr[lane]; o1 += pp * vr[lane + 64]; }
    out[(size_t)t * ldo + h * 128 + lane] = f2bf(o0 / den); out[(size_t)t * ldo + h * 128 + lane + 64] = f2bf(o1 / den);
}
__global__ void __launch_bounds__(256) n_router(const float* xm, const float* g2, const float* wg, const float* bg, const float* wr, const float* br, bf16* h2, int* eid, float* ew) {
    const int t = (blockIdx.x * 256 + threadIdx.x) >> 6, lane = threadIdx.x & 63;
    const float4* xr = (const float4*)(xm + (size_t)t * 1024);
    float hv[16]; float s = 0.f;
#pragma unroll
    for (int j = 0; j < 4; ++j) { const float4 v = xr[lane + 64 * j]; hv[4 * j] = v.x; hv[4 * j + 1] = v.y; hv[4 * j + 2] = v.z; hv[4 * j + 3] = v.w; s += v.x * v.x + v.y * v.y + v.z * v.z + v.w * v.w; }
    const float r = rsqrtf(wave_sum(s) * (1.f / 1024.f) + 1e-6f);
#pragma unroll
    for (int j = 0; j < 4; ++j)
#pragma unroll
        for (int i = 0; i < 4; ++i) { const int c = 4 * (lane + 64 * j) + i; hv[4 * j + i] = hv[4 * j + i] * r * g2[c]; h2[(size_t)t * 1024 + c] = f2bf(hv[4 * j + i]); }
    float lg[20];
#pragma unroll
    for (int n = 0; n < 20; ++n) { float a = 0.f;
#pragma unroll
        for (int j = 0; j < 4; ++j)
#pragma unroll
            for (int i = 0; i < 4; ++i) { const int c = 4 * (lane + 64 * j) + i; a += hv[4 * j + i] * (n < 4 ? wg[c * 4 + n] : wr[c * 16 + (n - 4)]); }
        lg[n] = wave_sum(a) + (n < 4 ? bg[n] : br[n - 4]); }
    if (lane == 0) {
        int gi = 0; float gm = lg[0];
        for (int i = 1; i < 4; ++i) if (lg[i] > gm) { gm = lg[i]; gi = i; }
        float den = 0.f; for (int i = 0; i < 4; ++i) den += __expf(lg[i] - gm);
        const float pg = 1.f / den;
        float e[4]; for (int i = 0; i < 4; ++i) e[i] = lg[4 + gi * 4 + i];
        int i1 = 0; for (int i = 1; i < 4; ++i) if (e[i] > e[i1]) i1 = i;
        int i2 = -1; for (int i = 0; i < 4; ++i) if (i != i1 && (i2 < 0 || e[i] > e[i2])) i2 = i;
        const float q2 = __expf(e[i2] - e[i1]); const float p1 = 1.f / (1.f + q2), p2 = q2 / (1.f + q2);
        eid[2 * t] = gi * 4 + i1; eid[2 * t + 1] = gi * 4 + i2; ew[2 * t] = pg * p1; ew[2 * t + 1] = pg * p2;
    }
}
__global__ void __launch_bounds__(256) n_moe(const bf16* h2, const int* eid, const float* ew, const float* wgate, const float* wup, const float* wdown, float* out) {
    __shared__ float hs[1024]; __shared__ float hid[512];
    const int t = blockIdx.x, tid = threadIdx.x;
    for (int i = tid; i < 1024; i += 256) hs[i] = bf2f(h2[(size_t)t * 1024 + i]);
    __syncthreads();
    float y[4] = {0.f, 0.f, 0.f, 0.f};
    for (int s = 0; s < 2; ++s) {
        const int e = eid[2 * t + s]; const float cw = ew[2 * t + s];
        const float* G = wgate + (size_t)e * 1024 * 512; const float* U = wup + (size_t)e * 1024 * 512; const float* Dn = wdown + (size_t)e * 512 * 1024;
        float g0 = 0.f, g1 = 0.f, u0 = 0.f, u1 = 0.f;
        for (int k = 0; k < 1024; ++k) { const float hk = hs[k]; g0 += hk * G[k * 512 + tid]; g1 += hk * G[k * 512 + tid + 256]; u0 += hk * U[k * 512 + tid]; u1 += hk * U[k * 512 + tid + 256]; }
        __syncthreads();
        hid[tid] = g0 * sigmoidf_(g0) * u0 * cw; hid[tid + 256] = g1 * sigmoidf_(g1) * u1 * cw;
        __syncthreads();
        for (int j = 0; j < 512; ++j) { const float hj = hid[j];
#pragma unroll
            for (int i = 0; i < 4; ++i) y[i] += hj * Dn[(size_t)j * 1024 + tid + 256 * i]; }
    }
#pragma unroll
    for (int i = 0; i < 4; ++i) out[(size_t)t * 1024 + tid + 256 * i] += y[i];
}

extern "C" void kernel_launch(void* const* d_in, const int* in_sizes, int n_in, void* d_out, int out_size, void* d_ws, size_t ws_size, hipStream_t stream) {
    const float* x = (const float*)d_in[0]; const float* mem = (const float*)d_in[1]; const int* positions = (const int*)d_in[2];
    const float* g_norm1 = (const float*)d_in[3]; const float* w_in = (const float*)d_in[4]; const float* g_q = (const float*)d_in[5]; const float* g_k = (const float*)d_in[6];
    const float* sinks = (const float*)d_in[7]; const float* w_o_attn = (const float*)d_in[8]; const float* w_conv_dw = (const float*)d_in[9]; const float* b_conv_dw = (const float*)d_in[10];
    const float* g_conv_ln = (const float*)d_in[11]; const float* b_conv_ln = (const float*)d_in[12]; const float* w_conv_out = (const float*)d_in[13]; const float* g_mem = (const float*)d_in[14];
    const float* w_kv_mem = (const float*)d_in[15]; const float* g_xq = (const float*)d_in[16]; const float* g_xk = (const float*)d_in[17]; const float* w_o_mem = (const float*)d_in[18];
    const float* w_out = (const float*)d_in[19]; const float* g_norm2 = (const float*)d_in[20]; const float* w_group = (const float*)d_in[21]; const float* b_group = (const float*)d_in[22];
    const float* w_router = (const float*)d_in[23]; const float* b_router = (const float*)d_in[24]; const float* w_gate = (const float*)d_in[25]; const float* w_up = (const float*)d_in[26]; const float* w_down = (const float*)d_in[27];
    float* out = (float*)d_out; unsigned char* ws = (unsigned char*)d_ws;
    bf16* q = (bf16*)(ws + 0 * MiB);
    bf16* k = (bf16*)(ws + 16 * MiB);
    bf16* v = (bf16*)(ws + 20 * MiB);
    bf16* u = (bf16*)(ws + 24 * MiB);
    bf16* xq = (bf16*)(ws + 40 * MiB);
    bf16* gates = (bf16*)(ws + 56 * MiB);
    bf16* acts = (bf16*)(ws + 152 * MiB);
    bf16* memn = (bf16*)(ws + 200 * MiB);
    float* mkv = (float*)(ws + 201 * MiB);
    float* mkn = (float*)(ws + 203 * MiB);
    float2* cs = (float2*)(ws + 204 * MiB);
    int* eid = (int*)(ws + 208 * MiB); float* ew = (float*)(ws + 209 * MiB);
    bf16* mbf = u;
    bf16* h2 = gates;
    bf16* h = (bf16*)out;
    float* merged = out;

    n_rmsnorm<<<T / 4, 256, 0, stream>>>(x, g_norm1, h, T, 0);
    n_rmsnorm<<<512 / 4, 256, 0, stream>>>(mem, g_mem, memn, 512, 0);
    n_rope_table<<<T * 32 / 256, 256, 0, stream>>>(positions, cs);
    n_gemm<false, EpiBf><<<dim3(512 / 64, T / 64), 256, 0, stream>>>(h, w_in + 0, nullptr, 1024, INW, 1024, 0, EpiBf{q, 512, 0});
    n_gemm<false, EpiBf><<<dim3(128 / 64, T / 64), 256, 0, stream>>>(h, w_in + 512, nullptr, 1024, INW, 1024, 0, EpiBf{k, 128, 0});
    n_gemm<false, EpiBf><<<dim3(128 / 64, T / 64), 256, 0, stream>>>(h, w_in + 640, nullptr, 1024, INW, 1024, 0, EpiBf{v, 128, 0});
    n_gemm<true, EpiGlu><<<dim3(512 / 64, T / 64), 256, 0, stream>>>(h, w_in + 768, w_in + 1280, 1024, INW, 1024, 0, EpiGlu{u, 512, 0});
    n_gemm<false, EpiBf><<<dim3(512 / 64, T / 64), 256, 0, stream>>>(h, w_in + 1792, nullptr, 1024, INW, 1024, 0, EpiBf{xq, 512, 0});
    n_gemm<false, EpiSig><<<dim3(3072 / 64, T / 64), 256, 0, stream>>>(h, w_in + 2304, nullptr, 1024, INW, 1024, 0, EpiSig{gates, 3072, 0});
    n_gemm<false, EpiF32><<<dim3(1024 / 64, 512 / 64), 256, 0, stream>>>(memn, w_kv_mem, nullptr, 1024, 1024, 1024, 0, EpiF32{mkv, 1024, 0});
    n_qkprep<<<T * 8 / 4, 256, 0, stream>>>(q, g_q, cs, 8, 0);
    n_qkprep<<<T * 2 / 4, 256, 0, stream>>>(k, g_k, cs, 2, 0);
    n_swa<<<T * 8 / 4, 256, 0, stream>>>(q, k, v, sinks, acts, 1536, 0);
    n_conv_ln<<<T, 512, 0, stream>>>(u, w_conv_dw, b_conv_dw, g_conv_ln, b_conv_ln, acts + 512, 1536, 0);
    n_mkprep<<<512 * 4 / 4, 256, 0, stream>>>(mkv, g_xk, mkn);
    n_xattn<<<T * 4 / 4, 256, 0, stream>>>(xq, g_xq, mkn, mkv, acts + 1024, 1536, 0);
    n_gemm<false, EpiGate><<<dim3(1024 / 64, T / 64), 256, 0, stream>>>(acts, w_o_attn, nullptr, 1536, 1024, 512, 0, EpiGate{gates, merged, mbf, 0, 0});
    n_gemm<false, EpiGate><<<dim3(1024 / 64, T / 64), 256, 0, stream>>>(acts + 512, w_conv_out, nullptr, 1536, 1024, 512, 0, EpiGate{gates + 1024, merged, mbf, 1, 0});
    n_gemm<false, EpiGate><<<dim3(1024 / 64, T / 64), 256, 0, stream>>>(acts + 1024, w_o_mem, nullptr, 1536, 1024, 512, 0, EpiGate{gates + 2048, merged, mbf, 2, 0});
    n_gemm<false, EpiRes><<<dim3(1024 / 64, T / 64), 256, 0, stream>>>(mbf, w_out, nullptr, 1024, 1024, 1024, 0, EpiRes{x, out});
    n_router<<<T / 4, 256, 0, stream>>>(out, g_norm2, w_group, b_group, w_router, b_router, h2, eid, ew);
    n_moe<<<T, 256, 0, stream>>>(h2, eid, ew, w_gate, w_up, w_down, out);
}
```

```cpp
#include <hip/hip_runtime.h>
#include <cstdint>
#include <cstdio>
#define MK_LEVEL 4
#define MK_MIXN 0
#define MK_SPLIT01 0
constexpr int NWAVES = 8;
constexpr int T = 16384, SEQ = 8192, D = 1024, INW = 5376;
constexpr size_t MiB = 1u << 20;
constexpr size_t WS_CTL = 0, CTL_ZERO_BYTES = 1 * MiB;
constexpr size_t WS_W1 = 1 * MiB;
constexpr size_t WS_WO3 = 12 * MiB;
constexpr size_t WS_WOUT = 15 * MiB;
constexpr size_t WS_WKV = 17 * MiB;
constexpr size_t WS_WGU = 19 * MiB;
constexpr size_t WS_WDT = 51 * MiB;
constexpr size_t WS_CS = 67 * MiB;
constexpr size_t WS_MEMN = 71 * MiB;
constexpr size_t WS_MKV = 72 * MiB;
constexpr size_t WS_ROUTE = 73 * MiB;
constexpr size_t WS_U = 76 * MiB;
constexpr size_t WS_XQ = 92 * MiB;
constexpr size_t WS_MERGED = 76 * MiB;
constexpr size_t WS_GATES = 108 * MiB;
constexpr size_t WS_H2 = 108 * MiB;
constexpr size_t WS_HID = 140 * MiB;
constexpr size_t WS_ACTS = 204 * MiB;
constexpr size_t WS_END = 252 * MiB;
constexpr size_t DO_H = 0, DO_Q = 32 * MiB, DO_K = 48 * MiB, DO_V = 52 * MiB;
constexpr size_t RT_CLS = 0;
constexpr size_t RT_W = 64 * 1024;
constexpr size_t RT_CNT = 192 * 1024;
constexpr size_t RT_TOK = 256 * 1024;
constexpr size_t RT_SW = 384 * 1024;
constexpr int CW_TMO = 0, CW_BAR = 4096;
constexpr int RING_OFF = 0, RING_BYTES = 131072;
constexpr int LDS_BYTES = 147456;
constexpr int LDSCTL_OFF = LDS_BYTES - 4096, MISC_OFF = LDSCTL_OFF + 320;
constexpr int TAB_OFF = LDSCTL_OFF + 1024;

#define GAS __attribute__((address_space(1)))
#define LAS __attribute__((address_space(3)))
typedef unsigned short bf16;
typedef unsigned v4u __attribute__((ext_vector_type(4)));
typedef unsigned v2u __attribute__((ext_vector_type(2)));
typedef float f32x4 __attribute__((ext_vector_type(4)));
typedef short bf16x8 __attribute__((ext_vector_type(8)));
typedef GAS unsigned gu32;
#define RLX_AGENT __ATOMIC_RELAXED, __HIP_MEMORY_SCOPE_AGENT
#define LDS_WAIT() asm volatile("s_waitcnt lgkmcnt(0)" ::: "memory")
#define VM_WAIT() asm volatile("s_waitcnt vmcnt(0)" ::: "memory")
__device__ __forceinline__ unsigned f2bf(float f) { unsigned u = __builtin_bit_cast(unsigned, f); return (u + 0x7fffu + ((u >> 16) & 1u)) >> 16; }
__device__ __forceinline__ unsigned pk2(float lo, float hi) { return f2bf(lo) | (f2bf(hi) << 16); }
__device__ __forceinline__ float bf2f(bf16 v) { return __uint_as_float((unsigned)v << 16); }
__device__ __forceinline__ float bflo(unsigned w) { return __uint_as_float(w << 16); }
__device__ __forceinline__ float bfhi(unsigned w) { return __uint_as_float(w & 0xffff0000u); }
__device__ __forceinline__ float wave_sum(float v) {
#pragma unroll
    for (int o = 1; o < 64; o <<= 1) v += __shfl_xor(v, o);
    return v;
}
__device__ __forceinline__ float wave_max(float v) {
#pragma unroll
    for (int o = 1; o < 64; o <<= 1) v = fmaxf(v, __shfl_xor(v, o));
    return v;
}
__device__ __forceinline__ float fsigmoid(float x) { return __builtin_amdgcn_rcpf(1.f + __expf(-x)); }

#define XB_TMO      128
#define XB_XCNT(j)  (256  + 64 * (j))
#define XB_XSUB(j)  (1280 + 64 * (j))
#define XB_XGEN(j)  (2304 + 64 * (j))
#define XB_TOP      3328
#define XB_TOPGEN   3392
#define XCD_BAR_WORDS 3456
#define XB_SPIN_CAP (1u << 18)
__device__ __forceinline__ unsigned xb_ld(unsigned* p)              { return __hip_atomic_load(p, __ATOMIC_RELAXED, __HIP_MEMORY_SCOPE_AGENT); }
__device__ __forceinline__ unsigned xb_add(unsigned* p, unsigned v) { return __hip_atomic_fetch_add(p, v, __ATOMIC_RELAXED, __HIP_MEMORY_SCOPE_AGENT); }
__device__ __forceinline__ unsigned xb_xcc_id() { return (unsigned)__builtin_amdgcn_s_getreg((3 << 11) | 20) & 0xFu; }
#define XB_SPIN(cond, bar) do { unsigned _sp = 0; while (cond) { __builtin_amdgcn_s_sleep(1); \
    if ((++_sp & 255u) == 0u) { if (xb_ld(&(bar)[XB_TMO])) break; if (_sp > XB_SPIN_CAP) { atomicAdd(&(bar)[XB_TMO], 1u); break; } } } } while (0)
struct XcdBarrier { unsigned* bar; unsigned x; volatile LAS unsigned* st; };
__device__ __forceinline__ XcdBarrier xcd_barrier_post(unsigned* bar, volatile LAS unsigned* st) {
    XcdBarrier b; b.bar = bar; b.x = xb_xcc_id(); b.st = st;
    if (threadIdx.x == 0) (void)xb_add(&bar[XB_XCNT(b.x)], 1u);
    return b;
}
__device__ __forceinline__ void xcd_barrier_complete(unsigned* bar, unsigned x, unsigned& nloc, unsigned& nx) {
    const unsigned G = gridDim.x * gridDim.y * gridDim.z;
    unsigned sum, cnt, mine, sp = 0u;
    for (;;) {
        sum = 0u; cnt = 0u; mine = 0u;
#pragma unroll
        for (unsigned j = 0; j < 16; ++j) { const unsigned c = xb_ld(&bar[XB_XCNT(j)]); sum += c; cnt += (c > 0u) ? 1u : 0u; mine = (j == x) ? c : mine; }
        if (sum == G) break;
        __builtin_amdgcn_s_sleep(1);
        if ((++sp & 255u) == 0u) { if (xb_ld(&bar[XB_TMO])) break; if (sp > XB_SPIN_CAP) { atomicAdd(&bar[XB_TMO], 1u); break; } }
    }
    nloc = mine > 0u ? mine : 1u; nx = cnt > 0u ? cnt : 1u;
}
__device__ __forceinline__ void xcd_barrier(const XcdBarrier& b) {
    asm volatile("s_waitcnt vmcnt(0)" ::: "memory");
    __syncthreads();
    if (threadIdx.x == 0) {
        unsigned* bar = b.bar;
        __builtin_amdgcn_s_waitcnt(0);
        unsigned nloc = b.st[0], nx = b.st[1];
        if (nloc == 0u) { xcd_barrier_complete(bar, b.x, nloc, nx); b.st[0] = nloc; b.st[1] = nx; }
        const unsigned old = xb_add(&bar[XB_XSUB(b.x)], 1u);
        const unsigned gen = old / nloc;
        if (old + 1u == (gen + 1u) * nloc) {
            __builtin_amdgcn_fence(__ATOMIC_RELEASE, "agent");
            asm volatile("s_waitcnt vmcnt(0)" ::: "memory");
            const unsigned og = xb_add(&bar[XB_TOP], 1u);
            const unsigned tg = og / nx;
            if (og + 1u == (tg + 1u) * nx) xb_add(&bar[XB_TOPGEN], 1u);
            else XB_SPIN(xb_ld(&bar[XB_TOPGEN]) == tg, bar);
            __builtin_amdgcn_fence(__ATOMIC_ACQUIRE, "agent");
            xb_add(&bar[XB_XGEN(b.x)], 1u);
            asm volatile("s_waitcnt vmcnt(0)" ::: "memory");
        } else {
            XB_SPIN(xb_ld(&bar[XB_XGEN(b.x)]) == gen, bar);
            __builtin_amdgcn_fence(__ATOMIC_ACQUIRE, "agent");
            asm volatile("s_waitcnt vmcnt(0)" ::: "memory");
        }
    }
    __syncthreads();
}

struct Args { const float* in[28]; float* out; unsigned char* ws; int ph_lo, ph_hi, li, pad; };
struct Frame {
    LAS unsigned char* lds; volatile LAS unsigned* MISC; gu32* ctl;
    int tid, lane, wave, vcu, G;
};
namespace pg8 {
#define PG8_LAS __attribute__((address_space(3)))
typedef unsigned short bf16_t;
typedef short bf16x8 __attribute__((ext_vector_type(8)));
typedef float f32x4 __attribute__((ext_vector_type(4)));
typedef unsigned u32x4 __attribute__((ext_vector_type(4)));
typedef unsigned u32x2 __attribute__((ext_vector_type(2)));
constexpr int BM = 256, BK = 64, HALF = 128, HTB = HALF * BK * 2  , STAGE_BYTES = 8 * HTB, NXCD = 8, WGM = 8;

__host__ __device__ __forceinline__ int lds_byte(int r, int c) { const int st = (r >> 4) * 2 + (c >> 5), rr = r & 15, cc = c & 31, ob = rr * 64 + cc * 2; return st * 1024 + (ob ^ (((ob >> 9) & 1) << 5)); }
__host__ __device__ __forceinline__ void stage_rc(int b, int& R, int& C) { const int st = b / 1024, sb = b % 1024, swz = sb ^ (((sb >> 9) & 1) << 5); R = (st >> 1) * 16 + swz / 64; C = (st & 1) * 32 + (swz % 64) / 2; }
__host__ __device__ __forceinline__ int perm32(int rho) { const int n = rho >> 4, i = rho & 15; return 8 * (i >> 2) + 4 * n + (i & 3); }

struct Unit { int pm, pn, aux, ksplit; const char* A; const char* B0; const char* B1; const int* ridx; };

typedef float f32x2_t __attribute__((ext_vector_type(2))); typedef __bf16 bf16x2_t __attribute__((ext_vector_type(2)));
__device__ __forceinline__ unsigned cvt_pk_bf16(float lo, float hi) { f32x2_t v = {lo, hi}; bf16x2_t b = __builtin_convertvector(v, bf16x2_t); return __builtin_bit_cast(unsigned, b); }

__device__ __forceinline__ bool static_tile(int L, int nM, int nN, int& pm, int& pn) {
    const int nwg = nM * nN; if (L >= nwg) return false;
    int wgid = L; { const int q = nwg / NXCD, r = nwg % NXCD, xcd = wgid % NXCD, off = wgid / NXCD; wgid = (xcd < r ? xcd * (q + 1) : r * (q + 1) + (xcd - r) * q) + off; }
    const int nig = WGM * nN, gid = wgid / nig, fm = gid * WGM, gsz = (nM - fm) < WGM ? (nM - fm) : WGM;
    pm = fm + ((wgid % nig) % gsz); pn = (wgid % nig) / gsz; return true;
}

template <class Epi, class Sched, bool ALIGN_EPI, bool GATHER>
__device__ __forceinline__ void gemm_phase(PG8_LAS unsigned char* lds, const int nt, const unsigned lda, const unsigned ldb, const Sched& S, const Epi& E) {
    const int tid = threadIdx.x, wid = __builtin_amdgcn_readfirstlane(tid >> 6), lane = tid & 63, wr = wid >> 2, wc = wid & 3, fr = lane & 15, fq = lane >> 4;
    unsigned voffA[2], voffB[2];
#pragma unroll
    for (int i = 0; i < 2; ++i) { int R, C; stage_rc(tid * 16 + i * 8192, R, C); const int Rb = Epi::PERM ? ((R & ~31) + perm32(R & 31)) : R;
        voffA[i] = (unsigned)R * lda + (unsigned)C * 2u; voffB[i] = (unsigned)Rb * ldb + (unsigned)C * 2u; }
    const size_t kstep = (size_t)(BK * 2);
    const size_t hstepA = (size_t)HALF * lda, hstepB = (size_t)HALF * ldb;
    const unsigned ldsw = (unsigned)wid * 1024u;
    const int aoff = lds_byte(wr * 64 + fr, fq * 8), boff = lds_byte(wc * 32 + fr, fq * 8);
#define PG8_SA(b, h) (((b) * 2 + (h)) * HTB)
#define PG8_SB(b, h) ((4 + (b) * 2 + (h)) * HTB)
#define PG8_STAGE(bufoff, gbase, voff) do { _Pragma("unroll") for (int _i = 0; _i < 2; ++_i) \
        __builtin_amdgcn_global_load_lds((const unsigned*)((const char*)(gbase) + (voff)[_i]), (PG8_LAS unsigned*)(lds + (bufoff) + ldsw + _i * 8192), 16, 0, 0); } while (0)
#define PG8_LDA(dst, b, h) do { _Pragma("unroll") for (int m = 0; m < 4; ++m) _Pragma("unroll") for (int k = 0; k < 2; ++k) dst[m][k] = *(const PG8_LAS bf16x8*)(lds + PG8_SA(b, h) + aoff + m * 2048 + k * 1024); } while (0)
#define PG8_LDB(dst, b, h) do { _Pragma("unroll") for (int n = 0; n < 2; ++n) _Pragma("unroll") for (int k = 0; k < 2; ++k) dst[n][k] = *(const PG8_LAS bf16x8*)(lds + PG8_SB(b, h) + boff + n * 2048 + k * 1024); } while (0)
#define PG8_MMA(ai, bj, At, Bt) do { __builtin_amdgcn_s_setprio(1); _Pragma("unroll") for (int m = 0; m < 4; ++m) _Pragma("unroll") for (int n = 0; n < 2; ++n) _Pragma("unroll") for (int k = 0; k < 2; ++k) \
        acc[ai][bj][m][n] = __builtin_amdgcn_mfma_f32_16x16x32_bf16(Bt[n][k], At[m][k], acc[ai][bj][m][n], 0, 0, 0); __builtin_amdgcn_s_setprio(0); } while (0)
#define PG8_WAIT_V(n) asm volatile("s_waitcnt vmcnt(" #n ")" ::: "memory")
#define PG8_WAIT_L(n) asm volatile("s_waitcnt lgkmcnt(" #n ")" ::: "memory")
#define PG8_BAR __builtin_amdgcn_s_barrier()
#define PG8_SCHED __builtin_amdgcn_sched_barrier(0)
#define PG8_APTR(u, h, t) ((u).A + (GATHER ? (size_t)0 : (size_t)(h) * hstepA) + (size_t)(t) * kstep)
#define PG8_BPTR(u, h, t) (((t) < (u).ksplit ? (u).B0 + (size_t)(t) * kstep : (u).B1 + (size_t)((t) - (u).ksplit) * kstep) + (size_t)(h) * hstepB)
#define PG8_STAGE_A(bufoff, u, g, h, t) do { if (GATHER) { unsigned _vo[2]; int _tid = tid; asm volatile("" : "+v"(_tid)); _Pragma("unroll") for (int _i = 0; _i < 2; ++_i) { int _R, _C; stage_rc(_tid * 16 + _i * 8192, _R, _C); \
            _vo[_i] = (((g)[h] >> (16 * _i)) & 0xffffu) * lda + (unsigned)_C * 2u; } PG8_STAGE(bufoff, PG8_APTR(u, h, t), _vo); } else PG8_STAGE(bufoff, PG8_APTR(u, h, t), voffA); } while (0)
#define PG8_STAGE_B(bufoff, u, h, t) PG8_STAGE(bufoff, PG8_BPTR(u, h, t), voffB)
#define PG8_GIDX(g, u) do { if (GATHER) { _Pragma("unroll") for (int _h = 0; _h < 2; ++_h) { unsigned _p = 0u; _Pragma("unroll") for (int _i = 0; _i < 2; ++_i) { int _R, _C; stage_rc(tid * 16 + _i * 8192, _R, _C); \
            int _t = (u).ridx[_h * HALF + _R]; _t = _t < 0 ? 0 : _t; _p |= (unsigned)_t << (16 * _i); } (g)[_h] = _p; } } } while (0)
    Unit cur, nxt; int ui = 0;
    if (!S.next(0, cur)) return;
    f32x4 acc[2][2][4][2];
#pragma unroll
    for (int a = 0; a < 2; ++a)
#pragma unroll
        for (int b = 0; b < 2; ++b)
#pragma unroll
            for (int m = 0; m < 4; ++m)
#pragma unroll
                for (int n = 0; n < 2; ++n) acc[a][b][m][n] = (f32x4){0.f, 0.f, 0.f, 0.f};
    bf16x8 At[4][2], B0[2][2], B1[2][2];
    unsigned gC[2] = {0u, 0u}, gN[2] = {0u, 0u};
    PG8_GIDX(gC, cur);
    PG8_STAGE_B(PG8_SB(0, 0), cur, 0, 0); PG8_STAGE_B(PG8_SB(0, 1), cur, 1, 0); PG8_STAGE_A(PG8_SA(0, 0), cur, gC, 0, 0); PG8_STAGE_A(PG8_SA(0, 1), cur, gC, 1, 0);
    if (wr == 1) PG8_BAR;
    PG8_WAIT_V(2); PG8_BAR;
    PG8_STAGE_B(PG8_SB(1, 0), cur, 0, 1); PG8_STAGE_A(PG8_SA(1, 0), cur, gC, 0, 1); PG8_STAGE_B(PG8_SB(1, 1), cur, 1, 1);
    PG8_WAIT_V(6); PG8_BAR;
    for (;;) {
        const bool has_next = S.next(ui + 1, nxt);
        if (!has_next) nxt = cur;
        if (GATHER) { if (has_next) { PG8_GIDX(gN, nxt); } else { gN[0] = gC[0]; gN[1] = gC[1]; } }
        for (int t = 0; t < nt; t += 2) {
            const bool last = (t == nt - 2);
            PG8_LDB(B0, 0, 0); PG8_LDB(B1, 0, 1); PG8_SCHED; PG8_LDA(At, 0, 0); PG8_STAGE_A(PG8_SA(1, 1), cur, gC, 1, t + 1);
            PG8_WAIT_V(8); PG8_WAIT_L(0); PG8_BAR; PG8_MMA(0, 0, At, B0); PG8_MMA(0, 1, At, B1); PG8_BAR; PG8_SCHED;
            PG8_LDA(At, 0, 1);
            if (!last) { PG8_STAGE_B(PG8_SB(0, 0), cur, 0, t + 2); PG8_STAGE_B(PG8_SB(0, 1), cur, 1, t + 2); PG8_STAGE_A(PG8_SA(0, 0), cur, gC, 0, t + 2); }
            else       { PG8_STAGE_B(PG8_SB(0, 0), nxt, 0, 0);     PG8_STAGE_B(PG8_SB(0, 1), nxt, 1, 0);     PG8_STAGE_A(PG8_SA(0, 0), nxt, gN, 0, 0); }
            PG8_WAIT_V(8); PG8_WAIT_L(0); PG8_BAR; PG8_MMA(1, 0, At, B0); PG8_MMA(1, 1, At, B1); PG8_BAR; PG8_SCHED;
            PG8_LDB(B0, 1, 0); PG8_LDB(B1, 1, 1); PG8_SCHED; PG8_LDA(At, 1, 0);
            if (!last) { PG8_STAGE_A(PG8_SA(0, 1), cur, gC, 1, t + 2); } else { PG8_STAGE_A(PG8_SA(0, 1), nxt, gN, 1, 0); }
            PG8_WAIT_V(8); PG8_WAIT_L(0); PG8_BAR; PG8_MMA(0, 0, At, B0); PG8_MMA(0, 1, At, B1); PG8_BAR; PG8_SCHED;
            PG8_LDA(At, 1, 1);
            if (!last) { PG8_STAGE_B(PG8_SB(1, 0), cur, 0, t + 3); PG8_STAGE_B(PG8_SB(1, 1), cur, 1, t + 3); PG8_STAGE_A(PG8_SA(1, 0), cur, gC, 0, t + 3); }
            else       { PG8_STAGE_B(PG8_SB(1, 0), nxt, 0, 1);     PG8_STAGE_B(PG8_SB(1, 1), nxt, 1, 1);     PG8_STAGE_A(PG8_SA(1, 0), nxt, gN, 0, 1); }
            PG8_WAIT_V(8); PG8_WAIT_L(0); PG8_BAR; PG8_MMA(1, 0, At, B0); PG8_MMA(1, 1, At, B1); PG8_BAR; PG8_SCHED;
        }
        if constexpr (ALIGN_EPI) { if (wr == 0) PG8_BAR; }
        int fr_ = fr, fq_ = fq; asm volatile("" : "+v"(fr_), "+v"(fq_));
        const bool zero = E(acc, cur, wr, wc, fr_, fq_);
        if (!has_next) break;
        if (zero) {
#pragma unroll
            for (int a = 0; a < 2; ++a)
#pragma unroll
                for (int b = 0; b < 2; ++b)
#pragma unroll
                    for (int m = 0; m < 4; ++m)
#pragma unroll
                        for (int n = 0; n < 2; ++n) acc[a][b][m][n] = (f32x4){0.f, 0.f, 0.f, 0.f};
        }
        cur = nxt; ++ui;
        if (GATHER) { gC[0] = gN[0]; gC[1] = gN[1]; }
        if constexpr (ALIGN_EPI) { if (wr == 1) PG8_BAR; }
    }
    PG8_WAIT_V(0);
    if constexpr (!ALIGN_EPI) { if (wr == 0) PG8_BAR; }
    PG8_BAR;
#undef PG8_SA
#undef PG8_SB
#undef PG8_STAGE
#undef PG8_LDA
#undef PG8_LDB
#undef PG8_MMA
#undef PG8_WAIT_V
#undef PG8_WAIT_L
#undef PG8_BAR
#undef PG8_SCHED
#undef PG8_APTR
#undef PG8_BPTR
#undef PG8_STAGE_A
#undef PG8_STAGE_B
#undef PG8_GIDX
}
}
__device__ __forceinline__ int map_win(int n) {
    if (n < 512) { const int hq = n >> 6, d = n & 63; return 256 * (hq >> 2) + (d >> 5) * 128 + 32 * (hq & 3) + (d & 31); }
    if (n < 768) { const int j = n - 512, hh = j >> 6, d = j & 63; return 512 + (d >> 5) * 128 + 32 * hh + (d & 31); }
    if (n < 1792) { const int j = n - 768; const int c = j & 511; return 768 + 8 * (c >> 2) + (j >= 512 ? 4 : 0) + (c & 3); }
    return n;
}
__device__ __forceinline__ int map_row(int mode, int n) {
    if (mode == 1) return map_win(n);
    if (mode == 2) return 8 * (n >> 2) + (n & 3);
    if (mode == 3) return 8 * (n >> 2) + 4 + (n & 3);
    return n;
}
__device__ __forceinline__ void p0_transpose_item(const float* W, int N, bf16* WT, int ldt, int mode, LAS float* scr, int kb, int nb, int lane) {
    const int k0 = 64 * kb, n0 = 32 * nb;
#pragma unroll 8
    for (int i = 0; i < 32; ++i) { const int kk = 2 * i + (lane >> 5); scr[kk * 33 + (lane & 31)] = W[(size_t)(k0 + kk) * N + n0 + (lane & 31)]; }
    LDS_WAIT(); asm volatile("" ::: "memory");
    const int c = lane & 7;
#pragma unroll
    for (int j = 0; j < 4; ++j) { const int n = (lane >> 3) + 8 * j; const LAS float* s = scr + (8 * c) * 33 + n;
        v4u o; o.x = pk2(s[0 * 33], s[1 * 33]); o.y = pk2(s[2 * 33], s[3 * 33]); o.z = pk2(s[4 * 33], s[5 * 33]); o.w = pk2(s[6 * 33], s[7 * 33]);
        *(GAS v4u*)(WT + (size_t)map_row(mode, n0 + n) * ldt + k0 + 8 * c) = o; }
    LDS_WAIT(); asm volatile("" ::: "memory");
}
__device__ __forceinline__ void rms_row_to_bf16(int lane, const float* xrow, const float* g, bf16* orow) {
    const GAS f32x4* xr = (const GAS f32x4*)xrow + lane;
    f32x4 v[4]; float s = 0.f;
#pragma unroll
    for (int j = 0; j < 4; ++j) { v[j] = xr[64 * j]; s += (v[j].x * v[j].x + v[j].y * v[j].y) + (v[j].z * v[j].z + v[j].w * v[j].w); }
    const float r = rsqrtf(wave_sum(s) * (1.f / 1024.f) + 1e-6f);
    GAS unsigned long long* o8 = (GAS unsigned long long*)orow + lane;
#pragma unroll
    for (int j = 0; j < 4; ++j) { const f32x4 gg = *((const GAS f32x4*)g + lane + 64 * j);
        o8[64 * j] = (unsigned long long)pk2(v[j].x * r * gg.x, v[j].y * r * gg.y) | ((unsigned long long)pk2(v[j].z * r * gg.z, v[j].w * r * gg.w) << 32); }
}
__device__ __forceinline__ void p0_prologue(Frame& F, const Args& a) {
    LAS float* scr = (LAS float*)(F.lds + RING_OFF + F.wave * 16384);
    const int gw = F.vcu * NWAVES + F.wave, NGW = F.G * NWAVES;
    unsigned char* ws = a.ws;
    constexpr int I_WIN = 16 * 168, I_WO = 8 * 32, I_SQ = 16 * 32, I_GU = 16 * 16 * 16, I_DN = 16 * 8 * 32;
    constexpr int NITEMS = I_WIN + 3 * I_WO + 2 * I_SQ + 2 * I_GU + I_DN;
    for (int it = gw; it < NITEMS; it += NGW) {
        int r = it;
        if (r < I_WIN) { p0_transpose_item(a.in[4], INW, (bf16*)(ws + WS_W1), 1024, 1, scr, r / 168, r % 168, F.lane); continue; } r -= I_WIN;
        if (r < 3 * I_WO) { const int b = r / I_WO, q = r % I_WO; const float* W = b == 0 ? a.in[8] : (b == 1 ? a.in[13] : a.in[18]);
            p0_transpose_item(W, 1024, (bf16*)(ws + WS_WO3) + (size_t)b * 1024 * 512, 512, 0, scr, q / 32, q % 32, F.lane); continue; } r -= 3 * I_WO;
        if (r < I_SQ) { p0_transpose_item(a.in[19], 1024, (bf16*)(ws + WS_WOUT), 1024, 0, scr, r / 32, r % 32, F.lane); continue; } r -= I_SQ;
        if (r < I_SQ) { p0_transpose_item(a.in[15], 1024, (bf16*)(ws + WS_WKV), 1024, 0, scr, r / 32, r % 32, F.lane); continue; } r -= I_SQ;
        if (r < 2 * I_GU) { const int up = r / I_GU, q = r % I_GU, e = q / 256, qq = q % 256; const float* W = (up ? a.in[26] : a.in[25]) + (size_t)e * 1024 * 512;
            p0_transpose_item(W, 512, (bf16*)(ws + WS_WGU) + (size_t)e * 1024 * 1024, 1024, 2 + up, scr, qq / 16, qq % 16, F.lane); continue; } r -= 2 * I_GU;
        { const int e = r / 256, qq = r % 256; p0_transpose_item(a.in[27] + (size_t)e * 512 * 1024, 1024, (bf16*)(ws + WS_WDT) + (size_t)e * 1024 * 512, 512, 0, scr, qq / 32, qq % 32, F.lane); }
    }
    for (int m = gw; m < T; m += NGW) rms_row_to_bf16(F.lane, a.in[0] + (size_t)m * D, a.in[3], (bf16*)((unsigned char*)a.out + DO_H) + (size_t)m * D);
    for (int m = gw; m < 512; m += NGW) rms_row_to_bf16(F.lane, a.in[1] + (size_t)m * D, a.in[14], (bf16*)(ws + WS_MEMN) + (size_t)m * D);
    {
        const int* positions = (const int*)a.in[2]; float2* cs = (float2*)(ws + WS_CS);
        const int gt = F.vcu * 512 + F.tid, NT_ = F.G * 512;
        for (int idx = gt; idx < T * 32; idx += NT_) { const int t = idx >> 5, i = idx & 31;
            const float inv = 1.0f / powf(10000.f, (float)(2 * i) / 64.f); const float ang = (float)positions[t] * inv;
            double s, c; sincos((double)ang, &s, &c); cs[idx] = make_float2((float)c, (float)s); }
    }
}

struct SchedP1 {
    int G, c; const char* Ah; const char* W1; const char* Amem; const char* Wkv;
    __device__ __forceinline__ bool next(int i, pg8::Unit& u) const {
        const int L = i * G + c; u.ksplit = 1 << 30; u.ridx = nullptr;
        if (L < 64 * 21) { int pm, pn; pg8::static_tile(L, 64, 21, pm, pn); u.pm = pm; u.pn = pn; u.aux = 0; u.A = Ah + (size_t)pm * 256 * 2048; u.B0 = W1 + (size_t)pn * 256 * 2048; u.B1 = u.B0; return true; }
        const int j = L - 64 * 21; if (j >= 8) return false;
        u.pm = j & 1; u.pn = j >> 1; u.aux = 1; u.A = Amem + (size_t)u.pm * 256 * 2048; u.B0 = Wkv + (size_t)u.pn * 256 * 2048; u.B1 = u.B0; return true;
    }
};
__device__ __forceinline__ v4u pack8(const f32x4 a, const f32x4 b) { v4u w; w.x = pg8::cvt_pk_bf16(a[0], a[1]); w.y = pg8::cvt_pk_bf16(a[2], a[3]); w.z = pg8::cvt_pk_bf16(b[0], b[1]); w.w = pg8::cvt_pk_bf16(b[2], b[3]); return w; }
struct EpiP1 {
    static constexpr bool PERM = true;
    bf16 *q, *k, *v, *u, *xq, *gates, *mkv; const float2* cs; const float *gq, *gk;
    __device__ __forceinline__ void qk_rope(const f32x4 (&acc)[2][2][4][2], int row0, bf16* dst, int ld, int head, const float* g, int fq) const {
        f32x4 g1[2], g2[2];
#pragma unroll
        for (int n = 0; n < 2; ++n) { g1[n] = *(const f32x4*)(g + 8 * fq + 4 * n); g2[n] = *(const f32x4*)(g + 32 + 8 * fq + 4 * n); }
#pragma unroll
        for (int ai = 0; ai < 2; ++ai)
#pragma unroll
            for (int m = 0; m < 4; ++m) {
                const int row = row0 + ai * 128 + m * 16;
                float ss = 0.f;
#pragma unroll
                for (int bj = 0; bj < 2; ++bj)
#pragma unroll
                    for (int n = 0; n < 2; ++n) { const f32x4 x = acc[ai][bj][m][n]; ss += (x[0] * x[0] + x[1] * x[1]) + (x[2] * x[2] + x[3] * x[3]); }
                ss += __shfl_xor(ss, 16); ss += __shfl_xor(ss, 32);
                const float r = rsqrtf(ss * (1.f / 64.f) + 1e-6f);
                const f32x4* cp = (const f32x4*)(cs + (size_t)row * 32 + 8 * fq);
                f32x4 o1[2], o2[2];
#pragma unroll
                for (int n = 0; n < 2; ++n) { const f32x4 ca = cp[2 * n], cb = cp[2 * n + 1];
                    const f32x4 y1 = acc[ai][0][m][n] * r * g1[n], y2 = acc[ai][1][m][n] * r * g2[n];
                    o1[n] = (f32x4){y1[0] * ca[0] - y2[0] * ca[1], y1[1] * ca[2] - y2[1] * ca[3], y1[2] * cb[0] - y2[2] * cb[1], y1[3] * cb[2] - y2[3] * cb[3]};
                    o2[n] = (f32x4){y2[0] * ca[0] + y1[0] * ca[1], y2[1] * ca[2] + y1[1] * ca[3], y2[2] * cb[0] + y1[2] * cb[1], y2[3] * cb[2] + y1[3] * cb[3]}; }
                bf16* p = dst + (size_t)row * ld + head * 64 + 8 * fq;
                *(v4u*)p = pack8(o1[0], o1[1]); *(v4u*)(p + 32) = pack8(o2[0], o2[1]);
            }
    }
    __device__ __forceinline__ bool operator()(f32x4 (&acc)[2][2][4][2], const pg8::Unit& un, int wr, int wc, int fr, int fq) const {
        const int row0 = un.pm * 256 + wr * 64 + fr;
        if (un.aux == 1) {
#pragma unroll
            for (int ai = 0; ai < 2; ++ai)
#pragma unroll
                for (int m = 0; m < 4; ++m)
#pragma unroll
                    for (int bj = 0; bj < 2; ++bj) *(v4u*)(mkv + (size_t)(row0 + ai * 128 + m * 16) * 1024 + un.pn * 256 + bj * 128 + wc * 32 + 8 * fq) = pack8(acc[ai][bj][m][0], acc[ai][bj][m][1]);
            return true;
        }
        const int pn = un.pn;
        if (pn < 2) { qk_rope(acc, row0, q, 512, 4 * pn + wc, gq, fq); return true; }
        if (pn == 2) {
            if (wc < 2) { qk_rope(acc, row0, k, 128, wc, gk, fq); return true; }
#pragma unroll
            for (int ai = 0; ai < 2; ++ai)
#pragma unroll
                for (int m = 0; m < 4; ++m)
#pragma unroll
                    for (int bj = 0; bj < 2; ++bj) *(v4u*)(v + (size_t)(row0 + ai * 128 + m * 16) * 128 + (wc - 2) * 64 + bj * 32 + 8 * fq) = pack8(acc[ai][bj][m][0], acc[ai][bj][m][1]);
            return true;
        }
        if (pn < 7) {
#pragma unroll
            for (int ai = 0; ai < 2; ++ai)
#pragma unroll
                for (int m = 0; m < 4; ++m)
#pragma unroll
                    for (int bj = 0; bj < 2; ++bj) { const f32x4 av = acc[ai][bj][m][0], bv = acc[ai][bj][m][1];
                        v2u w; w.x = pg8::cvt_pk_bf16(av[0] * fsigmoid(bv[0]), av[1] * fsigmoid(bv[1])); w.y = pg8::cvt_pk_bf16(av[2] * fsigmoid(bv[2]), av[3] * fsigmoid(bv[3]));
                        *(v2u*)(u + (size_t)(row0 + ai * 128 + m * 16) * 512 + 128 * (pn - 3) + 64 * bj + 16 * wc + 4 * fq) = w; }
            return true;
        }
        if (pn < 9) {
#pragma unroll
            for (int ai = 0; ai < 2; ++ai)
#pragma unroll
                for (int m = 0; m < 4; ++m)
#pragma unroll
                    for (int bj = 0; bj < 2; ++bj) *(v4u*)(xq + (size_t)(row0 + ai * 128 + m * 16) * 512 + (pn - 7) * 256 + bj * 128 + wc * 32 + 8 * fq) = pack8(acc[ai][bj][m][0], acc[ai][bj][m][1]);
            return true;
        }
#pragma unroll
        for (int ai = 0; ai < 2; ++ai)
#pragma unroll
            for (int m = 0; m < 4; ++m)
#pragma unroll
                for (int bj = 0; bj < 2; ++bj) { f32x4 a0 = acc[ai][bj][m][0], a1 = acc[ai][bj][m][1];
#pragma unroll
                    for (int e = 0; e < 4; ++e) { a0[e] = fsigmoid(a0[e]); a1[e] = fsigmoid(a1[e]); }
                    *(v4u*)(gates + (size_t)(row0 + ai * 128 + m * 16) * 3072 + (pn - 9) * 256 + bj * 128 + wc * 32 + 8 * fq) = pack8(a0, a1); }
        return true;
    }
};

struct SchedP3 {
    int G, c; const char* acts; const char* Wo3;
    __device__ __forceinline__ bool next(int i, pg8::Unit& u) const {
        const int j = i / 3, b = i - 3 * j; const int L = j * G + c; int pm, pn;
        if (!pg8::static_tile(L, 64, 4, pm, pn)) return false;
        u.pm = pm; u.pn = pn; u.aux = b; u.ksplit = 1 << 30; u.ridx = nullptr;
        u.A = acts + (size_t)pm * 256 * 3072 + (size_t)b * 1024; u.B0 = Wo3 + (size_t)b * (1024 * 1024) + (size_t)pn * 256 * 1024; u.B1 = u.B0; return true;
    }
};
struct EpiP3 {
    static constexpr bool PERM = true;
    const bf16* gates; bf16* merged;
    __device__ __forceinline__ bool operator()(f32x4 (&acc)[2][2][4][2], const pg8::Unit& un, int wr, int wc, int fr, int fq) const {
        const int row0 = un.pm * 256 + wr * 64 + fr, b = un.aux;
#pragma unroll
        for (int ai = 0; ai < 2; ++ai)
#pragma unroll
            for (int m = 0; m < 4; ++m)
#pragma unroll
                for (int bj = 0; bj < 2; ++bj) {
                    const int row = row0 + ai * 128 + m * 16, col = un.pn * 256 + bj * 128 + wc * 32 + 8 * fq;
                    const v4u ga = *(const v4u*)(gates + (size_t)row * 3072 + b * 1024 + col);
                    f32x4 s0 = (f32x4){bflo(ga.x), bfhi(ga.x), bflo(ga.y), bfhi(ga.y)}, s1 = (f32x4){bflo(ga.z), bfhi(ga.z), bflo(ga.w), bfhi(ga.w)};
                    if (b < 2) { const v4u gb = *(const v4u*)(gates + (size_t)row * 3072 + (b + 1) * 1024 + col);
                        const f32x4 d0 = (f32x4){bflo(gb.x), bfhi(gb.x), bflo(gb.y), bfhi(gb.y)}, d1 = (f32x4){bflo(gb.z), bfhi(gb.z), bflo(gb.w), bfhi(gb.w)};
#pragma unroll
                        for (int e = 0; e < 4; ++e) { s0[e] *= __builtin_amdgcn_rcpf(fmaxf(d0[e], 1e-20f)); s1[e] *= __builtin_amdgcn_rcpf(fmaxf(d1[e], 1e-20f)); } }
                    acc[ai][bj][m][0] *= s0; acc[ai][bj][m][1] *= s1;
                    if (b == 2) *(v4u*)(merged + (size_t)row * 1024 + col) = pack8(acc[ai][bj][m][0], acc[ai][bj][m][1]);
                }
        return b == 2;
    }
};

struct SchedP4 {
    int G, c; const char* A; const char* W;
    __device__ __forceinline__ bool next(int i, pg8::Unit& u) const {
        const int L = i * G + c; int pm, pn; if (!pg8::static_tile(L, 64, 4, pm, pn)) return false;
        u.pm = pm; u.pn = pn; u.aux = 0; u.ksplit = 1 << 30; u.ridx = nullptr; u.A = A + (size_t)pm * 256 * 2048; u.B0 = W + (size_t)pn * 256 * 2048; u.B1 = u.B0; return true;
    }
};
struct EpiP4 {
    static constexpr bool PERM = false;
    const float* x; float* out;
    __device__ __forceinline__ bool operator()(f32x4 (&acc)[2][2][4][2], const pg8::Unit& un, int wr, int wc, int fr, int fq) const {
        const int row0 = un.pm * 256 + wr * 64 + fr, col0 = un.pn * 256 + wc * 32 + 4 * fq;
#pragma unroll
        for (int ai = 0; ai < 2; ++ai)
#pragma unroll
            for (int m = 0; m < 4; ++m) { const size_t off = (size_t)(row0 + ai * 128 + m * 16) * 1024 + col0;
#pragma unroll
                for (int bj = 0; bj < 2; ++bj)
#pragma unroll
                    for (int n = 0; n < 2; ++n) *(f32x4*)(out + off + bj * 128 + n * 16) = *(const f32x4*)(x + off + bj * 128 + n * 16) + acc[ai][bj][m][n]; }
        return true;
    }
};
constexpr int TB_CLS = TAB_OFF, TB_W = TAB_OFF + 256, TB_HIST = TAB_OFF + 768, TB_TOTAL = TAB_OFF + 896, TB_PREFIX = TAB_OFF + 1024, TB_CBASE = TAB_OFF + 1152, TB_TAB = TAB_OFF + 1280;
constexpr int MAX_RT = 88;
typedef float f32x2v __attribute__((ext_vector_type(2)));
__device__ __forceinline__ void route_token(const LAS float* lg, const float* bg, const float* br, int& cls, float& wa, float& wb) {
    float l0 = lg[0] + bg[0], l1 = lg[1] + bg[1], l2 = lg[2] + bg[2], l3 = lg[3] + bg[3];
    int gi = 0; float gm = l0;
    if (l1 > gm) { gm = l1; gi = 1; } if (l2 > gm) { gm = l2; gi = 2; } if (l3 > gm) { gm = l3; gi = 3; }
    const float pg = 1.f / (__expf(l0 - gm) + __expf(l1 - gm) + __expf(l2 - gm) + __expf(l3 - gm));
    const float e0 = lg[4 + gi * 4 + 0] + br[gi * 4 + 0], e1 = lg[4 + gi * 4 + 1] + br[gi * 4 + 1], e2 = lg[4 + gi * 4 + 2] + br[gi * 4 + 2], e3 = lg[4 + gi * 4 + 3] + br[gi * 4 + 3];
    int i1 = 0; float v1 = e0;
    if (e1 > v1) { v1 = e1; i1 = 1; } if (e2 > v1) { v1 = e2; i1 = 2; } if (e3 > v1) { v1 = e3; i1 = 3; }
    int i2 = -1; float v2 = -3.0e38f;
    if (i1 != 0 && e0 > v2) { v2 = e0; i2 = 0; } if (i1 != 1 && e1 > v2) { v2 = e1; i2 = 1; } if (i1 != 2 && e2 > v2) { v2 = e2; i2 = 2; } if (i1 != 3 && e3 > v2) { v2 = e3; i2 = 3; }
    const float q2 = __expf(v2 - v1), p1 = 1.f / (1.f + q2), p2 = q2 * p1;
    const int a = i1 < i2 ? i1 : i2, b = i1 < i2 ? i2 : i1;
    wa = pg * (i1 < i2 ? p1 : p2); wb = pg * (i1 < i2 ? p2 : p1);
    cls = gi * 6 + (a * (7 - a)) / 2 + (b - a - 1);
}
__device__ __forceinline__ void p5_router(Frame& F, const Args& a) {
    LAS float* Wl = (LAS float*)(F.lds + RING_OFF);
    const float* wg = a.in[21]; const float* wrt = a.in[23];
    for (int e = F.tid; e < 20 * 1024; e += NWAVES * 64) { const int n = e >> 10, k = e & 1023; Wl[e] = n < 4 ? wg[k * 4 + n] : wrt[k * 16 + (n - 4)]; }
    LAS int* hist = (LAS int*)(F.lds + TB_HIST); LAS int* clsl = (LAS int*)(F.lds + TB_CLS); LAS f32x2v* wl = (LAS f32x2v*)(F.lds + TB_W);
    if (F.tid < 32) hist[F.tid] = 0;
    __syncthreads();
    unsigned char* ws = a.ws; const float* xm = a.out; const float* g2 = a.in[20];
    bf16* h2 = (bf16*)(ws + WS_H2); int* clsg = (int*)(ws + WS_ROUTE + RT_CLS); float2* wgl = (float2*)(ws + WS_ROUTE + RT_W);
    const int lane = F.lane;
    f32x4 g2v[4];
#pragma unroll
    for (int j = 0; j < 4; ++j) g2v[j] = *(const f32x4*)(g2 + 4 * (lane + 64 * j));
    for (int grp = 0; grp < 4; ++grp) {
        const int tl0 = F.wave * 8 + grp * 2, t0 = blockIdx.x * 64 + tl0;
        f32x4 hv[2][4];
#pragma unroll
        for (int tk = 0; tk < 2; ++tk) {
            const f32x4* xr = (const f32x4*)(xm + (size_t)(t0 + tk) * 1024); float ss = 0.f;
#pragma unroll
            for (int j = 0; j < 4; ++j) { hv[tk][j] = xr[lane + 64 * j]; const f32x4 v = hv[tk][j]; ss += (v[0] * v[0] + v[1] * v[1]) + (v[2] * v[2] + v[3] * v[3]); }
            const float r = rsqrtf(wave_sum(ss) * (1.f / 1024.f) + 1e-6f);
            unsigned long long* o8 = (unsigned long long*)(h2 + (size_t)(t0 + tk) * 1024) + lane;
#pragma unroll
            for (int j = 0; j < 4; ++j) { hv[tk][j] = hv[tk][j] * r * g2v[j]; const f32x4 v = hv[tk][j];
                o8[64 * j] = (unsigned long long)pg8::cvt_pk_bf16(v[0], v[1]) | ((unsigned long long)pg8::cvt_pk_bf16(v[2], v[3]) << 32); }
        }
        LAS float* lgl = (LAS float*)(F.lds + RING_OFF + 81920) + F.wave * 64;
#pragma unroll
        for (int n = 0; n < 20; ++n) {
            f32x4 w[4];
#pragma unroll
            for (int j = 0; j < 4; ++j) w[j] = *(const LAS f32x4*)(Wl + n * 1024 + 4 * (lane + 64 * j));
#pragma unroll
            for (int tk = 0; tk < 2; ++tk) { float p = 0.f;
#pragma unroll
                for (int j = 0; j < 4; ++j) { const f32x4 v = hv[tk][j] * w[j]; p += (v[0] + v[1]) + (v[2] + v[3]); }
                p = wave_sum(p); if (lane == 0) lgl[tk * 20 + n] = p; }
        }
        LDS_WAIT(); asm volatile("" ::: "memory");
#pragma unroll
        for (int tk = 0; tk < 2; ++tk)
            if (lane == tk) { int cls; float wa, wb; route_token(lgl + tk * 20, a.in[22], a.in[24], cls, wa, wb);
                clsg[t0 + tk] = cls; wgl[t0 + tk] = make_float2(wa, wb); clsl[tl0 + tk] = cls; wl[tl0 + tk] = (f32x2v){wa, wb};
                __hip_atomic_fetch_add(hist + cls, 1, __ATOMIC_RELAXED, __HIP_MEMORY_SCOPE_WORKGROUP); }
    }
    __syncthreads();
    if (F.tid < 32) ((int*)(ws + WS_ROUTE + RT_CNT))[blockIdx.x * 32 + F.tid] = hist[F.tid];
}
__device__ __forceinline__ void p6_slots(Frame& F, const Args& a) {
    unsigned char* ws = a.ws; const int* cnt = (const int*)(ws + WS_ROUTE + RT_CNT); int* rtok = (int*)(ws + WS_ROUTE + RT_TOK); float2* sw = (float2*)(ws + WS_ROUTE + RT_SW);
    LAS int* total = (LAS int*)(F.lds + TB_TOTAL); LAS int* prefix = (LAS int*)(F.lds + TB_PREFIX); LAS int* cbase = (LAS int*)(F.lds + TB_CBASE); LAS int* tab = (LAS int*)(F.lds + TB_TAB);
    LAS int* clsl = (LAS int*)(F.lds + TB_CLS); LAS f32x2v* wl = (LAS f32x2v*)(F.lds + TB_W);
    if (F.tid < 32) { total[F.tid] = 0; prefix[F.tid] = 0; }
    __syncthreads();
    const int me = blockIdx.x;
    for (int e = F.tid; e < F.G * 32; e += NWAVES * 64) { const int w = e >> 5, c = e & 31; if (c < 24) { const int v = cnt[e];
        if (v) { __hip_atomic_fetch_add(total + c, v, __ATOMIC_RELAXED, __HIP_MEMORY_SCOPE_WORKGROUP); if (w < me) __hip_atomic_fetch_add(prefix + c, v, __ATOMIC_RELAXED, __HIP_MEMORY_SCOPE_WORKGROUP); } } }
    __syncthreads();
    if (F.tid == 0) { int tb = 0;
        for (int c = 0; c < 24; ++c) { const int nt_ = (total[c] + 255) >> 8; cbase[c] = tb * 256; for (int r = 0; r < nt_; ++r) tab[1 + tb + r] = c; tb += nt_; }
        tab[0] = tb; }
    __syncthreads();
    if (F.tid < 64) { const int j = F.tid, c = clsl[j]; int rank = 0;
        for (int q = 0; q < j; ++q) rank += (clsl[q] == c) ? 1 : 0;
        const int slot = cbase[c] + prefix[c] + rank; rtok[slot] = me * 64 + j; const f32x2v ww = wl[j]; sw[slot] = make_float2(ww.x, ww.y); }
    if (me < 24) { const int c = me, lo = cbase[c] + total[c], hi = cbase[c] + (((total[c] + 255) >> 8) << 8);
        for (int s = lo + F.tid; s < hi; s += NWAVES * 64) { rtok[s] = -1; sw[s] = make_float2(0.f, 0.f); } }
}
__device__ __forceinline__ void class_experts(int c, int& ea, int& eb) {
    const int g = c / 6, p = c - 6 * g; const int a = p < 3 ? 0 : (p < 5 ? 1 : 2), b = p < 3 ? p + 1 : (p < 5 ? p - 1 : 3); ea = g * 4 + a; eb = g * 4 + b;
}
struct SchedP7 {
    int G, vcu; const LAS int* tab; const char* h2; const char* Wgu; const int* rtok;
    __device__ __forceinline__ bool next(int i, pg8::Unit& u) const {
        const int L = i * G + vcu, R = tab[0]; if (L >= R * 8) return false;
        const int r = L >> 3, pn = L & 7; int ea, eb; class_experts(tab[1 + r], ea, eb); const int e = pn < 4 ? ea : eb;
        u.pm = r; u.pn = pn; u.aux = 0; u.ksplit = 1 << 30; u.A = h2; u.ridx = rtok + 256 * r;
        u.B0 = Wgu + (size_t)e * (1024 * 2048) + (size_t)(pn & 3) * 256 * 2048; u.B1 = u.B0; return true;
    }
};
struct EpiP7 {
    static constexpr bool PERM = true;
    bf16* hid; const float2* sw;
    __device__ __forceinline__ bool operator()(f32x4 (&acc)[2][2][4][2], const pg8::Unit& un, int wr, int wc, int fr, int fq) const {
        const int slot0 = un.pm * 256 + wr * 64 + fr, sel = un.pn >> 2, col0 = sel * 512 + 128 * (un.pn & 3) + 16 * wc + 4 * fq;
#pragma unroll
        for (int ai = 0; ai < 2; ++ai)
#pragma unroll
            for (int m = 0; m < 4; ++m) { const int slot = slot0 + ai * 128 + m * 16; const float2 w2 = sw[slot]; const float w = sel ? w2.y : w2.x;
#pragma unroll
                for (int bj = 0; bj < 2; ++bj) { const f32x4 gv = acc[ai][bj][m][0], uv = acc[ai][bj][m][1]; f32x4 hh;
#pragma unroll
                    for (int e = 0; e < 4; ++e) hh[e] = gv[e] * fsigmoid(gv[e]) * uv[e] * w;
                    v2u o; o.x = pg8::cvt_pk_bf16(hh[0], hh[1]); o.y = pg8::cvt_pk_bf16(hh[2], hh[3]);
                    *(v2u*)(hid + (size_t)slot * 1024 + col0 + 64 * bj) = o; } }
        return true;
    }
};
struct SchedP8 {
    int G, vcu; const LAS int* tab; const char* hid; const char* WdT;
    __device__ __forceinline__ bool next(int i, pg8::Unit& u) const {
        const int L = i * G + vcu, R = tab[0]; if (L >= R * 4) return false;
        const int r = L >> 2, pn = L & 3; int ea, eb; class_experts(tab[1 + r], ea, eb);
        u.pm = r; u.pn = pn; u.aux = 0; u.ksplit = 8; u.A = hid + (size_t)r * 256 * 2048; u.ridx = nullptr;
        u.B0 = WdT + (size_t)ea * (1024 * 1024) + (size_t)pn * 256 * 1024; u.B1 = WdT + (size_t)eb * (1024 * 1024) + (size_t)pn * 256 * 1024; return true;
    }
};
struct EpiP8 {
    static constexpr bool PERM = false;
    const int* rtok; float* out;
    __device__ __forceinline__ bool operator()(f32x4 (&acc)[2][2][4][2], const pg8::Unit& un, int wr, int wc, int fr, int fq) const {
        const int slot0 = un.pm * 256 + wr * 64 + fr, col0 = un.pn * 256 + wc * 32 + 4 * fq;
#pragma unroll
        for (int ai = 0; ai < 2; ++ai)
#pragma unroll
            for (int m = 0; m < 4; ++m) { const int tok = rtok[slot0 + ai * 128 + m * 16];
                if (tok >= 0) { float* p = out + (size_t)tok * 1024 + col0;
#pragma unroll
                    for (int bj = 0; bj < 2; ++bj)
#pragma unroll
                        for (int n = 0; n < 2; ++n) { f32x4* q = (f32x4*)(p + bj * 128 + n * 16); *q = *q + acc[ai][bj][m][n]; } } }
        return true;
    }
};
constexpr int KST64 = 144, KST128 = 272, VST = 528;
template <int DH, bool SWA>
__device__ __forceinline__ void attn256_mtile(const LAS unsigned char* Kl, const LAS unsigned char* Vl, const bf16* qrow0, int ldq, bf16* orow0, int ldo,
                                              float sink_l2, int i0, bool has_prev, int lane) {
    constexpr int KST = DH * 2 + 16, NKS = DH / 32, NDT = DH / 16;
    const int qi = lane & 15, g = lane >> 4;
    bf16x8 qf[NKS]; float ssq = 0.f;
#pragma unroll
    for (int ks = 0; ks < NKS; ++ks) { qf[ks] = *(const bf16x8*)(qrow0 + (size_t)qi * ldq + 8 * g + 32 * ks);
        if (!SWA) {
#pragma unroll
            for (int e = 0; e < 8; ++e) { const float x = bf2f((bf16)qf[ks][e]); ssq += x * x; } } }
    float sc;
    if (SWA) sc = 0.125f * 1.4426950408889634f;
    else { ssq += __shfl_xor(ssq, 16); ssq += __shfl_xor(ssq, 32); sc = rsqrtf(ssq * (1.f / 128.f) + 1e-6f) * (0.08838834764831845f * 1.4426950408889634f); }
    f32x4 sacc[8][2];
    const int krow = 8 * (qi >> 2) + (qi & 3);
#pragma unroll
    for (int s = 0; s < 8; ++s)
#pragma unroll
        for (int h = 0; h < 2; ++h) { f32x4 c = (f32x4){0.f, 0.f, 0.f, 0.f}; const LAS unsigned char* kp = Kl + (32 * s + krow + 4 * h) * KST + 16 * g;
#pragma unroll
            for (int ks = 0; ks < NKS; ++ks) c = __builtin_amdgcn_mfma_f32_16x16x32_bf16(*(const LAS bf16x8*)(kp + 64 * ks), qf[ks], c, 0, 0, 0);
            sacc[s][h] = c; __builtin_amdgcn_sched_barrier(0); }
    float m = SWA ? sink_l2 : -3.0e38f;
#pragma unroll
    for (int s = 0; s < 8; ++s)
#pragma unroll
        for (int h = 0; h < 2; ++h)
#pragma unroll
            for (int r = 0; r < 4; ++r) { float v = sacc[s][h][r] * sc;
                if (SWA) { const int kb = 32 * s + 8 * g + 4 * h + r, delta = 128 + i0 + qi - kb; const bool ok = (delta >= 0) && (delta < 128) && (has_prev || kb >= 128); v = ok ? v : -1.0e30f; }
                sacc[s][h][r] = v; m = fmaxf(m, v); }
    m = fmaxf(m, __shfl_xor(m, 16)); m = fmaxf(m, __shfl_xor(m, 32));
    float sum = 0.f;
#pragma unroll
    for (int s = 0; s < 8; ++s)
#pragma unroll
        for (int h = 0; h < 2; ++h)
#pragma unroll
            for (int r = 0; r < 4; ++r) { const float p = __builtin_amdgcn_exp2f(sacc[s][h][r] - m); sacc[s][h][r] = p; sum += p; }
    sum += __shfl_xor(sum, 16); sum += __shfl_xor(sum, 32);
    if (SWA) sum += __builtin_amdgcn_exp2f(sink_l2 - m);
    const float inv = 1.f / sum;
    bf16x8 pf[8];
#pragma unroll
    for (int s = 0; s < 8; ++s) { v4u w; w.x = pg8::cvt_pk_bf16(sacc[s][0][0], sacc[s][0][1]); w.y = pg8::cvt_pk_bf16(sacc[s][0][2], sacc[s][0][3]);
        w.z = pg8::cvt_pk_bf16(sacc[s][1][0], sacc[s][1][1]); w.w = pg8::cvt_pk_bf16(sacc[s][1][2], sacc[s][1][3]); pf[s] = __builtin_bit_cast(bf16x8, w); }
#pragma unroll
    for (int dt = 0; dt < NDT; ++dt) { f32x4 o = (f32x4){0.f, 0.f, 0.f, 0.f}; const LAS unsigned char* vp = Vl + (16 * dt + qi) * VST + 16 * g;
#pragma unroll
        for (int s = 0; s < 8; ++s) o = __builtin_amdgcn_mfma_f32_16x16x32_bf16(*(const LAS bf16x8*)(vp + 64 * s), pf[s], o, 0, 0, 0);
        v2u w; w.x = pg8::cvt_pk_bf16(o[0] * inv, o[1] * inv); w.y = pg8::cvt_pk_bf16(o[2] * inv, o[3] * inv);
        *(v2u*)(orow0 + (size_t)qi * ldo + 16 * dt + 4 * g) = w; __builtin_amdgcn_sched_barrier(0); }
}
template <int DH>
__device__ __forceinline__ void stage_vt(LAS unsigned char* Vl, const bf16* vsrc, int ldv, int kmin, int tid) {
    constexpr int NC = DH / 8;
#pragma unroll
    for (int i = 0; i < (128 * NC) / 512; ++i) { const int id = tid + 512 * i, c = id % NC, kp = id / NC;
        v4u a = (v4u){0u, 0u, 0u, 0u}, b = a;
        if (2 * kp >= kmin) { a = *(const v4u*)(vsrc + (size_t)(2 * kp) * ldv + 8 * c); b = *(const v4u*)(vsrc + (size_t)(2 * kp + 1) * ldv + 8 * c); }
        LAS unsigned char* dst = Vl + (8 * c) * VST + 4 * kp;
        const unsigned aw[4] = {a.x, a.y, a.z, a.w}, bw[4] = {b.x, b.y, b.z, b.w};
#pragma unroll
        for (int e = 0; e < 4; ++e) { *(LAS unsigned*)(dst + (2 * e) * VST) = (aw[e] & 0xffffu) | (bw[e] << 16); *(LAS unsigned*)(dst + (2 * e + 1) * VST) = (aw[e] >> 16) | (bw[e] & 0xffff0000u); } }
}
__device__ __forceinline__ void swa_unit(Frame& F, const Args& a, int u) {
    const int hk = u & 1, n = (u >> 1) & 63, b = u >> 7;
    unsigned char* dout = (unsigned char*)a.out;
    const bf16* q = (const bf16*)(dout + DO_Q); const bf16* k = (const bf16*)(dout + DO_K); const bf16* v = (const bf16*)(dout + DO_V); bf16* acts = (bf16*)(a.ws + WS_ACTS);
    LAS unsigned char* Kl = F.lds; LAS unsigned char* Vl = F.lds + 256 * KST64;
    const int rowb = b * SEQ + 128 * (n - 1), kmin = (n == 0) ? 128 : 0;
#pragma unroll
    for (int i = 0; i < 4; ++i) { const int id = F.tid + 512 * i, key = id >> 3, c = id & 7; v4u w = (v4u){0u, 0u, 0u, 0u};
        if (key >= kmin) w = *(const v4u*)(k + ((long)(rowb + key) * 128 + hk * 64 + 8 * c));
        *(LAS v4u*)(Kl + key * KST64 + 16 * c) = w; }
    stage_vt<64>(Vl, v + ((long)rowb * 128 + hk * 64), 128, kmin, F.tid);
    __syncthreads();
    const int hq = 4 * hk + (F.wave >> 1), r0 = 64 * (F.wave & 1);
    const float sink_l2 = a.in[7][hq] * 1.4426950408889634f;
#pragma unroll 1
    for (int mt = 0; mt < 4; ++mt) { const int i0 = r0 + 16 * mt; const size_t tok0 = (size_t)b * SEQ + 128 * n + i0;
        attn256_mtile<64, true>(Kl, Vl, q + tok0 * 512 + hq * 64, 512, acts + tok0 * 1536 + hq * 64, 1536, sink_l2, i0, n > 0, F.lane); }
    __syncthreads();
}
__device__ __forceinline__ void xattn_unit(Frame& F, const Args& a, int u) {
    const int qb = u & 31, h = (u >> 5) & 3, b = u >> 7;
    const bf16* mkv = (const bf16*)(a.ws + WS_MKV); const bf16* xq = (const bf16*)(a.ws + WS_XQ); bf16* acts = (bf16*)(a.ws + WS_ACTS);
    LAS unsigned char* Kl = F.lds; LAS unsigned char* Vl = F.lds + 256 * KST128;
    { const int c = F.tid & 15; const f32x4 ga = *(const f32x4*)(a.in[17] + 8 * c), gb = *(const f32x4*)(a.in[17] + 8 * c + 4), qa = *(const f32x4*)(a.in[16] + 8 * c), qc = *(const f32x4*)(a.in[16] + 8 * c + 4);
      const f32x4 g0 = ga * qa, g1 = gb * qc;
#pragma unroll
      for (int i = 0; i < 8; ++i) { const int key = (F.tid >> 4) + 32 * i; const v4u w = *(const v4u*)(mkv + (size_t)(b * 256 + key) * 1024 + h * 128 + 8 * c);
          f32x4 x0 = (f32x4){bflo(w.x), bfhi(w.x), bflo(w.y), bfhi(w.y)}, x1 = (f32x4){bflo(w.z), bfhi(w.z), bflo(w.w), bfhi(w.w)};
          float ss = (x0[0] * x0[0] + x0[1] * x0[1]) + (x0[2] * x0[2] + x0[3] * x0[3]) + (x1[0] * x1[0] + x1[1] * x1[1]) + (x1[2] * x1[2] + x1[3] * x1[3]);
          ss += __shfl_xor(ss, 1); ss += __shfl_xor(ss, 2); ss += __shfl_xor(ss, 4); ss += __shfl_xor(ss, 8);
          const float r = rsqrtf(ss * (1.f / 128.f) + 1e-6f); x0 = x0 * r * g0; x1 = x1 * r * g1;
          *(LAS v4u*)(Kl + key * KST128 + 16 * c) = pack8(x0, x1); } }
    stage_vt<128>(Vl, mkv + (size_t)(b * 256) * 1024 + 512 + h * 128, 1024, 0, F.tid);
    __syncthreads();
#pragma unroll 1
    for (int mt = 0; mt < 2; ++mt) { const size_t tok0 = (size_t)b * SEQ + 256 * qb + 32 * F.wave + 16 * mt;
        attn256_mtile<128, false>(Kl, Vl, xq + tok0 * 512 + h * 128, 512, acts + tok0 * 1536 + 1024 + h * 128, 1536, 0.f, 0, true, F.lane); }
    __syncthreads();
}
__device__ __forceinline__ void conv_unit(Frame& F, const Args& a, int cu) {
    const bf16* u = (const bf16*)(a.ws + WS_U); bf16* acts = (bf16*)(a.ws + WS_ACTS);
    LAS unsigned char* Ul = F.lds; LAS float* Yl = (LAS float*)(F.lds + 62 * 1024);
    const int t0 = 32 * cu, s0 = t0 & (SEQ - 1);
    for (int id = F.tid; id < 62 * 64; id += 512) { const int j = id >> 6, c = id & 63; v4u w = (v4u){0u, 0u, 0u, 0u};
        if (s0 - 30 + j >= 0) w = *(const v4u*)(u + (size_t)(t0 - 30 + j) * 512 + 8 * c);
        *(LAS v4u*)(Ul + j * 1024 + 16 * c) = w; }
    __syncthreads();
    { const int cp = F.tid & 255, th = F.tid >> 8;
      const float* wdw = a.in[9]; const float2 bias = *(const float2*)(a.in[10] + 2 * cp);
      float2 w[31];
#pragma unroll
      for (int j = 0; j < 31; ++j) w[j] = *(const float2*)(wdw + j * 512 + 2 * cp);
#pragma unroll 1
      for (int ch = 0; ch < 2; ++ch) { const int i0 = 16 * th + 8 * ch;
          float acc0[8], acc1[8];
#pragma unroll
          for (int i = 0; i < 8; ++i) { acc0[i] = bias.x; acc1[i] = bias.y; }
#pragma unroll
          for (int r = 0; r < 38; ++r) { const unsigned x = *(const LAS unsigned*)(Ul + (i0 + r) * 1024 + 4 * cp); const float x0 = bflo(x), x1 = bfhi(x);
#pragma unroll
              for (int i = 0; i < 8; ++i) { const int j = r - i; if (j >= 0 && j < 31) { acc0[i] += w[j].x * x0; acc1[i] += w[j].y * x1; } } }
#pragma unroll
          for (int i = 0; i < 8; ++i) *(LAS f32x2v*)(Yl + (i0 + i) * 512 + 2 * cp) = (f32x2v){acc0[i], acc1[i]}; }
    }
    __syncthreads();
    { const int lane = F.lane; const f32x4 ga = *(const f32x4*)(a.in[11] + 8 * lane), gb = *(const f32x4*)(a.in[11] + 8 * lane + 4), ba = *(const f32x4*)(a.in[12] + 8 * lane), bb = *(const f32x4*)(a.in[12] + 8 * lane + 4);
#pragma unroll 1
      for (int i = 0; i < 4; ++i) { const int tk = 4 * F.wave + i; const f32x4 y0 = *(const LAS f32x4*)(Yl + tk * 512 + 8 * lane), y1 = *(const LAS f32x4*)(Yl + tk * 512 + 8 * lane + 4);
          const float mean = wave_sum((y0[0] + y0[1]) + (y0[2] + y0[3]) + (y1[0] + y1[1]) + (y1[2] + y1[3])) * (1.f / 512.f);
          const f32x4 d0 = y0 - mean, d1 = y1 - mean;
          const float var = wave_sum((d0[0] * d0[0] + d0[1] * d0[1]) + (d0[2] * d0[2] + d0[3] * d0[3]) + (d1[0] * d1[0] + d1[1] * d1[1]) + (d1[2] * d1[2] + d1[3] * d1[3])) * (1.f / 512.f);
          const float rstd = rsqrtf(var + 1e-5f);
          f32x4 z0 = d0 * rstd * ga + ba, z1 = d1 * rstd * gb + bb;
#pragma unroll
          for (int e = 0; e < 4; ++e) { z0[e] = z0[e] * fsigmoid(z0[e]); z1[e] = z1[e] * fsigmoid(z1[e]); }
          *(v4u*)(acts + (size_t)(t0 + tk) * 1536 + 512 + 8 * lane) = pack8(z0, z1); } }
    __syncthreads();
}
__device__ __forceinline__ void p2_mixers(Frame& F, const Args& a) {
    for (int u = F.vcu; u < 256; u += F.G) swa_unit(F, a, u);
    for (int u = F.vcu; u < 256; u += F.G) xattn_unit(F, a, u);
    for (int cu = 2 * F.vcu; cu < 512; cu += 2 * F.G) { conv_unit(F, a, cu); conv_unit(F, a, cu + 1); }
}
__device__ __forceinline__ float sigmoidf_(float x) { return 1.f / (1.f + __expf(-x)); }
__device__ __forceinline__ bf16 f2bf16(float f) { return (bf16)f2bf(f); }
template <bool DUAL, class Epi>
__global__ void __launch_bounds__(256) n_gemm(const bf16* A, const float* B0, const float* B1, int lda, int ldb, int K, int pad, Epi epi) {
    __shared__ float As[16][65];
    __shared__ float Bs0[16][64];
    __shared__ float Bs1[16][64];
    const int tx = threadIdx.x & 15, ty = threadIdx.x >> 4;
    const int row0 = blockIdx.y * 64, col0 = blockIdx.x * 64;
    float acc0[4][4], acc1[4][4];
#pragma unroll
    for (int i = 0; i < 4; ++i)
#pragma unroll
        for (int j = 0; j < 4; ++j) { acc0[i][j] = 0.f; acc1[i][j] = 0.f; }
    for (int k0 = 0; k0 < K; k0 += 16) {
        { const int r = threadIdx.x >> 2, kk = (threadIdx.x & 3) * 4; const bf16* p = A + (size_t)(row0 + r) * lda + k0 + kk;
#pragma unroll
          for (int i = 0; i < 4; ++i) As[kk + i][r] = bf2f(p[i]); }
        { const int kk = threadIdx.x >> 4, c = (threadIdx.x & 15) * 4;
          const float4 b = *(const float4*)(B0 + (size_t)(k0 + kk) * ldb + col0 + c);
          Bs0[kk][c] = b.x; Bs0[kk][c + 1] = b.y; Bs0[kk][c + 2] = b.z; Bs0[kk][c + 3] = b.w;
          if (DUAL) { const float4 b1 = *(const float4*)(B1 + (size_t)(k0 + kk) * ldb + col0 + c);
              Bs1[kk][c] = b1.x; Bs1[kk][c + 1] = b1.y; Bs1[kk][c + 2] = b1.z; Bs1[kk][c + 3] = b1.w; } }
        __syncthreads();
#pragma unroll
        for (int kk = 0; kk < 16; ++kk) {
            float a[4], b[4], c1[4];
#pragma unroll
            for (int i = 0; i < 4; ++i) { a[i] = As[kk][ty * 4 + i]; b[i] = Bs0[kk][tx * 4 + i]; c1[i] = DUAL ? Bs1[kk][tx * 4 + i] : 0.f; }
#pragma unroll
            for (int i = 0; i < 4; ++i)
#pragma unroll
                for (int j = 0; j < 4; ++j) { acc0[i][j] += a[i] * b[j]; if (DUAL) acc1[i][j] += a[i] * c1[j]; }
        }
        __syncthreads();
    }
#pragma unroll
    for (int i = 0; i < 4; ++i)
#pragma unroll
        for (int j = 0; j < 4; ++j) epi(row0 + ty * 4 + i, col0 + tx * 4 + j, acc0[i][j], acc1[i][j]);
}
struct EpiBf { bf16* out; int ldo; int pad; __device__ void operator()(int r, int c, float a, float) const { out[(size_t)r * ldo + c] = f2bf16(a); } };
struct EpiF32 { float* out; int ldo; int pad; __device__ void operator()(int r, int c, float a, float) const { out[(size_t)r * ldo + c] = a; } };
struct EpiGlu { bf16* out; int ldo; int pad; __device__ void operator()(int r, int c, float a, float b) const { out[(size_t)r * ldo + c] = f2bf16(a * sigmoidf_(b)); } };
struct EpiSig { bf16* out; int ldo; int pad; __device__ void operator()(int r, int c, float a, float) const { out[(size_t)r * ldo + c] = f2bf16(sigmoidf_(a)); } };
struct EpiGate { const bf16* gates; float* merged; bf16* mbf; int mode; int pad;
    __device__ void operator()(int r, int c, float a, float) const {
        const float g = bf2f(gates[(size_t)r * 3072 + c]); float v = g * a; const size_t o = (size_t)r * 1024 + c;
        if (mode > 0) v += merged[o];
        if (mode < 2) merged[o] = v; else mbf[o] = f2bf16(v);
    } };
struct EpiRes { const float* x; float* out; __device__ void operator()(int r, int c, float a, float) const { const size_t o = (size_t)r * 1024 + c; out[o] = x[o] + a; } };

__global__ void n_rope_table(const int* positions, float2* cs) {
    const int idx = blockIdx.x * 256 + threadIdx.x; if (idx >= T * 32) return;
    const int t = idx >> 5, i = idx & 31;
    const float inv = 1.0f / powf(10000.f, (float)(2 * i) / 64.f);
    const float ang = (float)positions[t] * inv;
    double s, c; sincos((double)ang, &s, &c);
    cs[idx] = make_float2((float)c, (float)s);
}
__global__ void __launch_bounds__(256) n_qkprep(bf16* q, const float* g, const float2* cs, int nheads, int pad) {
    const int w = (blockIdx.x * 256 + threadIdx.x) >> 6, lane = threadIdx.x & 63;
    if (w >= T * nheads) return;
    const int t = w / nheads, h = w % nheads;
    bf16* p = q + (size_t)t * (nheads * 64) + h * 64;
    const float v = bf2f(p[lane]);
    const float ss = wave_sum(v * v);
    const float y = v * rsqrtf(ss * (1.f / 64.f) + 1e-6f) * g[lane];
    const float other = __shfl_xor(y, 32);
    const float2 c = cs[(size_t)t * 32 + (lane & 31)];
    const float o = (lane < 32) ? (y * c.x - other * c.y) : (y * c.x + other * c.y);
    p[lane] = f2bf16(o);
}
__global__ void __launch_bounds__(256) n_swa(const bf16* q, const bf16* k, const bf16* v, const float* sinks, bf16* out, int ldo, int pad) {
    const int w = (blockIdx.x * 256 + threadIdx.x) >> 6, lane = threadIdx.x & 63;
    if (w >= T * 8) return;
    const int t = w >> 3, h = w & 7, hk = h >> 2, s = t & (SEQ - 1);
    const bf16* qp = q + (size_t)t * 512 + h * 64;
    float sc[2];
#pragma unroll
    for (int j = 0; j < 2; ++j) {
        const int delta = lane + 64 * j, kp = s - delta;
        float a = -1e30f;
        if (kp >= 0) { const bf16* kr = k + (size_t)(t - delta) * 128 + hk * 64; a = 0.f;
            for (int d = 0; d < 64; ++d) a += bf2f(qp[d]) * bf2f(kr[d]);
            a *= 0.125f; }
        sc[j] = a;
    }
    const float sink = sinks[h];
    const float m = fmaxf(wave_max(fmaxf(sc[0], sc[1])), sink);
    const float p0 = __expf(sc[0] - m), p1 = __expf(sc[1] - m);
    const float den = wave_sum(p0 + p1) + __expf(sink - m);
    float o = 0.f;
    for (int j = 0; j < 2; ++j)
        for (int l = 0; l < 64; ++l) {
            const float p = __shfl(j == 0 ? p0 : p1, l); const int delta = l + 64 * j;
            if (s - delta >= 0) o += p * bf2f(v[(size_t)(t - delta) * 128 + hk * 64 + lane]);
        }
    out[(size_t)t * ldo + h * 64 + lane] = f2bf16(o / den);
}
__global__ void __launch_bounds__(512) n_conv_ln(const bf16* u, const float* w, const float* b, const float* g, const float* be, bf16* out, int ldo, int pad) {
    __shared__ float red[16];
    const int t = blockIdx.x, c = threadIdx.x, s = t & (SEQ - 1);
    float y = b[c];
    for (int j = 0; j < 31; ++j) { const int sp = s - 30 + j; if (sp >= 0) y += w[j * 512 + c] * bf2f(u[(size_t)(t - 30 + j) * 512 + c]); }
    float sm = wave_sum(y);
    if ((c & 63) == 0) red[c >> 6] = sm;
    __syncthreads();
    float mean = 0.f;
    for (int i = 0; i < 8; ++i) mean += red[i];
    mean *= (1.f / 512.f);
    const float dv = y - mean;
    float sq = wave_sum(dv * dv);
    if ((c & 63) == 0) red[8 + (c >> 6)] = sq;
    __syncthreads();
    float var = 0.f;
    for (int i = 0; i < 8; ++i) var += red[8 + i];
    var *= (1.f / 512.f);
    const float z = dv * rsqrtf(var + 1e-5f) * g[c] + be[c];
    out[(size_t)t * ldo + c] = f2bf16(z * sigmoidf_(z));
}
__global__ void __launch_bounds__(256) n_mkprep(const bf16* mkv, const float* g, float* mkn) {
    const int w = (blockIdx.x * 256 + threadIdx.x) >> 6, lane = threadIdx.x & 63;
    if (w >= 512 * 4) return;
    const int r = w >> 2, h = w & 3;
    const bf16* p = mkv + (size_t)r * 1024 + h * 128;
    const float a = bf2f(p[lane]), b2 = bf2f(p[lane + 64]);
    const float rr = rsqrtf(wave_sum(a * a + b2 * b2) * (1.f / 128.f) + 1e-6f);
    mkn[(size_t)r * 512 + h * 128 + lane] = a * rr * g[lane];
    mkn[(size_t)r * 512 + h * 128 + lane + 64] = b2 * rr * g[lane + 64];
}
__global__ void __launch_bounds__(256) n_xattn(const bf16* xq, const float* gxq, const float* mkn, const bf16* mkv, bf16* out, int ldo, int pad) {
    __shared__ float qs[4][128];
    const int wl = threadIdx.x >> 6, w = blockIdx.x * 4 + wl, lane = threadIdx.x & 63;
    const int t = w >> 2, h = w & 3, b = t / SEQ;
    const bf16* qp = xq + (size_t)t * 512 + h * 128;
    const float a = bf2f(qp[lane]), b2 = bf2f(qp[lane + 64]);
    const float rr = rsqrtf(wave_sum(a * a + b2 * b2) * (1.f / 128.f) + 1e-6f);
    qs[wl][lane] = a * rr * gxq[lane]; qs[wl][lane + 64] = b2 * rr * gxq[lane + 64];
    __syncthreads();
    float sc[4];
#pragma unroll
    for (int j = 0; j < 4; ++j) { const float* kr = mkn + (size_t)(b * 256 + lane + 64 * j) * 512 + h * 128; float s = 0.f;
        for (int d = 0; d < 128; ++d) s += qs[wl][d] * kr[d];
        sc[j] = s * 0.08838834764831845f; }
    const float m = wave_max(fmaxf(fmaxf(sc[0], sc[1]), fmaxf(sc[2], sc[3])));
    float p[4]; float ps = 0.f;
#pragma unroll
    for (int j = 0; j < 4; ++j) { p[j] = __expf(sc[j] - m); ps += p[j]; }
    const float den = wave_sum(ps);
    float o0 = 0.f, o1 = 0.f;
#pragma unroll
    for (int j = 0; j < 4; ++j)
        for (int l = 0; l < 64; ++l) { const float pp = __shfl(p[j], l); const bf16* vr = mkv + (size_t)(b * 256 + l + 64 * j) * 1024 + 512 + h * 128;
            o0 += pp * bf2f(vr[lane]); o1 += pp * bf2f(vr[lane + 64]); }
    out[(size_t)t * ldo + h * 128 + lane] = f2bf16(o0 / den); out[(size_t)t * ldo + h * 128 + lane + 64] = f2bf16(o1 / den);
}
__global__ void __launch_bounds__(256) n_router(const float* xm, const float* g2, const float* wg, const float* bg, const float* wr, const float* br, bf16* h2, int* eid, float* ew) {
    const int t = (blockIdx.x * 256 + threadIdx.x) >> 6, lane = threadIdx.x & 63;
    const float4* xr = (const float4*)(xm + (size_t)t * 1024);
    float hv[16]; float s = 0.f;
#pragma unroll
    for (int j = 0; j < 4; ++j) { const float4 v = xr[lane + 64 * j]; hv[4 * j] = v.x; hv[4 * j + 1] = v.y; hv[4 * j + 2] = v.z; hv[4 * j + 3] = v.w; s += v.x * v.x + v.y * v.y + v.z * v.z + v.w * v.w; }
    const float r = rsqrtf(wave_sum(s) * (1.f / 1024.f) + 1e-6f);
#pragma unroll
    for (int j = 0; j < 4; ++j)
#pragma unroll
        for (int i = 0; i < 4; ++i) { const int c = 4 * (lane + 64 * j) + i; hv[4 * j + i] = hv[4 * j + i] * r * g2[c]; h2[(size_t)t * 1024 + c] = f2bf16(hv[4 * j + i]); }
    float lg[20];
#pragma unroll
    for (int n = 0; n < 20; ++n) { float a = 0.f;
#pragma unroll
        for (int j = 0; j < 4; ++j)
#pragma unroll
            for (int i = 0; i < 4; ++i) { const int c = 4 * (lane + 64 * j) + i; a += hv[4 * j + i] * (n < 4 ? wg[c * 4 + n] : wr[c * 16 + (n - 4)]); }
        lg[n] = wave_sum(a) + (n < 4 ? bg[n] : br[n - 4]); }
    if (lane == 0) {
        int gi = 0; float gm = lg[0];
        for (int i = 1; i < 4; ++i) if (lg[i] > gm) { gm = lg[i]; gi = i; }
        float den = 0.f; for (int i = 0; i < 4; ++i) den += __expf(lg[i] - gm);
        const float pg = 1.f / den;
        float e[4]; for (int i = 0; i < 4; ++i) e[i] = lg[4 + gi * 4 + i];
        int i1 = 0; for (int i = 1; i < 4; ++i) if (e[i] > e[i1]) i1 = i;
        int i2 = -1; for (int i = 0; i < 4; ++i) if (i != i1 && (i2 < 0 || e[i] > e[i2])) i2 = i;
        const float q2 = __expf(e[i2] - e[i1]); const float p1 = 1.f / (1.f + q2), p2 = q2 / (1.f + q2);
        eid[2 * t] = gi * 4 + i1; eid[2 * t + 1] = gi * 4 + i2; ew[2 * t] = pg * p1; ew[2 * t + 1] = pg * p2;
    }
}
__global__ void __launch_bounds__(256) n_moe(const bf16* h2, const int* eid, const float* ew, const float* wgate, const float* wup, const float* wdown, float* out) {
    __shared__ float hs[1024]; __shared__ float hid[512];
    const int t = blockIdx.x, tid = threadIdx.x;
    for (int i = tid; i < 1024; i += 256) hs[i] = bf2f(h2[(size_t)t * 1024 + i]);
    __syncthreads();
    float y[4] = {0.f, 0.f, 0.f, 0.f};
    for (int s = 0; s < 2; ++s) {
        const int e = eid[2 * t + s]; const float cw = ew[2 * t + s];
        const float* G = wgate + (size_t)e * 1024 * 512; const float* U = wup + (size_t)e * 1024 * 512; const float* Dn = wdown + (size_t)e * 512 * 1024;
        float g0 = 0.f, g1 = 0.f, u0 = 0.f, u1 = 0.f;
        for (int k = 0; k < 1024; ++k) { const float hk = hs[k]; g0 += hk * G[k * 512 + tid]; g1 += hk * G[k * 512 + tid + 256]; u0 += hk * U[k * 512 + tid]; u1 += hk * U[k * 512 + tid + 256]; }
        __syncthreads();
        hid[tid] = g0 * sigmoidf_(g0) * u0 * cw; hid[tid + 256] = g1 * sigmoidf_(g1) * u1 * cw;
        __syncthreads();
        for (int j = 0; j < 512; ++j) { const float hj = hid[j];
#pragma unroll
            for (int i = 0; i < 4; ++i) y[i] += hj * Dn[(size_t)j * 1024 + tid + 256 * i]; }
    }
#pragma unroll
    for (int i = 0; i < 4; ++i) out[(size_t)t * 1024 + tid + 256 * i] += y[i];
}

__global__ void __launch_bounds__(NWAVES * 64, 2) mk_fwd(Args args) {
    extern __shared__ __attribute__((aligned(16))) unsigned char lds[];
    Frame F;
    F.lds = (LAS unsigned char*)lds;
    F.MISC = (volatile LAS unsigned*)(F.lds + MISC_OFF);
    F.tid = threadIdx.x; F.lane = F.tid & 63; F.wave = __builtin_amdgcn_readfirstlane(F.tid >> 6);
    F.G = gridDim.x; { const int bx = blockIdx.x; F.vcu = (F.G % 8 == 0) ? (bx % 8) * (F.G / 8) + bx / 8 : bx; }
    unsigned char* ws = args.ws;
    F.ctl = (gu32*)(ws + WS_CTL);
    for (int u = F.tid; u < (LDS_BYTES - LDSCTL_OFF) / 4; u += NWAVES * 64) ((LAS unsigned*)(F.lds + LDSCTL_OFF))[u] = 0u;
    __syncthreads();
    XcdBarrier bar = xcd_barrier_post((unsigned*)(F.ctl + CW_BAR) + args.li * XCD_BAR_WORDS, F.MISC + 8);
    const int lo = args.ph_lo, hi = args.ph_hi;
#define IN(k) (lo <= (k) && (k) < hi)
#define BOTH(k) (IN(k) && IN((k) + 1))
    unsigned char* dout = (unsigned char*)args.out;

    if (IN(0)) { p0_prologue(F, args); if (BOTH(0)) xcd_barrier(bar); }
    if (IN(1)) {
        SchedP1 S{F.G, (int)blockIdx.x, (const char*)(dout + DO_H), (const char*)(ws + WS_W1), (const char*)(ws + WS_MEMN), (const char*)(ws + WS_WKV)};
        EpiP1 E{(bf16*)(dout + DO_Q), (bf16*)(dout + DO_K), (bf16*)(dout + DO_V), (bf16*)(ws + WS_U), (bf16*)(ws + WS_XQ), (bf16*)(ws + WS_GATES), (bf16*)(ws + WS_MKV),
                (const float2*)(ws + WS_CS), args.in[5], args.in[6]};
        pg8::gemm_phase<EpiP1, SchedP1, true, false>(F.lds + RING_OFF, 16, 2048u, 2048u, S, E);
        if (BOTH(1)) xcd_barrier(bar);
    }
    if (IN(2)) { p2_mixers(F, args); if (BOTH(2)) xcd_barrier(bar); }
    if (IN(3)) {
        SchedP3 S{F.G, (int)blockIdx.x, (const char*)(ws + WS_ACTS), (const char*)(ws + WS_WO3)};
        EpiP3 E{(const bf16*)(ws + WS_GATES), (bf16*)(ws + WS_MERGED)};
        pg8::gemm_phase<EpiP3, SchedP3, true, false>(F.lds + RING_OFF, 8, 3072u, 1024u, S, E);
        if (BOTH(3)) xcd_barrier(bar);
    }
    if (IN(4)) {
        SchedP4 S{F.G, (int)blockIdx.x, (const char*)(ws + WS_MERGED), (const char*)(ws + WS_WOUT)};
        EpiP4 E{args.in[0], args.out};
        pg8::gemm_phase<EpiP4, SchedP4, true, false>(F.lds + RING_OFF, 16, 2048u, 2048u, S, E);
        if (BOTH(4)) xcd_barrier(bar);
    }
    if (IN(5)) { p5_router(F, args); if (BOTH(5)) xcd_barrier(bar); }
    if (IN(6)) { p6_slots(F, args); if (BOTH(6)) xcd_barrier(bar); }
    if (IN(7)) {
        SchedP7 S{F.G, F.vcu, (const LAS int*)(F.lds + TB_TAB), (const char*)(ws + WS_H2), (const char*)(ws + WS_WGU), (const int*)(ws + WS_ROUTE + RT_TOK)};
        EpiP7 E{(bf16*)(ws + WS_HID), (const float2*)(ws + WS_ROUTE + RT_SW)};
        pg8::gemm_phase<EpiP7, SchedP7, true, true>(F.lds + RING_OFF, 16, 2048u, 2048u, S, E);
        if (BOTH(7)) xcd_barrier(bar);
    }
    if (IN(8)) {
        SchedP8 S{F.G, F.vcu, (const LAS int*)(F.lds + TB_TAB), (const char*)(ws + WS_HID), (const char*)(ws + WS_WDT)};
        EpiP8 E{(const int*)(ws + WS_ROUTE + RT_TOK), args.out};
        pg8::gemm_phase<EpiP8, SchedP8, true, false>(F.lds + RING_OFF, 16, 2048u, 1024u, S, E);
    }
#undef IN
#undef BOTH
}

__global__ void n_check(const unsigned* ctl, float* out) {
    unsigned bad = 0; for (int li = 0; li < 3; ++li) bad |= ctl[CW_BAR + li * XCD_BAR_WORDS + XB_TMO];
    if (bad) out[threadIdx.x] = __builtin_nanf("");
}
__global__ void n_poison(const unsigned short* buf, size_t n, unsigned* flag) {
    size_t i = (size_t)blockIdx.x * 256 + threadIdx.x; const size_t st = (size_t)gridDim.x * 256; unsigned c = 0;
    for (; i < n; i += st) c += (buf[i] == 0xAAAAu);
    if (c) atomicAdd(flag, c);
}
__global__ void n_hash(const unsigned* buf, size_t nwords, unsigned long long* h) {
    size_t i = (size_t)blockIdx.x * 256 + threadIdx.x; const size_t st = (size_t)gridDim.x * 256; unsigned long long c = 0;
    for (; i < nwords; i += st) c += (unsigned long long)buf[i] * (2654435761ull + 2 * i);
    atomicAdd(h, c);
}
__global__ void n_hash_cmp(const unsigned long long* h, float* out) { if (h[0] != h[1]) out[threadIdx.x] = __builtin_nanf(""); }
__global__ void n_poison_report(const unsigned* flag, float* out) { if (*flag) out[threadIdx.x] = __builtin_nanf(""); }
static void launch_mk(Args a, int lo, int hi, int li, int grid, hipStream_t stream) {
    a.ph_lo = lo; a.ph_hi = hi; a.li = li; a.pad = 0;
    hipLaunchKernelGGL(mk_fwd, dim3(grid), dim3(NWAVES * 64), LDS_BYTES, stream, a);
}
extern "C" void kernel_launch(void* const* d_in, const int* in_sizes, int n_in, void* d_out, int out_size, void* d_ws, size_t ws_size, hipStream_t stream) {
    static int grid = 0;
    if (grid == 0) {
        int dev = 0, cus = 0, per_cu = 0;
        if (n_in != 28 || ws_size < WS_END || hipGetDevice(&dev) != hipSuccess || hipDeviceGetAttribute(&cus, hipDeviceAttributeMultiprocessorCount, dev) != hipSuccess) { fprintf(stderr, "kernel_launch: bad setup (n_in %d ws %zu)\n", n_in, ws_size); grid = -1; return; }
        if (hipFuncSetAttribute((const void*)mk_fwd, hipFuncAttributeMaxDynamicSharedMemorySize, LDS_BYTES) != hipSuccess) { fprintf(stderr, "kernel_launch: hipFuncSetAttribute failed\n"); grid = -1; return; }
        if (hipOccupancyMaxActiveBlocksPerMultiprocessor(&per_cu, (const void*)mk_fwd, NWAVES * 64, LDS_BYTES) != hipSuccess || per_cu < 1) { fprintf(stderr, "kernel_launch: occupancy query says %d\n", per_cu); per_cu = 1; }
        (void)hipGetLastError();
        grid = cus;
    }
    if (grid < 0) return;
    hipMemsetAsync((char*)d_ws + WS_CTL, 0, CTL_ZERO_BYTES, stream);
    Args a{};
    for (int i = 0; i < 28; ++i) a.in[i] = (const float*)d_in[i];
    a.out = (float*)d_out; a.ws = (unsigned char*)d_ws;
    unsigned char* ws = (unsigned char*)d_ws; unsigned char* dout = (unsigned char*)d_out; float* out = (float*)d_out;
    const float* sinks = a.in[7];
#if MK_LEVEL == 4
    launch_mk(a, 0, 9, 0, grid, stream);
#elif MK_LEVEL == 5
    launch_mk(a, 0, 3, 0, grid, stream);
    { bf16* acts = (bf16*)(ws + WS_ACTS); float* mkn = (float*)(ws + WS_ROUTE + 1 * MiB);
#if MK_MIXN & 1
    n_swa<<<T * 8 / 4, 256, 0, stream>>>((const bf16*)(dout + DO_Q), (const bf16*)(dout + DO_K), (const bf16*)(dout + DO_V), sinks, acts, 1536, 0);
#endif
#if MK_MIXN & 2
    n_conv_ln<<<T, 512, 0, stream>>>((const bf16*)(ws + WS_U), a.in[9], a.in[10], a.in[11], a.in[12], acts + 512, 1536, 0);
#endif
#if MK_MIXN & 4
    n_mkprep<<<512 * 4 / 4, 256, 0, stream>>>((const bf16*)(ws + WS_MKV), a.in[17], mkn);
    n_xattn<<<T * 4 / 4, 256, 0, stream>>>((const bf16*)(ws + WS_XQ), a.in[16], mkn, (const bf16*)(ws + WS_MKV), acts + 1024, 1536, 0);
#endif
    }
    launch_mk(a, 3, 9, 1, grid, stream);
    n_check<<<1, 64, 0, stream>>>((const unsigned*)(ws + WS_CTL), out);
#endif
#if MK_LEVEL >= 1 && MK_LEVEL <= 3
#if MK_SPLIT01
    launch_mk(a, 0, 1, 0, grid, stream); launch_mk(a, 1, 2, 2, grid, stream);
#else
    launch_mk(a, 0, 2, 0, grid, stream);
#endif
#ifdef MK_OVR
    {
        const bf16* hh = (const bf16*)(dout + DO_H); const float* w_in = a.in[4]; float2* cs2 = (float2*)(ws + WS_ROUTE + 2 * MiB - 0);
        bf16* qq = (bf16*)(dout + DO_Q); bf16* kk = (bf16*)(dout + DO_K); bf16* vv = (bf16*)(dout + DO_V);
        if (MK_OVR & 1) { n_gemm<false, EpiBf><<<dim3(512 / 64, T / 64), 256, 0, stream>>>(hh, w_in + 0, nullptr, 1024, INW, 1024, 0, EpiBf{qq, 512, 0});
                          n_qkprep<<<T * 8 / 4, 256, 0, stream>>>(qq, a.in[5], (const float2*)(ws + WS_CS), 8, 0); }
        if (MK_OVR & 2) { n_gemm<false, EpiBf><<<dim3(128 / 64, T / 64), 256, 0, stream>>>(hh, w_in + 512, nullptr, 1024, INW, 1024, 0, EpiBf{kk, 128, 0});
                          n_qkprep<<<T * 2 / 4, 256, 0, stream>>>(kk, a.in[6], (const float2*)(ws + WS_CS), 2, 0); }
        if (MK_OVR & 4) n_gemm<false, EpiBf><<<dim3(128 / 64, T / 64), 256, 0, stream>>>(hh, w_in + 640, nullptr, 1024, INW, 1024, 0, EpiBf{vv, 128, 0});
        if (MK_OVR & 8) n_gemm<true, EpiGlu><<<dim3(512 / 64, T / 64), 256, 0, stream>>>(hh, w_in + 768, w_in + 1280, 1024, INW, 1024, 0, EpiGlu{(bf16*)(ws + WS_U), 512, 0});
        if (MK_OVR & 16) n_gemm<false, EpiBf><<<dim3(512 / 64, T / 64), 256, 0, stream>>>(hh, w_in + 1792, nullptr, 1024, INW, 1024, 0, EpiBf{(bf16*)(ws + WS_XQ), 512, 0});
        if (MK_OVR & 32) n_gemm<false, EpiSig><<<dim3(3072 / 64, T / 64), 256, 0, stream>>>(hh, w_in + 2304, nullptr, 1024, INW, 1024, 0, EpiSig{(bf16*)(ws + WS_GATES), 3072, 0});
        if (MK_OVR & 64) n_gemm<false, EpiBf><<<dim3(1024 / 64, 512 / 64), 256, 0, stream>>>((const bf16*)(ws + WS_MEMN), a.in[15], nullptr, 1024, 1024, 1024, 0, EpiBf{(bf16*)(ws + WS_MKV), 1024, 0});
    }
#endif
#ifdef MK_HASH
    {   unsigned long long* hh = (unsigned long long*)(ws + WS_CTL) + 40;
#if MK_HASH == 2
        n_hash<<<2048, 256, 0, stream>>>((const unsigned*)(dout + DO_H), (size_t)T * 1024 / 2, hh);
        n_hash<<<2048, 256, 0, stream>>>((const unsigned*)(ws + WS_W1), (size_t)5376 * 1024 / 2, hh);
        n_hash<<<2048, 256, 0, stream>>>((const unsigned*)(ws + WS_CS), (size_t)T * 64, hh);
        launch_mk(a, 1, 2, 2, grid, stream);
        n_hash<<<2048, 256, 0, stream>>>((const unsigned*)(dout + DO_H), (size_t)T * 1024 / 2, hh + 1);
        n_hash<<<2048, 256, 0, stream>>>((const unsigned*)(ws + WS_W1), (size_t)5376 * 1024 / 2, hh + 1);
        n_hash<<<2048, 256, 0, stream>>>((const unsigned*)(ws + WS_CS), (size_t)T * 64, hh + 1);
#else
        n_hash<<<2048, 256, 0, stream>>>((const unsigned*)(ws + WS_GATES), (size_t)T * 3072 / 2, hh);
        launch_mk(a, 1, 2, 2, grid, stream);
        n_hash<<<2048, 256, 0, stream>>>((const unsigned*)(ws + WS_GATES), (size_t)T * 3072 / 2, hh + 1);
#endif
    }
#endif
#ifdef MK_POISON
    n_poison<<<2048, 256, 0, stream>>>((const unsigned short*)(ws + WS_GATES), (size_t)T * 3072, (unsigned*)(ws + WS_CTL) + 64);
#endif
    bf16* acts = (bf16*)(ws + WS_ACTS); float* mkn = (float*)(ws + WS_ROUTE + 1 * MiB);
    n_swa<<<T * 8 / 4, 256, 0, stream>>>((const bf16*)(dout + DO_Q), (const bf16*)(dout + DO_K), (const bf16*)(dout + DO_V), sinks, acts, 1536, 0);
    n_conv_ln<<<T, 512, 0, stream>>>((const bf16*)(ws + WS_U), a.in[9], a.in[10], a.in[11], a.in[12], acts + 512, 1536, 0);
    n_mkprep<<<512 * 4 / 4, 256, 0, stream>>>((const bf16*)(ws + WS_MKV), a.in[17], mkn);
    n_xattn<<<T * 4 / 4, 256, 0, stream>>>((const bf16*)(ws + WS_XQ), a.in[16], mkn, (const bf16*)(ws + WS_MKV), acts + 1024, 1536, 0);
#if MK_LEVEL == 1
    launch_mk(a, 3, 5, 1, grid, stream);
#elif MK_LEVEL == 3
    launch_mk(a, 3, 9, 1, grid, stream);
#else
    { const bf16* gates = (const bf16*)(ws + WS_GATES); bf16* mbf = (bf16*)(ws + WS_MERGED);
    n_gemm<false, EpiGate><<<dim3(1024 / 64, T / 64), 256, 0, stream>>>(acts, a.in[8], nullptr, 1536, 1024, 512, 0, EpiGate{gates, out, mbf, 0, 0});
    n_gemm<false, EpiGate><<<dim3(1024 / 64, T / 64), 256, 0, stream>>>(acts + 512, a.in[13], nullptr, 1536, 1024, 512, 0, EpiGate{gates + 1024, out, mbf, 1, 0});
    n_gemm<false, EpiGate><<<dim3(1024 / 64, T / 64), 256, 0, stream>>>(acts + 1024, a.in[18], nullptr, 1536, 1024, 512, 0, EpiGate{gates + 2048, out, mbf, 2, 0});
    n_gemm<false, EpiRes><<<dim3(1024 / 64, T / 64), 256, 0, stream>>>(mbf, a.in[19], nullptr, 1024, 1024, 1024, 0, EpiRes{a.in[0], out}); }
#endif
#if MK_LEVEL != 3
    int* eid = (int*)(ws + WS_ROUTE); float* ew = (float*)(ws + WS_ROUTE + 256 * 1024);
    n_router<<<T / 4, 256, 0, stream>>>(out, a.in[20], a.in[21], a.in[22], a.in[23], a.in[24], (bf16*)(ws + WS_H2), eid, ew);
    n_moe<<<T, 256, 0, stream>>>((const bf16*)(ws + WS_H2), eid, ew, a.in[25], a.in[26], a.in[27], out);
#endif
    n_check<<<1, 64, 0, stream>>>((const unsigned*)(ws + WS_CTL), out);
#ifdef MK_HASH
    n_hash_cmp<<<1, 64, 0, stream>>>((const unsigned long long*)(ws + WS_CTL) + 40, out);
#endif
#ifdef MK_POISON
    n_poison_report<<<1, 64, 0, stream>>>((const unsigned*)(ws + WS_CTL) + 64, out);
#endif
#endif
}
```

```cpp
#include <hip/hip_runtime.h>
#include <cstdint>
#include <cstdio>
#define MK_LEVEL 4
#define MK_GTB 0
#define MK_SPLIT_HI 9
#define MK_SPLIT_LO 9
#define MK_MIXN 0
#define MK_SPLIT01 0
constexpr int NWAVES = 8;
constexpr int T = 16384, SEQ = 8192, D = 1024, INW = 5376;
constexpr size_t MiB = 1u << 20;
constexpr size_t WS_CTL = 0, CTL_ZERO_BYTES = 1 * MiB;
constexpr size_t WS_W1 = 1 * MiB;
constexpr size_t WS_WO3 = 12 * MiB;
constexpr size_t WS_WOUT = 15 * MiB;
constexpr size_t WS_WKV = 17 * MiB;
constexpr size_t WS_WGU = 19 * MiB;
constexpr size_t WS_WDT = 51 * MiB;
constexpr size_t WS_CS = 67 * MiB;
constexpr size_t WS_MEMN = 71 * MiB;
constexpr size_t WS_MKV = 72 * MiB;
constexpr size_t WS_ROUTE = 73 * MiB;
constexpr size_t WS_RINV = WS_ROUTE + 1792 * 1024;
constexpr size_t WS_U = 76 * MiB;
constexpr size_t WS_XQ = 92 * MiB;
constexpr size_t WS_MERGED = 76 * MiB;
constexpr size_t WS_GATES = 108 * MiB;
constexpr size_t WS_H2 = 212 * MiB;
constexpr size_t WS_HID = 156 * MiB;
constexpr size_t WS_ACTS = 204 * MiB;
constexpr size_t WS_END = 252 * MiB;
constexpr size_t DO_H = 0, DO_Q = 32 * MiB, DO_K = 48 * MiB, DO_V = 52 * MiB;
constexpr size_t RT_CLS = 0;
constexpr size_t RT_W = 64 * 1024;
constexpr size_t RT_CNT = 192 * 1024;
constexpr size_t RT_TOK = 256 * 1024;
constexpr size_t RT_SW = 384 * 1024;
constexpr int CW_TMO = 0, CW_BAR = 4096;
constexpr int RING_OFF = 0, RING_BYTES = 131072;
constexpr int LDS_BYTES = 147456;
constexpr int LDSCTL_OFF = LDS_BYTES - 4096, MISC_OFF = LDSCTL_OFF + 320;
constexpr int TAB_OFF = LDSCTL_OFF + 1024;

#define GAS __attribute__((address_space(1)))
#define LAS __attribute__((address_space(3)))
typedef unsigned short bf16;
typedef unsigned v4u __attribute__((ext_vector_type(4)));
typedef unsigned v2u __attribute__((ext_vector_type(2)));
typedef float f32x4 __attribute__((ext_vector_type(4)));
typedef short bf16x8 __attribute__((ext_vector_type(8)));
typedef GAS unsigned gu32;
#define RLX_AGENT __ATOMIC_RELAXED, __HIP_MEMORY_SCOPE_AGENT
#define LDS_WAIT() asm volatile("s_waitcnt lgkmcnt(0)" ::: "memory")
#define VM_WAIT() asm volatile("s_waitcnt vmcnt(0)" ::: "memory")
__device__ __forceinline__ unsigned f2bf(float f) { unsigned u = __builtin_bit_cast(unsigned, f); return (u + 0x7fffu + ((u >> 16) & 1u)) >> 16; }
__device__ __forceinline__ unsigned pk2(float lo, float hi) { return f2bf(lo) | (f2bf(hi) << 16); }
__device__ __forceinline__ float bf2f(bf16 v) { return __uint_as_float((unsigned)v << 16); }
__device__ __forceinline__ float bflo(unsigned w) { return __uint_as_float(w << 16); }
__device__ __forceinline__ float bfhi(unsigned w) { return __uint_as_float(w & 0xffff0000u); }
__device__ __forceinline__ float shx(float v, int mask) { int l = threadIdx.x; asm volatile("" : "+v"(l));
    return __builtin_bit_cast(float, __builtin_amdgcn_ds_bpermute(((l ^ mask) & 63) << 2, __builtin_bit_cast(int, v))); }
__device__ __forceinline__ float wave_sum(float v) {
    v += __builtin_bit_cast(float, __builtin_amdgcn_update_dpp(0, __builtin_bit_cast(int, v), 0xB1, 0xF, 0xF, true));
    v += __builtin_bit_cast(float, __builtin_amdgcn_update_dpp(0, __builtin_bit_cast(int, v), 0x4E, 0xF, 0xF, true));
    v += __builtin_bit_cast(float, __builtin_amdgcn_update_dpp(0, __builtin_bit_cast(int, v), 0x141, 0xF, 0xF, true));
    v += __builtin_bit_cast(float, __builtin_amdgcn_update_dpp(0, __builtin_bit_cast(int, v), 0x140, 0xF, 0xF, true));
    v += shx(v, 16); v += shx(v, 32);
    return v;
}
__device__ __forceinline__ float wave_max(float v) {
#pragma unroll
    for (int o = 1; o < 64; o <<= 1) v = fmaxf(v, shx(v, o));
    return v;
}
__device__ __forceinline__ float fsigmoid(float x) { return __builtin_amdgcn_rcpf(1.f + __expf(-x)); }

#define XB_TMO      128
#define XB_XCNT(j)  (256  + 64 * (j))
#define XB_XSUB(j)  (1280 + 64 * (j))
#define XB_XGEN(j)  (2304 + 64 * (j))
#define XB_TOP      3328
#define XB_TOPGEN   3392
#define XCD_BAR_WORDS 3456
#define XB_SPIN_CAP (1u << 18)
__device__ __forceinline__ unsigned xb_ld(unsigned* p)              { return __hip_atomic_load(p, __ATOMIC_RELAXED, __HIP_MEMORY_SCOPE_AGENT); }
__device__ __forceinline__ unsigned xb_add(unsigned* p, unsigned v) { return __hip_atomic_fetch_add(p, v, __ATOMIC_RELAXED, __HIP_MEMORY_SCOPE_AGENT); }
__device__ __forceinline__ unsigned xb_xcc_id() { return (unsigned)__builtin_amdgcn_s_getreg((3 << 11) | 20) & 0xFu; }
#define XB_SPIN(cond, bar) do { unsigned _sp = 0; while (cond) { __builtin_amdgcn_s_sleep(1); \
    if ((++_sp & 255u) == 0u) { if (xb_ld(&(bar)[XB_TMO])) break; if (_sp > XB_SPIN_CAP) { atomicAdd(&(bar)[XB_TMO], 1u); break; } } } } while (0)
struct XcdBarrier { unsigned* bar; unsigned x; volatile LAS unsigned* st; };
__device__ __forceinline__ XcdBarrier xcd_barrier_post(unsigned* bar, volatile LAS unsigned* st) {
    XcdBarrier b; b.bar = bar; b.x = xb_xcc_id(); b.st = st;
    if (threadIdx.x == 0) (void)xb_add(&bar[XB_XCNT(b.x)], 1u);
    return b;
}
__device__ __forceinline__ void xcd_barrier_complete(unsigned* bar, unsigned x, unsigned& nloc, unsigned& nx) {
    const unsigned G = gridDim.x * gridDim.y * gridDim.z;
    unsigned sum, cnt, mine, sp = 0u;
    for (;;) {
        sum = 0u; cnt = 0u; mine = 0u;
#pragma unroll
        for (unsigned j = 0; j < 16; ++j) { const unsigned c = xb_ld(&bar[XB_XCNT(j)]); sum += c; cnt += (c > 0u) ? 1u : 0u; mine = (j == x) ? c : mine; }
        if (sum == G) break;
        __builtin_amdgcn_s_sleep(1);
        if ((++sp & 255u) == 0u) { if (xb_ld(&bar[XB_TMO])) break; if (sp > XB_SPIN_CAP) { atomicAdd(&bar[XB_TMO], 1u); break; } }
    }
    nloc = mine > 0u ? mine : 1u; nx = cnt > 0u ? cnt : 1u;
}
__device__ __forceinline__ void xcd_barrier(const XcdBarrier& b) {
    asm volatile("s_waitcnt vmcnt(0)" ::: "memory");
    __syncthreads();
    if (threadIdx.x == 0) {
        unsigned* bar = b.bar;
        __builtin_amdgcn_s_waitcnt(0);
        unsigned nloc = b.st[0], nx = b.st[1];
        if (nloc == 0u) { xcd_barrier_complete(bar, b.x, nloc, nx); b.st[0] = nloc; b.st[1] = nx; }
        const unsigned old = xb_add(&bar[XB_XSUB(b.x)], 1u);
        const unsigned gen = old / nloc;
        if (old + 1u == (gen + 1u) * nloc) {
            __builtin_amdgcn_fence(__ATOMIC_RELEASE, "agent");
            asm volatile("s_waitcnt vmcnt(0)" ::: "memory");
            const unsigned og = xb_add(&bar[XB_TOP], 1u);
            const unsigned tg = og / nx;
            if (og + 1u == (tg + 1u) * nx) xb_add(&bar[XB_TOPGEN], 1u);
            else XB_SPIN(xb_ld(&bar[XB_TOPGEN]) == tg, bar);
            __builtin_amdgcn_fence(__ATOMIC_ACQUIRE, "agent");
            xb_add(&bar[XB_XGEN(b.x)], 1u);
            asm volatile("s_waitcnt vmcnt(0)" ::: "memory");
        } else {
            XB_SPIN(xb_ld(&bar[XB_XGEN(b.x)]) == gen, bar);
            __builtin_amdgcn_fence(__ATOMIC_ACQUIRE, "agent");
            asm volatile("s_waitcnt vmcnt(0)" ::: "memory");
        }
    }
    __syncthreads();
}

struct Args { const float* in[28]; float* out; unsigned char* ws; int ph_lo, ph_hi, li, pad; };
constexpr int PARG_OFF = LDSCTL_OFF + 512;
struct Frame {
    LAS unsigned char* lds; volatile LAS unsigned* MISC; gu32* ctl;
    int wave, vcu, G;
    __device__ __forceinline__ int ftid() const { int t = threadIdx.x; asm volatile("" : "+v"(t)); return t; }
    __device__ __forceinline__ unsigned long long ldp(int i) const { const unsigned long long v = ((const LAS unsigned long long*)(lds + PARG_OFF))[i];
        const unsigned lo = __builtin_amdgcn_readfirstlane((unsigned)v), hi = __builtin_amdgcn_readfirstlane((unsigned)(v >> 32)); return ((unsigned long long)hi << 32) | lo; }
    __device__ __forceinline__ const float* in(int i) const { return (const float*)(const GAS float*)ldp(i); }
    __device__ __forceinline__ float* out() const { return (float*)(GAS float*)ldp(28); }
    __device__ __forceinline__ unsigned char* ws() const { return (unsigned char*)(GAS unsigned char*)ldp(29); }
};
namespace pg8 {
#define PG8_LAS __attribute__((address_space(3)))
typedef unsigned short bf16_t;
typedef short bf16x8 __attribute__((ext_vector_type(8)));
typedef float f32x4 __attribute__((ext_vector_type(4)));
typedef unsigned u32x4 __attribute__((ext_vector_type(4)));
typedef unsigned u32x2 __attribute__((ext_vector_type(2)));
constexpr int BM = 256, BK = 64, HALF = 128, HTB = HALF * BK * 2  , STAGE_BYTES = 8 * HTB, NXCD = 8, WGM = 8;

__host__ __device__ __forceinline__ int lds_byte(int r, int c) { const int st = (r >> 4) * 2 + (c >> 5), rr = r & 15, cc = c & 31, ob = rr * 64 + cc * 2; return st * 1024 + (ob ^ (((ob >> 9) & 1) << 5)); }
__host__ __device__ __forceinline__ void stage_rc(int b, int& R, int& C) { const int st = b / 1024, sb = b % 1024, swz = sb ^ (((sb >> 9) & 1) << 5); R = (st >> 1) * 16 + swz / 64; C = (st & 1) * 32 + (swz % 64) / 2; }
__host__ __device__ __forceinline__ int perm32(int rho) { const int n = rho >> 4, i = rho & 15; return 8 * (i >> 2) + 4 * n + (i & 3); }

struct Unit { int pm, pn, aux, ksplit; const char* A; const char* B0; const char* B1; const int* ridx; };

typedef float f32x2_t __attribute__((ext_vector_type(2))); typedef __bf16 bf16x2_t __attribute__((ext_vector_type(2)));
__device__ __forceinline__ unsigned cvt_pk_bf16(float lo, float hi) { f32x2_t v = {lo, hi}; bf16x2_t b = __builtin_convertvector(v, bf16x2_t); return __builtin_bit_cast(unsigned, b); }

__device__ __forceinline__ bool static_tile(int L, int nM, int nN, int& pm, int& pn) {
    const int nwg = nM * nN; if (L >= nwg) return false;
    int wgid = L; { const int q = nwg / NXCD, r = nwg % NXCD, xcd = wgid % NXCD, off = wgid / NXCD; wgid = (xcd < r ? xcd * (q + 1) : r * (q + 1) + (xcd - r) * q) + off; }
    const int nig = WGM * nN, gid = wgid / nig, fm = gid * WGM, gsz = (nM - fm) < WGM ? (nM - fm) : WGM;
    pm = fm + ((wgid % nig) % gsz); pn = (wgid % nig) / gsz; return true;
}

template <class Epi, class Sched, bool ALIGN_EPI, bool GATHER, bool SPLIT, int nt, unsigned lda, unsigned ldb>
__device__ __forceinline__ void gemm_phase(PG8_LAS unsigned char* lds, const Sched& S, const Epi& E) {
    const int tid = threadIdx.x, wid = __builtin_amdgcn_readfirstlane(tid >> 6), lane = tid & 63, wr = wid >> 2, wc = wid & 3, fr = lane & 15, fq = lane >> 4;
    unsigned voffA[2], voffB[2];
#pragma unroll
    for (int i = 0; i < 2; ++i) { int R, C; stage_rc(tid * 16 + i * 8192, R, C); const int Rb = Epi::PERM ? ((R & ~31) + perm32(R & 31)) : R;
        voffA[i] = (unsigned)R * lda + (unsigned)C * 2u; voffB[i] = (unsigned)Rb * ldb + (unsigned)C * 2u; }
    const size_t kstep = (size_t)(BK * 2);
    const size_t hstepA = (size_t)HALF * lda, hstepB = (size_t)HALF * ldb;
    const unsigned ldsw = (unsigned)wid * 1024u;
    const int aoff = lds_byte(wr * 64 + fr, fq * 8), boff = lds_byte(wc * 32 + fr, fq * 8);
#define PG8_SA(b, h) (((b) * 2 + (h)) * HTB)
#define PG8_SB(b, h) ((4 + (b) * 2 + (h)) * HTB)
#define PG8_STAGE(bufoff, gbase, voff) do { const __amdgpu_buffer_rsrc_t _rs = __builtin_amdgcn_make_buffer_rsrc((void*)(gbase), 0, 0x7fffffff, 0x00020000); _Pragma("unroll") for (int _i = 0; _i < 2; ++_i) \
        __builtin_amdgcn_raw_ptr_buffer_load_lds(_rs, (PG8_LAS unsigned*)(lds + (bufoff) + ldsw + _i * 8192), 16, (int)(voff)[_i], 0, 0, 0); } while (0)
#define PG8_LDA(dst, b, h) do { _Pragma("unroll") for (int m = 0; m < 4; ++m) _Pragma("unroll") for (int k = 0; k < 2; ++k) dst[m][k] = *(const PG8_LAS bf16x8*)(lds + PG8_SA(b, h) + aoff + m * 2048 + k * 1024); } while (0)
#define PG8_LDB(dst, b, h) do { _Pragma("unroll") for (int n = 0; n < 2; ++n) _Pragma("unroll") for (int k = 0; k < 2; ++k) dst[n][k] = *(const PG8_LAS bf16x8*)(lds + PG8_SB(b, h) + boff + n * 2048 + k * 1024); } while (0)
#define PG8_MMA(ai, bj, At, Bt) do { __builtin_amdgcn_s_setprio(1); _Pragma("unroll") for (int m = 0; m < 4; ++m) _Pragma("unroll") for (int n = 0; n < 2; ++n) _Pragma("unroll") for (int k = 0; k < 2; ++k) \
        acc[ai][bj][m][n] = __builtin_amdgcn_mfma_f32_16x16x32_bf16(Bt[n][k], At[m][k], acc[ai][bj][m][n], 0, 0, 0); __builtin_amdgcn_s_setprio(0); } while (0)
#define PG8_WAIT_V(n) asm volatile("s_waitcnt vmcnt(" #n ")" ::: "memory")
#define PG8_WAIT_L(n) asm volatile("s_waitcnt lgkmcnt(" #n ")" ::: "memory")
#define PG8_BAR __builtin_amdgcn_s_barrier()
#define PG8_SCHED __builtin_amdgcn_sched_barrier(0)
#ifndef MK_GT
#define MK_GT -1
#endif
#define PG8_TMARK(cat) do { if (MK_GT >= 0) { if (tid == 0) { PG8_LAS unsigned long long* ts_ = (PG8_LAS unsigned long long*)(lds - RING_OFF + PARG_OFF + 256); if (ts_[2]) { const unsigned long long t_ = __builtin_amdgcn_s_memrealtime(); ts_[4 + (cat)] += t_ - ts_[3]; ts_[3] = t_; } } } } while (0)
#define PG8_APTR(u, h, t) ((u).A + (GATHER ? (size_t)0 : (size_t)(h) * hstepA) + (size_t)(t) * kstep)
#define PG8_BPTR(u, h, t) ((SPLIT ? ((t) < (u).ksplit ? (u).B0 + (size_t)(t) * kstep : (u).B1 + (size_t)((t) - (u).ksplit) * kstep) : (u).B0 + (size_t)(t) * kstep) + (size_t)(h) * hstepB)
#define PG8_STAGE_A(bufoff, u, g, h, t) do { if (GATHER) { unsigned _vo[2]; int _tid = tid; asm volatile("" : "+v"(_tid)); _Pragma("unroll") for (int _i = 0; _i < 2; ++_i) { int _R, _C; stage_rc(_tid * 16 + _i * 8192, _R, _C); \
            _vo[_i] = (((g)[h] >> (16 * _i)) & 0xffffu) * lda + (unsigned)_C * 2u; } PG8_STAGE(bufoff, PG8_APTR(u, h, t), _vo); } else PG8_STAGE(bufoff, PG8_APTR(u, h, t), voffA); } while (0)
#define PG8_STAGE_B(bufoff, u, h, t) PG8_STAGE(bufoff, PG8_BPTR(u, h, t), voffB)
#define PG8_GIDX(g, u) do { if (GATHER) { _Pragma("unroll") for (int _h = 0; _h < 2; ++_h) { unsigned _p = 0u; _Pragma("unroll") for (int _i = 0; _i < 2; ++_i) { int _R, _C; stage_rc(tid * 16 + _i * 8192, _R, _C); \
            const int _j = _h * HALF + _R, _t = (u).ridx[_j < (u).aux ? _j : (u).aux - 1]; _p |= (unsigned)_t << (16 * _i); } (g)[_h] = _p; } } } while (0)
    PG8_TMARK(0);
    Unit cur, nxt; int ui = 0;
    if (!S.next(0, cur)) return;
    f32x4 acc[2][2][4][2];
#pragma unroll
    for (int a = 0; a < 2; ++a)
#pragma unroll
        for (int b = 0; b < 2; ++b)
#pragma unroll
            for (int m = 0; m < 4; ++m)
#pragma unroll
                for (int n = 0; n < 2; ++n) acc[a][b][m][n] = (f32x4){0.f, 0.f, 0.f, 0.f};
    bf16x8 At[4][2], B0[2][2], B1[2][2];
    unsigned gC[2] = {0u, 0u}, gN[2] = {0u, 0u};
    S.a_ready(cur);
    PG8_GIDX(gC, cur);
    if constexpr (Epi::PREFETCH) E.prefetch(cur, lds + STAGE_BYTES + wid * 256, tid);
    PG8_STAGE_B(PG8_SB(0, 0), cur, 0, 0); PG8_STAGE_B(PG8_SB(0, 1), cur, 1, 0); PG8_STAGE_A(PG8_SA(0, 0), cur, gC, 0, 0); PG8_STAGE_A(PG8_SA(0, 1), cur, gC, 1, 0);
    if (wr == 1) PG8_BAR;
    PG8_WAIT_V(2); PG8_BAR;
    PG8_STAGE_B(PG8_SB(1, 0), cur, 0, 1); PG8_STAGE_A(PG8_SA(1, 0), cur, gC, 0, 1); PG8_STAGE_B(PG8_SB(1, 1), cur, 1, 1);
    PG8_WAIT_V(6); PG8_BAR;
    PG8_TMARK(1);
    for (;;) {
        const bool has_next = S.next(ui + 1, nxt);
        if (!has_next) nxt = cur;
        if (GATHER) { if (has_next) { PG8_GIDX(gN, nxt); } else { gN[0] = gC[0]; gN[1] = gC[1]; } }
        for (int t = 0; t < nt; t += 2) {
            const bool last = (t == nt - 2);
            if (last && has_next) S.a_ready(nxt);
            PG8_LDB(B0, 0, 0); PG8_LDB(B1, 0, 1); PG8_SCHED; PG8_LDA(At, 0, 0); PG8_STAGE_A(PG8_SA(1, 1), cur, gC, 1, t + 1);
            PG8_WAIT_V(8); PG8_WAIT_L(0); PG8_BAR; PG8_MMA(0, 0, At, B0); PG8_MMA(0, 1, At, B1); PG8_BAR; PG8_SCHED;
            PG8_LDA(At, 0, 1);
            if (!last) { PG8_STAGE_B(PG8_SB(0, 0), cur, 0, t + 2); PG8_STAGE_B(PG8_SB(0, 1), cur, 1, t + 2); PG8_STAGE_A(PG8_SA(0, 0), cur, gC, 0, t + 2); }
            else       { PG8_STAGE_B(PG8_SB(0, 0), nxt, 0, 0);     PG8_STAGE_B(PG8_SB(0, 1), nxt, 1, 0);     PG8_STAGE_A(PG8_SA(0, 0), nxt, gN, 0, 0); }
            PG8_WAIT_V(8); PG8_WAIT_L(0); PG8_BAR; PG8_MMA(1, 0, At, B0); PG8_MMA(1, 1, At, B1); PG8_BAR; PG8_SCHED;
            PG8_LDB(B0, 1, 0); PG8_LDB(B1, 1, 1); PG8_SCHED; PG8_LDA(At, 1, 0);
            if (!last) { PG8_STAGE_A(PG8_SA(0, 1), cur, gC, 1, t + 2); } else { PG8_STAGE_A(PG8_SA(0, 1), nxt, gN, 1, 0); }
            PG8_WAIT_V(8); PG8_WAIT_L(0); PG8_BAR; PG8_MMA(0, 0, At, B0); PG8_MMA(0, 1, At, B1); PG8_BAR; PG8_SCHED;
            PG8_LDA(At, 1, 1);
            if (!last) { PG8_STAGE_B(PG8_SB(1, 0), cur, 0, t + 3); PG8_STAGE_B(PG8_SB(1, 1), cur, 1, t + 3); PG8_STAGE_A(PG8_SA(1, 0), cur, gC, 0, t + 3); }
            else       { PG8_STAGE_B(PG8_SB(1, 0), nxt, 0, 1);     PG8_STAGE_B(PG8_SB(1, 1), nxt, 1, 1);     PG8_STAGE_A(PG8_SA(1, 0), nxt, gN, 0, 1); }
            PG8_WAIT_V(8); PG8_WAIT_L(0); PG8_BAR; PG8_MMA(1, 0, At, B0); PG8_MMA(1, 1, At, B1); PG8_BAR; PG8_SCHED;
        }
        if constexpr (ALIGN_EPI) { if (wr == 0) PG8_BAR; }
        PG8_TMARK(2);
        int fr_ = fr, fq_ = fq; asm volatile("" : "+v"(fr_), "+v"(fq_));
        bool zero = true;
        asm volatile("" ::: "memory");
        if constexpr (!Epi::AFTER_DRAIN) zero = E(acc, cur, wr, wc, fr_, fq_);
        asm volatile("" ::: "memory");
        PG8_TMARK(3);
        if (!has_next) break;
        if (zero) {
#pragma unroll
            for (int a = 0; a < 2; ++a)
#pragma unroll
                for (int b = 0; b < 2; ++b)
#pragma unroll
                    for (int m = 0; m < 4; ++m)
#pragma unroll
                        for (int n = 0; n < 2; ++n) acc[a][b][m][n] = (f32x4){0.f, 0.f, 0.f, 0.f};
        }
        cur = nxt; ++ui;
        if constexpr (Epi::PREFETCH) E.prefetch(cur, lds + STAGE_BYTES + wid * 256, tid);
        if (GATHER) { gC[0] = gN[0]; gC[1] = gN[1]; }
        if constexpr (ALIGN_EPI) { if (wr == 1) PG8_BAR; }
        PG8_TMARK(4);
    }
    PG8_WAIT_V(0);
    if constexpr (!ALIGN_EPI) { if (wr == 0) PG8_BAR; }
    PG8_BAR;
    PG8_TMARK(5);
    if constexpr (Epi::AFTER_DRAIN) { int fr_ = fr, fq_ = fq; asm volatile("" : "+v"(fr_), "+v"(fq_)); E.fused(acc, cur, wr, wc, fr_, fq_, lds, wid, lane); }
    PG8_TMARK(6);
#undef PG8_SA
#undef PG8_SB
#undef PG8_STAGE
#undef PG8_LDA
#undef PG8_LDB
#undef PG8_MMA
#undef PG8_WAIT_V
#undef PG8_WAIT_L
#undef PG8_BAR
#undef PG8_SCHED
#undef PG8_APTR
#undef PG8_BPTR
#undef PG8_STAGE_A
#undef PG8_STAGE_B
#undef PG8_GIDX
#undef PG8_TMARK
}
}
#ifndef MK_TSUB
#define MK_TSUB -1
#endif
#ifndef TSUB_BEG
#define TSUB_BEG(k) if (MK_TSUB == (k)) { __syncthreads(); if (threadIdx.x == 0) ((LAS unsigned long long*)(F.lds + PARG_OFF + 256))[0] = __builtin_amdgcn_s_memrealtime(); }
#define TSUB_END(k) if (MK_TSUB == (k)) { __syncthreads(); if (threadIdx.x == 0) ((LAS unsigned long long*)(F.lds + PARG_OFF + 256))[1] = __builtin_amdgcn_s_memrealtime(); }
#endif
__device__ __forceinline__ int map_win(int n) {
    if (n < 512) { const int hq = n >> 6, d = n & 63; return 256 * (hq >> 2) + (d >> 5) * 128 + 32 * (hq & 3) + (d & 31); }
    if (n < 768) { const int j = n - 512, hh = j >> 6, d = j & 63; return 512 + (d >> 5) * 128 + 32 * hh + (d & 31); }
    if (n < 1792) { const int j = n - 768; const int c = j & 511; return 768 + 8 * (c >> 2) + (j >= 512 ? 4 : 0) + (c & 3); }
    return n;
}
__device__ __forceinline__ int map_row(int mode, int n) {
    if (mode == 1) return map_win(n);
    if (mode == 2) return 8 * (n >> 2) + (n & 3);
    if (mode == 3) return 8 * (n >> 2) + 4 + (n & 3);
    return n;
}
constexpr int TSCR = 64 * 65 * 4;
__device__ __forceinline__ void p0_transpose_item(const float* W, int N, bf16* WT, int ldt, int mode, LAS float* scr, int kb, int nb, int lane) {
    const int k0 = 64 * kb, n0 = 64 * nb, kk = lane >> 4, nq = lane & 15;
    const GAS f32x4* src = (const GAS f32x4*)(W + (size_t)(k0 + kk) * N + n0 + 4 * nq);
#pragma unroll 8
    for (int i = 0; i < 16; ++i) { const f32x4 v = src[(size_t)i * N]; LAS float* d = scr + (4 * i + kk) * 65 + 4 * nq; d[0] = v[0]; d[1] = v[1]; d[2] = v[2]; d[3] = v[3]; }
    LDS_WAIT(); asm volatile("" ::: "memory");
    const int c = lane & 7, nn = lane >> 3;
#pragma unroll
    for (int j = 0; j < 8; ++j) { const int n = nn + 8 * j; const LAS float* s = scr + (8 * c) * 65 + n;
        v4u o; o.x = pk2(s[0 * 65], s[1 * 65]); o.y = pk2(s[2 * 65], s[3 * 65]); o.z = pk2(s[4 * 65], s[5 * 65]); o.w = pk2(s[6 * 65], s[7 * 65]);
        *(GAS v4u*)(WT + (size_t)map_row(mode, n0 + n) * ldt + k0 + 8 * c) = o; }
    LDS_WAIT(); asm volatile("" ::: "memory");
}
constexpr int IA_WIN = 16 * 84, IA_KV = 16 * 16, NITEMS_A = IA_WIN + IA_KV;
constexpr int IB_WO = 8 * 16, IB_OUT = 16 * 16, IB_GU = 16 * 16 * 8, IB_DN = 16 * 8 * 16, NITEMS_B = 3 * IB_WO + IB_OUT + 2 * IB_GU, NITEMS_B2 = IB_DN;
__device__ __forceinline__ void convert_item_a(Frame& F, unsigned char* ws, LAS float* scr, int r, int lane) {
    if (r < IA_WIN) { p0_transpose_item(F.in(4), INW, (bf16*)(ws + WS_W1), 1024, 1, scr, r / 84, r % 84, lane); return; } r -= IA_WIN;
    p0_transpose_item(F.in(15), 1024, (bf16*)(ws + WS_WKV), 1024, 0, scr, r / 16, r % 16, lane);
}
__device__ __forceinline__ void convert_item_b(Frame& F, unsigned char* ws, LAS float* scr, int r, int lane) {
    if (r < 3 * IB_WO) { const int b = r / IB_WO, q = r % IB_WO; const float* W = b == 0 ? F.in(8) : (b == 1 ? F.in(13) : F.in(18));
        p0_transpose_item(W, 1024, (bf16*)(ws + WS_WO3) + (size_t)b * 1024 * 512, 512, 0, scr, q / 16, q % 16, lane); return; } r -= 3 * IB_WO;
    if (r < IB_OUT) { p0_transpose_item(F.in(19), 1024, (bf16*)(ws + WS_WOUT), 1024, 0, scr, r / 16, r % 16, lane); return; } r -= IB_OUT;
    if (r < 2 * IB_GU) { const int up = r / IB_GU, q = r % IB_GU, e = q / 128, qq = q % 128; const float* W = (up ? F.in(26) : F.in(25)) + (size_t)e * 1024 * 512;
        p0_transpose_item(W, 512, (bf16*)(ws + WS_WGU) + (size_t)e * 1024 * 1024, 1024, 2 + up, scr, qq / 8, qq % 8, lane); return; }
}
__device__ __forceinline__ void convert_item_b2(Frame& F, unsigned char* ws, LAS float* scr, int r, int lane) {
    { const int e = r / 128, qq = r % 128; p0_transpose_item(F.in(27) + (size_t)e * 512 * 1024, 1024, (bf16*)(ws + WS_WDT) + (size_t)e * 1024 * 512, 512, 0, scr, qq / 16, qq % 16, lane); }
}
__device__ __forceinline__ void convert_b2_tail(Frame& F, int nunits) {
    const int rem = nunits % F.G, first = rem, cnt = rem ? F.G - rem : F.G, idx = rem ? F.vcu - rem : F.vcu;
    if (idx < 0) return; (void)first;
    const int tid_ = F.ftid(), lane_ = tid_ & 63; unsigned char* ws = F.ws();
    LAS float* scr = (LAS float*)(F.lds + RING_OFF + F.wave * TSCR);
    for (int it = idx * NWAVES + F.wave; it < NITEMS_B2; it += cnt * NWAVES) convert_item_b2(F, ws, scr, it, lane_);
}
__device__ __forceinline__ void convert_b2_all(Frame& F) {
    const int tid_ = F.ftid(), lane_ = tid_ & 63; unsigned char* ws = F.ws();
    LAS float* scr = (LAS float*)(F.lds + RING_OFF + F.wave * TSCR);
    for (int it = F.vcu * NWAVES + F.wave; it < NITEMS_B2; it += F.G * NWAVES) convert_item_b2(F, ws, scr, it, lane_);
    __syncthreads();
}
constexpr int P1_LONG = 72;
__device__ __forceinline__ void convert_b_tail(Frame& F) {
    if (F.G <= P1_LONG || (int)blockIdx.x < P1_LONG) return;
    const int tid_ = F.ftid(), lane_ = tid_ & 63; unsigned char* ws = F.ws();
    LAS float* scr = (LAS float*)(F.lds + RING_OFF + F.wave * TSCR);
    const int gw = ((int)blockIdx.x - P1_LONG) * NWAVES + F.wave, NGW = (F.G - P1_LONG) * NWAVES;
    for (int it = gw; it < NITEMS_B; it += NGW) convert_item_b(F, ws, scr, it, lane_);
}
template <int NR>
__device__ __forceinline__ void rms_rows_load(f32x4 (&v)[NR][4], int lane, const float* xrow, size_t stride) {
#pragma unroll
    for (int i = 0; i < NR; ++i) { const GAS f32x4* xr = (const GAS f32x4*)(xrow + i * stride) + lane;
#pragma unroll
        for (int j = 0; j < 4; ++j) v[i][j] = xr[64 * j]; }
}
template <int NR>
__device__ __forceinline__ void rms_rows_finish(const f32x4 (&v)[NR][4], int lane, size_t stride, const float* g, bf16* orow, float* rinv = nullptr, int rstride = 0) {
    float s[NR]; f32x4 gg[4];
#pragma unroll
    for (int j = 0; j < 4; ++j) gg[j] = *((const GAS f32x4*)g + lane + 64 * j);
#pragma unroll
    for (int i = 0; i < NR; ++i) { s[i] = 0.f;
#pragma unroll
        for (int j = 0; j < 4; ++j) s[i] += (v[i][j].x * v[i][j].x + v[i][j].y * v[i][j].y) + (v[i][j].z * v[i][j].z + v[i][j].w * v[i][j].w); }
#pragma unroll
    for (int i = 0; i < NR; ++i) s[i] = wave_sum(s[i]);
#pragma unroll
    for (int i = 0; i < NR; ++i) { const float r = rsqrtf(s[i] * (1.f / 1024.f) + 1e-6f); GAS unsigned long long* o8 = (GAS unsigned long long*)(orow + i * stride) + lane;
        if (rinv != nullptr && lane == 0) rinv[i * rstride] = 1.f / r;
#pragma unroll
        for (int j = 0; j < 4; ++j) o8[64 * j] = (unsigned long long)pg8::cvt_pk_bf16(v[i][j].x * r * gg[j].x, v[i][j].y * r * gg[j].y) | ((unsigned long long)pg8::cvt_pk_bf16(v[i][j].z * r * gg[j].z, v[i][j].w * r * gg[j].w) << 32); }
}
template <int NR>
__device__ __forceinline__ void rms_rows_to_bf16(int lane, const float* xrow, size_t stride, const float* g, bf16* orow) { f32x4 v[NR][4]; rms_rows_load<NR>(v, lane, xrow, stride); rms_rows_finish<NR>(v, lane, stride, g, orow); }
__device__ __forceinline__ void p0_prologue(Frame& F) {
    const int tid_ = F.ftid(), lane_ = tid_ & 63; (void)lane_;
    LAS float* scr = (LAS float*)(F.lds + RING_OFF + F.wave * TSCR);
    const int gw = F.vcu * NWAVES + F.wave, NGW = F.G * NWAVES;
    unsigned char* ws = F.ws();
    if (T == 8 * NGW) {
        f32x4 v[8][4]; rms_rows_load<8>(v, lane_, F.in(0) + (size_t)gw * D, (size_t)NGW * D);
        for (int it = gw; it < NITEMS_A; it += NGW) convert_item_a(F, ws, scr, it, lane_);
        rms_rows_finish<8>(v, lane_, (size_t)NGW * D, F.in(3), (bf16*)((unsigned char*)F.out() + DO_H) + (size_t)gw * D, (float*)(ws + WS_RINV) + gw, NGW);
    } else {
        for (int it = gw; it < NITEMS_A; it += NGW) convert_item_a(F, ws, scr, it, lane_);
        for (int m = gw; m < T; m += NGW) { f32x4 v1[1][4]; rms_rows_load<1>(v1, lane_, F.in(0) + (size_t)m * D, 0); rms_rows_finish<1>(v1, lane_, 0, F.in(3), (bf16*)((unsigned char*)F.out() + DO_H) + (size_t)m * D, (float*)(ws + WS_RINV) + m, 0); }
    }
    for (int m = gw; m < 512; m += NGW) rms_rows_to_bf16<1>(lane_, F.in(1) + (size_t)m * D, 0, F.in(14), (bf16*)(ws + WS_MEMN) + (size_t)m * D);
    {
        const float* g2 = F.in(20); const float* wg = F.in(21); const float* wrt = F.in(23); bf16* WR = (bf16*)(ws + WS_ROUTE + 2 * MiB);
        const int gt = F.vcu * 512 + tid_, NT_ = F.G * 512;
        for (int id = gt; id < 4 * 32 * 256; id += NT_) { const int pn = id >> 13, n = (id >> 8) & 31, s = id & 255, gidx = s >> 5, kg = (s >> 3) & 3, j = s & 7;
            const int col = 256 * pn + 128 * (gidx >> 2) + 32 * (gidx & 3) + (j < 4 ? 4 * kg + j : 16 + 4 * kg + j - 4); float w = 0.f;
            if (n < 20) w = g2[col] * (n < 4 ? wg[col * 4 + n] : wrt[col * 16 + (n - 4)]);
            const unsigned hi = f2bf(w), lo = f2bf(w - __uint_as_float(hi << 16));
            WR[(size_t)((pn * 2 + 0) * 32 + n) * 256 + s] = (bf16)hi; WR[(size_t)((pn * 2 + 1) * 32 + n) * 256 + s] = (bf16)lo; }
    }
    {
        const int* positions = (const int*)F.in(2); float2* cs = (float2*)(ws + WS_CS);
        const int gt = F.vcu * 512 + tid_, NT_ = F.G * 512;
        for (int idx = gt; idx < T * 32; idx += NT_) { const int t = idx >> 5, i = idx & 31;
            const float inv = 1.0f / powf(10000.f, (float)(2 * i) / 64.f); const float ang = (float)positions[t] * inv;
            double s, c; sincos((double)ang, &s, &c); cs[idx] = make_float2((float)c, (float)s); }
    }
}

struct SchedP1 {
    __device__ __forceinline__ void a_ready(const pg8::Unit&) const {}
    int G, c; const char* Ah; const char* W1; const char* Amem; const char* Wkv;
    __device__ __forceinline__ bool next(int i, pg8::Unit& u) const {
        const int L = i * G + c; u.ksplit = 1 << 30; u.ridx = nullptr;
        if (L < 64 * 21) { int pm, pn; pg8::static_tile(L, 64, 21, pm, pn); u.pm = pm; u.pn = pn; u.aux = 0; u.A = Ah + (size_t)pm * 256 * 2048; u.B0 = W1 + (size_t)pn * 256 * 2048; u.B1 = u.B0; return true; }
        const int j = L - 64 * 21; if (j >= 8) return false;
        u.pm = j & 1; u.pn = j >> 1; u.aux = 1; u.A = Amem + (size_t)u.pm * 256 * 2048; u.B0 = Wkv + (size_t)u.pn * 256 * 2048; u.B1 = u.B0; return true;
    }
};
__device__ __forceinline__ v4u pack8(const f32x4 a, const f32x4 b) { v4u w; w.x = pg8::cvt_pk_bf16(a[0], a[1]); w.y = pg8::cvt_pk_bf16(a[2], a[3]); w.z = pg8::cvt_pk_bf16(b[0], b[1]); w.w = pg8::cvt_pk_bf16(b[2], b[3]); return w; }
struct EpiP1 {
    static constexpr bool PERM = true, AFTER_DRAIN = false, PREFETCH = false;
    bf16 *q, *k, *v, *u, *xq, *gates, *mkv; const float2* cs; const float *gq, *gk;
    __device__ __forceinline__ void qk_rope(const f32x4 (&acc)[2][2][4][2], int row0, bf16* dst, int ld, int head, const float* g, int fq) const {
        f32x4 g1[2], g2[2];
#pragma unroll
        for (int n = 0; n < 2; ++n) { g1[n] = *(const f32x4*)(g + 8 * fq + 4 * n); g2[n] = *(const f32x4*)(g + 32 + 8 * fq + 4 * n); }
#pragma unroll
        for (int ai = 0; ai < 2; ++ai)
#pragma unroll
            for (int m = 0; m < 4; ++m) {
                const int row = row0 + ai * 128 + m * 16;
                float ss = 0.f;
#pragma unroll
                for (int bj = 0; bj < 2; ++bj)
#pragma unroll
                    for (int n = 0; n < 2; ++n) { const f32x4 x = acc[ai][bj][m][n]; ss += (x[0] * x[0] + x[1] * x[1]) + (x[2] * x[2] + x[3] * x[3]); }
                ss += shx(ss, 16); ss += shx(ss, 32);
                const float r = rsqrtf(ss * (1.f / 64.f) + 1e-6f);
                const f32x4* cp = (const f32x4*)(cs + (size_t)row * 32 + 8 * fq);
                f32x4 o1[2], o2[2];
#pragma unroll
                for (int n = 0; n < 2; ++n) { const f32x4 ca = cp[2 * n], cb = cp[2 * n + 1];
                    const f32x4 y1 = acc[ai][0][m][n] * r * g1[n], y2 = acc[ai][1][m][n] * r * g2[n];
                    o1[n] = (f32x4){y1[0] * ca[0] - y2[0] * ca[1], y1[1] * ca[2] - y2[1] * ca[3], y1[2] * cb[0] - y2[2] * cb[1], y1[3] * cb[2] - y2[3] * cb[3]};
                    o2[n] = (f32x4){y2[0] * ca[0] + y1[0] * ca[1], y2[1] * ca[2] + y1[1] * ca[3], y2[2] * cb[0] + y1[2] * cb[1], y2[3] * cb[2] + y1[3] * cb[3]}; }
                bf16* p = dst + (size_t)row * ld + head * 64 + 8 * fq;
                *(v4u*)p = pack8(o1[0], o1[1]); *(v4u*)(p + 32) = pack8(o2[0], o2[1]);
            }
    }
    __device__ __forceinline__ bool operator()(f32x4 (&acc)[2][2][4][2], const pg8::Unit& un, int wr, int wc, int fr, int fq) const {
        const int row0 = un.pm * 256 + wr * 64 + fr;
        if (un.aux == 1) {
#pragma unroll
            for (int ai = 0; ai < 2; ++ai)
#pragma unroll
                for (int m = 0; m < 4; ++m)
#pragma unroll
                    for (int bj = 0; bj < 2; ++bj) *(v4u*)(mkv + (size_t)(row0 + ai * 128 + m * 16) * 1024 + un.pn * 256 + bj * 128 + wc * 32 + 8 * fq) = pack8(acc[ai][bj][m][0], acc[ai][bj][m][1]);
            return true;
        }
        const int pn = un.pn;
        if (pn < 2) { qk_rope(acc, row0, q, 512, 4 * pn + wc, gq, fq); return true; }
        if (pn == 2) {
            if (wc < 2) { qk_rope(acc, row0, k, 128, wc, gk, fq); return true; }
#pragma unroll
            for (int ai = 0; ai < 2; ++ai)
#pragma unroll
                for (int m = 0; m < 4; ++m)
#pragma unroll
                    for (int bj = 0; bj < 2; ++bj) *(v4u*)(v + (size_t)(row0 + ai * 128 + m * 16) * 128 + (wc - 2) * 64 + bj * 32 + 8 * fq) = pack8(acc[ai][bj][m][0], acc[ai][bj][m][1]);
            return true;
        }
        if (pn < 7) {
#pragma unroll
            for (int ai = 0; ai < 2; ++ai)
#pragma unroll
                for (int m = 0; m < 4; ++m)
#pragma unroll
                    for (int bj = 0; bj < 2; ++bj) { const f32x4 av = acc[ai][bj][m][0], bv = acc[ai][bj][m][1];
                        v2u w; w.x = pg8::cvt_pk_bf16(av[0] * fsigmoid(bv[0]), av[1] * fsigmoid(bv[1])); w.y = pg8::cvt_pk_bf16(av[2] * fsigmoid(bv[2]), av[3] * fsigmoid(bv[3]));
                        *(v2u*)(u + (size_t)(row0 + ai * 128 + m * 16) * 512 + 128 * (pn - 3) + 64 * bj + 16 * wc + 4 * fq) = w; }
            return true;
        }
        if (pn < 9) {
#pragma unroll
            for (int ai = 0; ai < 2; ++ai)
#pragma unroll
                for (int m = 0; m < 4; ++m)
#pragma unroll
                    for (int bj = 0; bj < 2; ++bj) *(v4u*)(xq + (size_t)(row0 + ai * 128 + m * 16) * 512 + (pn - 7) * 256 + bj * 128 + wc * 32 + 8 * fq) = pack8(acc[ai][bj][m][0], acc[ai][bj][m][1]);
            return true;
        }
        unsigned char* g8 = (unsigned char*)gates;
#pragma unroll
        for (int ai = 0; ai < 2; ++ai)
#pragma unroll
            for (int m = 0; m < 4; ++m)
#pragma unroll
                for (int bj = 0; bj < 2; ++bj) { const f32x4 a0 = acc[ai][bj][m][0], a1 = acc[ai][bj][m][1]; v2u w; w.x = 0u; w.y = 0u;
#pragma unroll
                    for (int e = 0; e < 4; ++e) { w.x = __builtin_amdgcn_cvt_pk_u8_f32(fmaxf(fsigmoid(a0[e]) * 255.f, 1.f), e, w.x); w.y = __builtin_amdgcn_cvt_pk_u8_f32(fmaxf(fsigmoid(a1[e]) * 255.f, 1.f), e, w.y); }
                    *(v2u*)(g8 + (size_t)(row0 + ai * 128 + m * 16) * 3072 + (pn - 9) * 256 + bj * 128 + wc * 32 + 8 * fq) = w; }
        return true;
    }
};

struct SchedP3 {
    __device__ __forceinline__ void a_ready(const pg8::Unit&) const {}
    int G, c; const char* acts; const char* Wo3;
    __device__ __forceinline__ bool next(int i, pg8::Unit& u) const {
        const int j = i / 3, b = i - 3 * j; const int L = j * G + c; int pm, pn;
        if (!pg8::static_tile(L, 64, 4, pm, pn)) return false;
        u.pm = pm; u.pn = pn; u.aux = b; u.ksplit = 1 << 30; u.ridx = nullptr;
        u.A = acts + (size_t)pm * 256 * 3072 + (size_t)b * 1024; u.B0 = Wo3 + (size_t)b * (1024 * 1024) + (size_t)pn * 256 * 1024; u.B1 = u.B0; return true;
    }
};
struct EpiP3 {
    static constexpr bool PERM = true, AFTER_DRAIN = false, PREFETCH = false;
    const unsigned char* gates; bf16* merged;
    __device__ __forceinline__ void prefetch(const pg8::Unit&, LAS unsigned char*, int) const {}
    static __device__ __forceinline__ f32x4 ub4(unsigned w) { return (f32x4){(float)(w & 255u), (float)((w >> 8) & 255u), (float)((w >> 16) & 255u), (float)(w >> 24)}; }
    __device__ __forceinline__ bool operator()(f32x4 (&acc)[2][2][4][2], const pg8::Unit& un, int wr, int wc, int fr, int fq) const {
        const int b = un.aux; const bool fin = b == 2;
        const __amdgpu_buffer_rsrc_t rg = __builtin_amdgcn_make_buffer_rsrc((void*)gates, 0, 0x7fffffff, 0x00020000);
        const int vg = fr * 3072 + 8 * fq, sg = (un.pm * 256 + wr * 64) * 3072 + b * 1024 + un.pn * 256 + wc * 32, db = fin ? 0 : 1024;
        v2u ga[2][2], gb[2][2];
#define EPI3_LD(g) do { const int so_ = sg + ((g >> 2) * 128 + (g & 3) * 16) * 3072; _Pragma("unroll") for (int bj = 0; bj < 2; ++bj) { \
            ga[(g) & 1][bj] = __builtin_amdgcn_raw_buffer_load_b64(rg, vg, so_ + bj * 128, 0); gb[(g) & 1][bj] = __builtin_amdgcn_raw_buffer_load_b64(rg, vg, so_ + bj * 128 + db, 0); } } while (0)
        EPI3_LD(0);
#pragma unroll
        for (int g = 0; g < 8; ++g) {
            if (g + 1 < 8) EPI3_LD(g + 1);
#pragma unroll
            for (int bj = 0; bj < 2; ++bj) {
                f32x4 s0 = ub4(ga[g & 1][bj].x), s1 = ub4(ga[g & 1][bj].y); const f32x4 d0 = ub4(gb[g & 1][bj].x), d1 = ub4(gb[g & 1][bj].y);
#pragma unroll
                for (int e = 0; e < 4; ++e) { s0[e] *= fin ? (1.f / 255.f) : __builtin_amdgcn_rcpf(d0[e]); s1[e] *= fin ? (1.f / 255.f) : __builtin_amdgcn_rcpf(d1[e]); }
                acc[g >> 2][bj][g & 3][0] *= s0; acc[g >> 2][bj][g & 3][1] *= s1; }
            __builtin_amdgcn_sched_barrier(0); }
#undef EPI3_LD
        if (fin) {
            const __amdgpu_buffer_rsrc_t rm = __builtin_amdgcn_make_buffer_rsrc((void*)merged, 0, 0x7fffffff, 0x00020000);
            const int vm = fr * 2048 + 16 * fq, sm = (un.pm * 256 + wr * 64) * 2048 + (un.pn * 256 + wc * 32) * 2;
#pragma unroll
            for (int ai = 0; ai < 2; ++ai)
#pragma unroll
                for (int m = 0; m < 4; ++m)
#pragma unroll
                    for (int bj = 0; bj < 2; ++bj)
                        __builtin_amdgcn_raw_buffer_store_b128(pack8(acc[ai][bj][m][0], acc[ai][bj][m][1]), rm, vm, sm + (ai * 128 + m * 16) * 2048 + bj * 256, 0);
        }
        return fin;
    }
};

struct SchedP4 {
    __device__ __forceinline__ void a_ready(const pg8::Unit&) const {}
    int G, c; const char* A; const char* W;
    __device__ __forceinline__ bool next(int i, pg8::Unit& u) const {
        const int L = i * G + c; int pm, pn; if (!pg8::static_tile(L, 64, 4, pm, pn)) return false;
        u.pm = pm; u.pn = pn; u.aux = 0; u.ksplit = 1 << 30; u.ridx = nullptr; u.A = A + (size_t)pm * 256 * 2048; u.B0 = W + (size_t)pn * 256 * 2048; u.B1 = u.B0; return true;
    }
};
struct EpiP4 {
    static constexpr bool PERM = false, AFTER_DRAIN = false, PREFETCH = false;
    const float* x; float* out;
    __device__ __forceinline__ bool operator()(f32x4 (&acc)[2][2][4][2], const pg8::Unit& un, int wr, int wc, int fr, int fq) const {
        const int row0 = un.pm * 256 + wr * 64 + fr, col0 = un.pn * 256 + wc * 32 + 4 * fq;
#pragma unroll
        for (int ai = 0; ai < 2; ++ai)
#pragma unroll
            for (int m = 0; m < 4; ++m) { const size_t off = (size_t)(row0 + ai * 128 + m * 16) * 1024 + col0;
#pragma unroll
                for (int bj = 0; bj < 2; ++bj)
#pragma unroll
                    for (int n = 0; n < 2; ++n) *(f32x4*)(out + off + bj * 128 + n * 16) = *(const f32x4*)(x + off + bj * 128 + n * 16) + acc[ai][bj][m][n]; }
        return true;
    }
};
constexpr size_t RT_TOKC = 0, RT_SWT = 1536 * 1024;
constexpr int CW_CCNT = 1024, CCNT_STRIDE = 64;
constexpr int TB_TOTAL = TAB_OFF, TB_TAB = TAB_OFF + 256;
typedef float f32x2v __attribute__((ext_vector_type(2)));
constexpr int WST = 2064;
__device__ __forceinline__ void route_token(const LAS float* lg, const float* bg, const float* br, int& cls, float& wa, float& wb) {
    float l0 = lg[0] + bg[0], l1 = lg[1] + bg[1], l2 = lg[2] + bg[2], l3 = lg[3] + bg[3];
    int gi = 0; float gm = l0;
    if (l1 > gm) { gm = l1; gi = 1; } if (l2 > gm) { gm = l2; gi = 2; } if (l3 > gm) { gm = l3; gi = 3; }
    const float pg = 1.f / (__expf(l0 - gm) + __expf(l1 - gm) + __expf(l2 - gm) + __expf(l3 - gm));
    const float e0 = lg[4 + gi * 4 + 0] + br[gi * 4 + 0], e1 = lg[4 + gi * 4 + 1] + br[gi * 4 + 1], e2 = lg[4 + gi * 4 + 2] + br[gi * 4 + 2], e3 = lg[4 + gi * 4 + 3] + br[gi * 4 + 3];
    int i1 = 0; float v1 = e0;
    if (e1 > v1) { v1 = e1; i1 = 1; } if (e2 > v1) { v1 = e2; i1 = 2; } if (e3 > v1) { v1 = e3; i1 = 3; }
    int i2 = -1; float v2 = -3.0e38f;
    if (i1 != 0 && e0 > v2) { v2 = e0; i2 = 0; } if (i1 != 1 && e1 > v2) { v2 = e1; i2 = 1; } if (i1 != 2 && e2 > v2) { v2 = e2; i2 = 2; } if (i1 != 3 && e3 > v2) { v2 = e3; i2 = 3; }
    const float q2 = __expf(v2 - v1), p1 = 1.f / (1.f + q2), p2 = q2 * p1;
    const int a = i1 < i2 ? i1 : i2, b = i1 < i2 ? i2 : i1;
    wa = pg * (i1 < i2 ? p1 : p2); wb = pg * (i1 < i2 ? p2 : p1);
    cls = gi * 6 + (a * (7 - a)) / 2 + (b - a - 1);
}
constexpr size_t WS_WRT = WS_ROUTE + 2 * MiB;
constexpr size_t WS_PART = WS_ACTS;
constexpr int CW_PCNT = 2600, CW_WDT = 2700;
#ifndef MK_GT
#define MK_GT -1
#endif
#define P4_TMARK(cat) do { if (MK_GT >= 0) { if (tid == 0) { LAS unsigned long long* ts_ = (LAS unsigned long long*)(lds - RING_OFF + PARG_OFF + 256); if (ts_[2]) { const unsigned long long t_ = __builtin_amdgcn_s_memrealtime(); ts_[4 + (cat)] += t_ - ts_[3]; ts_[3] = t_; } } } } while (0)
constexpr int WR_LST = 528;
struct EpiP4F {
    static constexpr bool PERM = false, AFTER_DRAIN = true, PREFETCH = false;
    __device__ __forceinline__ void prefetch(const pg8::Unit&, LAS unsigned char*, int) const {}
    const bf16* h; const float* rinv; bf16* h2; const float* g2; const bf16* WR; float* gpart; unsigned* ctl; const float* bg; const float* br; int* rtokc; f32x4* swt; const float* g1;
    __device__ __forceinline__ bool operator()(f32x4 (&)[2][2][4][2], const pg8::Unit&, int, int, int, int) const { return true; }
    __device__ __forceinline__ void fused(f32x4 (&acc)[2][2][4][2], const pg8::Unit& un, int wr, int wc, int fr, int fq, LAS unsigned char* lds, int wid, int lane) const {
        const int tid = wid * 64 + lane;
        { const v4u* src = (const v4u*)(WR + (size_t)un.pn * (2 * 32 * 256));
#pragma unroll
          for (int i = 0; i < 4; ++i) { const int L = tid + 512 * i; *(LAS v4u*)(lds + (L >> 5) * WR_LST + (L & 31) * 16) = src[L]; } }
        const int row0 = un.pm * 256 + wr * 64 + fr, col0 = un.pn * 256 + wc * 32 + 4 * fq;
        { f32x4 g2v[2][2];
#pragma unroll
          for (int bj = 0; bj < 2; ++bj)
#pragma unroll
              for (int n = 0; n < 2; ++n) g2v[bj][n] = *(const f32x4*)(g2 + col0 + bj * 128 + n * 16);
          f32x4 gi1[2][2]; float ri[8];
#pragma unroll
          for (int bj = 0; bj < 2; ++bj)
#pragma unroll
              for (int n = 0; n < 2; ++n) { const f32x4 g = *(const f32x4*)(g1 + col0 + bj * 128 + n * 16); gi1[bj][n] = (f32x4){1.f / g[0], 1.f / g[1], 1.f / g[2], 1.f / g[3]}; }
#pragma unroll
          for (int g = 0; g < 8; ++g) ri[g] = rinv[row0 + (g >> 2) * 128 + (g & 3) * 16];
          const __amdgpu_buffer_rsrc_t rx = __builtin_amdgcn_make_buffer_rsrc((void*)h, 0, 0x7fffffff, 0x00020000), rh = __builtin_amdgcn_make_buffer_rsrc((void*)h2, 0, 0x7fffffff, 0x00020000);
          const int vh = fr * 2048 + (wc * 32 + 4 * fq) * 2, sh = ((un.pm * 256 + wr * 64) * 1024 + un.pn * 256) * 2;
          v2u xb[3][2][2];
#define EPI4_LD(g) do { _Pragma("unroll") for (int bj = 0; bj < 2; ++bj) _Pragma("unroll") for (int n = 0; n < 2; ++n) \
              xb[(g) % 3][bj][n] = __builtin_amdgcn_raw_buffer_load_b64(rx, vh + bj * 256 + n * 32, sh + (((g) >> 2) * 128 + ((g) & 3) * 16) * 2048, 0); } while (0)
          EPI4_LD(0); EPI4_LD(1);
#pragma unroll
          for (int g = 0; g < 8; ++g) { const int ai = g >> 2, m = g & 3;
              if (g + 2 < 8) EPI4_LD(g + 2);
#pragma unroll
              for (int bj = 0; bj < 2; ++bj)
#pragma unroll
                  for (int n = 0; n < 2; ++n) { const v2u hx = xb[g % 3][bj][n];
                      const f32x4 v = (f32x4){bflo(hx.x), bfhi(hx.x), bflo(hx.y), bfhi(hx.y)} * gi1[bj][n] * ri[g] + acc[ai][bj][m][n]; acc[ai][bj][m][n] = v;
                      const f32x4 hv = v * g2v[bj][n];
                      v2u w; w.x = pg8::cvt_pk_bf16(hv[0], hv[1]); w.y = pg8::cvt_pk_bf16(hv[2], hv[3]);
                      __builtin_amdgcn_raw_buffer_store_b64(w, rh, vh + bj * 256 + n * 32, sh + (ai * 128 + m * 16) * 2048, 0); }
              __builtin_amdgcn_sched_barrier(0); }
#undef EPI4_LD
        }
        __syncthreads(); P4_TMARK(8);
        LAS float* P = (LAS float*)(lds + 36864);
#pragma unroll
        for (int ai = 0; ai < 2; ++ai)
#pragma unroll
            for (int m = 0; m < 4; ++m) { float ss = 0.f; f32x4 l0 = (f32x4){0.f, 0.f, 0.f, 0.f}, l1 = l0;
#pragma unroll
                for (int bj = 0; bj < 2; ++bj) { const f32x4 v0 = acc[ai][bj][m][0], v1 = acc[ai][bj][m][1];
                    ss += (v0[0] * v0[0] + v0[1] * v0[1]) + (v0[2] * v0[2] + v0[3] * v0[3]) + (v1[0] * v1[0] + v1[1] * v1[1]) + (v1[2] * v1[2] + v1[3] * v1[3]);
                    const v4u hi = pack8(v0, v1);
                    const v4u lo = pack8(v0 - (f32x4){bflo(hi.x), bfhi(hi.x), bflo(hi.y), bfhi(hi.y)}, v1 - (f32x4){bflo(hi.z), bfhi(hi.z), bflo(hi.w), bfhi(hi.w)});
                    const bf16x8 Bh = __builtin_bit_cast(bf16x8, hi), Bl = __builtin_bit_cast(bf16x8, lo);
                    const LAS unsigned char* wp = lds + fr * WR_LST + (bj * 4 + wc) * 64 + fq * 16;
                    const bf16x8 Ah0 = *(const LAS bf16x8*)wp, Ah1 = *(const LAS bf16x8*)(wp + 16 * WR_LST), Al0 = *(const LAS bf16x8*)(wp + 32 * WR_LST), Al1 = *(const LAS bf16x8*)(wp + 48 * WR_LST);
                    l0 = __builtin_amdgcn_mfma_f32_16x16x32_bf16(Ah0, Bh, l0, 0, 0, 0); l0 = __builtin_amdgcn_mfma_f32_16x16x32_bf16(Ah0, Bl, l0, 0, 0, 0); l0 = __builtin_amdgcn_mfma_f32_16x16x32_bf16(Al0, Bh, l0, 0, 0, 0);
                    l1 = __builtin_amdgcn_mfma_f32_16x16x32_bf16(Ah1, Bh, l1, 0, 0, 0); l1 = __builtin_amdgcn_mfma_f32_16x16x32_bf16(Ah1, Bl, l1, 0, 0, 0); l1 = __builtin_amdgcn_mfma_f32_16x16x32_bf16(Al1, Bh, l1, 0, 0, 0); }
                ss += shx(ss, 16); ss += shx(ss, 32);
                LAS float* pr = P + (ai * 128 + wr * 64 + m * 16 + fr) * 100 + wc * 24;
                *(LAS f32x4*)(pr + 4 * fq) = l0;
                if (fq == 0) *(LAS f32x4*)(pr + 16) = l1;
                if (fq == 1) *(LAS f32x4*)(pr + 20) = (f32x4){ss, 0.f, 0.f, 0.f}; }
        __syncthreads(); P4_TMARK(9);
        float* gp = gpart + (size_t)(un.pm * 4 + un.pn) * (256 * 24);
        { const int row = tid >> 1, half = tid & 1;
#pragma unroll
          for (int q = 0; q < 3; ++q) { const LAS float* pr = P + row * 100 + half * 12 + 4 * q;
              const f32x4 s = ((*(const LAS f32x4*)pr + *(const LAS f32x4*)(pr + 24)) + *(const LAS f32x4*)(pr + 48)) + *(const LAS f32x4*)(pr + 72);
              unsigned long long* g8 = (unsigned long long*)(gp + row * 24 + half * 12 + 4 * q);
              __hip_atomic_store(g8, ((unsigned long long)__float_as_uint(s[1]) << 32) | __float_as_uint(s[0]), __ATOMIC_RELAXED, __HIP_MEMORY_SCOPE_AGENT);
              __hip_atomic_store(g8 + 1, ((unsigned long long)__float_as_uint(s[3]) << 32) | __float_as_uint(s[2]), __ATOMIC_RELAXED, __HIP_MEMORY_SCOPE_AGENT); } }
        asm volatile("s_waitcnt vmcnt(0)" ::: "memory");
        __syncthreads(); P4_TMARK(10);
        if (tid == 0) {
            const unsigned old = __hip_atomic_fetch_add(ctl + CW_PCNT + un.pm, 1u, __ATOMIC_RELAXED, __HIP_MEMORY_SCOPE_AGENT);
            if (old == 3u) { __builtin_amdgcn_fence(__ATOMIC_ACQUIRE, "agent"); asm volatile("s_waitcnt vmcnt(0)" ::: "memory"); }
            *(LAS unsigned*)lds = old; }
        __syncthreads();
        const unsigned old = (unsigned)__builtin_amdgcn_readfirstlane((int)*(const LAS unsigned*)lds);
        __syncthreads(); P4_TMARK(11);
        if (old == 3u) {
            LAS int* hist = (LAS int*)(lds + 512); LAS int* cbase = (LAS int*)(lds + 768);
            if (tid < 32) hist[tid] = 0;
            __syncthreads();
            int cls = 0, rank = 0; float wa = 0.f, wb = 0.f, r = 0.f;
            if (tid < 256) {
                f32x4 s[6];
#pragma unroll
                for (int q = 0; q < 6; ++q) s[q] = (f32x4){0.f, 0.f, 0.f, 0.f};
                const float* pp = gpart + (size_t)(un.pm * 4) * (256 * 24) + tid * 24;
#pragma unroll
                for (int t4 = 0; t4 < 4; ++t4)
#pragma unroll
                    for (int q = 0; q < 6; ++q) s[q] += *(const f32x4*)(pp + (size_t)t4 * (256 * 24) + 4 * q);
                r = rsqrtf(s[5][0] * (1.f / 1024.f) + 1e-6f);
                LAS float* lg = (LAS float*)(lds + 1024) + tid * 24;
#pragma unroll
                for (int q = 0; q < 5; ++q) *(LAS f32x4*)(lg + 4 * q) = s[q] * r;
                route_token(lg, bg, br, cls, wa, wb);
                rank = __hip_atomic_fetch_add(hist + cls, 1, __ATOMIC_RELAXED, __HIP_MEMORY_SCOPE_WORKGROUP);
            }
            __syncthreads();
            if (tid < 24) cbase[tid] = (int)__hip_atomic_fetch_add(ctl + CW_CCNT + CCNT_STRIDE * tid, (unsigned)hist[tid], __ATOMIC_RELAXED, __HIP_MEMORY_SCOPE_AGENT);
            __syncthreads();
            if (tid < 256) { const int token = un.pm * 256 + tid; rtokc[cls * T + cbase[cls] + rank] = token; swt[token] = (f32x4){wa, wb, r, 0.f}; } P4_TMARK(12);
        }
    }
};
__device__ __forceinline__ void class_experts(int c, int& ea, int& eb) {
    const int g = c / 6, p = c - 6 * g; const int a = p < 3 ? 0 : (p < 5 ? 1 : 2), b = p < 3 ? p + 1 : (p < 5 ? p - 1 : 3); ea = g * 4 + a; eb = g * 4 + b;
}
__device__ __forceinline__ void moe_tables(Frame& F) {
    const int tid_ = F.ftid(), lane_ = tid_ & 63; (void)lane_;
    LAS int* total = (LAS int*)(F.lds + TB_TOTAL); LAS int* tab = (LAS int*)(F.lds + TB_TAB);
    if (tid_ < 24) total[tid_] = (int)__hip_atomic_load((unsigned*)(F.ws() + WS_CTL) + CW_CCNT + CCNT_STRIDE * tid_, __ATOMIC_RELAXED, __HIP_MEMORY_SCOPE_AGENT);
    __syncthreads();
    if (tid_ == 0) { int tb = 0;
        for (int c = 0; c < 24; ++c) { const int nt_ = (total[c] + 255) >> 8; for (int r = 0; r < nt_; ++r) tab[1 + tb + r] = c | (r << 8); tb += nt_; }
        tab[0] = tb; }
    __syncthreads();
}
constexpr int CW_RT = 16384, RT_STRIDE = 64;
struct SchedP7 {
    __device__ __forceinline__ void a_ready(const pg8::Unit&) const {}
    int G, vcu; const LAS int* tab; const LAS int* total; const char* h2; const char* Wgu; const int* rtokc; int first, nmax;
    __device__ __forceinline__ bool next(int i, pg8::Unit& u) const {
        const int L = first + i * G + vcu, R = tab[0]; if (i >= nmax || L >= R * 8) return false;
        const int r = L >> 3, pn = L & 7, tv = tab[1 + r], c = tv & 255, rp = tv >> 8; int ea, eb; class_experts(c, ea, eb); const int e = pn < 4 ? ea : eb;
        const int nv = total[c] - 256 * rp;
        u.pm = r; u.pn = pn; u.aux = nv < 256 ? nv : 256; u.ksplit = 1 << 30; u.A = h2; u.ridx = rtokc + c * T + 256 * rp;
        u.B0 = Wgu + (size_t)e * (1024 * 2048) + (size_t)(pn & 3) * 256 * 2048; u.B1 = u.B0; return true;
    }
};
struct EpiP7 {
    static constexpr bool PERM = true, AFTER_DRAIN = false, PREFETCH = false;
    bf16* hid; const f32x4* swt; unsigned* ctl;
    __device__ __forceinline__ bool operator()(f32x4 (&acc)[2][2][4][2], const pg8::Unit& un, int wr, int wc, int fr, int fq) const {
        const int rl0 = wr * 64 + fr, sel = un.pn >> 2, col0 = sel * 512 + 128 * (un.pn & 3) + 16 * wc + 4 * fq, last = un.aux - 1;
        const __amdgpu_buffer_rsrc_t rs = __builtin_amdgcn_make_buffer_rsrc((void*)swt, 0, 0x7fffffff, 0x00020000);
        int tok[8]; float w[8], r[8];
#pragma unroll
        for (int g = 0; g < 8; ++g) { const int rl = rl0 + (g >> 2) * 128 + (g & 3) * 16; tok[g] = un.ridx[rl < last ? rl : last]; }
#pragma unroll
        for (int g = 0; g < 8; ++g) { w[g] = __builtin_bit_cast(float, __builtin_amdgcn_raw_buffer_load_b32(rs, tok[g] * 16, sel * 4, 0)); r[g] = __builtin_bit_cast(float, __builtin_amdgcn_raw_buffer_load_b32(rs, tok[g] * 16 + 8, 0, 0)); }
        __builtin_amdgcn_sched_barrier(0);
#pragma unroll
        for (int g = 0; g < 8; ++g) { const int ai = g >> 2, m = g & 3, rl = rl0 + ai * 128 + m * 16; const bool ok = rl <= last; const float rr = ok ? r[g] : 0.f, rw = ok ? r[g] * w[g] : 0.f;
#pragma unroll
            for (int bj = 0; bj < 2; ++bj) { const f32x4 gv = acc[ai][bj][m][0] * rr, uv = acc[ai][bj][m][1] * rw; f32x4 hh;
#pragma unroll
                for (int e = 0; e < 4; ++e) hh[e] = gv[e] * fsigmoid(gv[e]) * uv[e];
                v2u o; o.x = pg8::cvt_pk_bf16(hh[0], hh[1]); o.y = pg8::cvt_pk_bf16(hh[2], hh[3]);
                *(v2u*)(hid + (size_t)(un.pm * 256 + rl) * 1024 + col0 + 64 * bj) = o; } }
        return true;
    }
};
struct SchedP8 {
    int G, vcu; const LAS int* tab; const LAS int* total; const char* hid; const char* WdT; const int* rtokc; unsigned* ctl; int first, nmax;
    __device__ __forceinline__ bool next(int i, pg8::Unit& u) const {
        const int L = first + i * G + vcu, R = tab[0]; if (i >= nmax || L < 0 || L >= R * 4) return false;
        const int r = L >> 2, pn = L & 3, tv = tab[1 + r], c = tv & 255, rp = tv >> 8; int ea, eb; class_experts(c, ea, eb);
        const int nv = total[c] - 256 * rp;
        u.pm = r; u.pn = pn; u.aux = nv < 256 ? nv : 256; u.ksplit = 8; u.A = hid + (size_t)r * 256 * 2048; u.ridx = rtokc + c * T + 256 * rp;
        u.B0 = WdT + (size_t)ea * (1024 * 1024) + (size_t)pn * 256 * 1024; u.B1 = WdT + (size_t)eb * (1024 * 1024) + (size_t)pn * 256 * 1024; return true;
    }
    __device__ __forceinline__ void a_ready(const pg8::Unit&) const {}
};
struct EpiP8 {
    static constexpr bool PERM = false, AFTER_DRAIN = false, PREFETCH = false;
    float* out; const bf16* h2; const float* g2;
    __device__ __forceinline__ bool operator()(f32x4 (&acc)[2][2][4][2], const pg8::Unit& un, int wr, int wc, int fr, int fq) const {
        const int rl0 = wr * 64 + fr, col0 = un.pn * 256 + wc * 32 + 4 * fq, last = un.aux - 1;
        const __amdgpu_buffer_rsrc_t rh = __builtin_amdgcn_make_buffer_rsrc((void*)h2, 0, 0x7fffffff, 0x00020000), ro = __builtin_amdgcn_make_buffer_rsrc((void*)out, 0, T * 1024 * 4, 0x00020000);
        int tok[8];
#pragma unroll
        for (int g = 0; g < 8; ++g) { const int rl = rl0 + (g >> 2) * 128 + (g & 3) * 16; tok[g] = un.ridx[rl < last ? rl : last]; }
        f32x4 gi[2][2];
#pragma unroll
        for (int bj = 0; bj < 2; ++bj)
#pragma unroll
            for (int n = 0; n < 2; ++n) { const f32x4 g = *(const f32x4*)(g2 + col0 + bj * 128 + n * 16); gi[bj][n] = (f32x4){1.f / g[0], 1.f / g[1], 1.f / g[2], 1.f / g[3]}; }
        v2u hw[2][2][2];
#define EPI8_LD(g) do { const int vo_ = tok[g] * 2048 + col0 * 2; _Pragma("unroll") for (int bj = 0; bj < 2; ++bj) _Pragma("unroll") for (int n = 0; n < 2; ++n) \
            hw[(g) & 1][bj][n] = __builtin_amdgcn_raw_buffer_load_b64(rh, vo_ + bj * 256 + n * 32, 0, 0); } while (0)
        EPI8_LD(0);
#pragma unroll
        for (int g = 0; g < 8; ++g) { const int ai = g >> 2, m = g & 3, rl = rl0 + ai * 128 + m * 16;
            if (g + 1 < 8) EPI8_LD(g + 1);
            const int so = rl <= last ? tok[g] * 4096 + col0 * 4 : 0x70000000;
#pragma unroll
            for (int bj = 0; bj < 2; ++bj)
#pragma unroll
                for (int n = 0; n < 2; ++n) { const v2u h = hw[g & 1][bj][n];
                    const f32x4 xm = (f32x4){bflo(h.x), bfhi(h.x), bflo(h.y), bfhi(h.y)} * gi[bj][n] + acc[ai][bj][m][n];
                    __builtin_amdgcn_raw_buffer_store_b128(__builtin_bit_cast(v4u, xm), ro, so + bj * 512 + n * 64, 0, 0); }
            __builtin_amdgcn_sched_barrier(0); }
#undef EPI8_LD
        return true;
    }
};
constexpr int KST64 = 144, KST128 = 272, VST = 528;
template <int DH, bool SWA>
__device__ __forceinline__ void attn256_mtile(const LAS unsigned char* Kl, const LAS unsigned char* Vl, const bf16x8 (&qf)[DH / 32], bf16* orow0, int ldo,
                                              float sink_l2, int i0, bool has_prev, int lane) {
    constexpr int KST = DH * 2 + 16, NKS = DH / 32, NDT = DH / 16;
    const int qi = lane & 15, g = lane >> 4;
    float ssq = 0.f;
#pragma unroll
    for (int ks = 0; ks < NKS; ++ks) {
        if (!SWA) {
#pragma unroll
            for (int e = 0; e < 8; ++e) { const float x = bf2f((bf16)qf[ks][e]); ssq += x * x; } } }
    float sc;
    if (SWA) sc = 0.125f * 1.4426950408889634f;
    else { ssq += shx(ssq, 16); ssq += shx(ssq, 32); sc = rsqrtf(ssq * (1.f / 128.f) + 1e-6f) * (0.08838834764831845f * 1.4426950408889634f); }
    f32x4 sacc[SWA ? 5 : 8][2];
    const int krow = 8 * (qi >> 2) + (qi & 3);
    constexpr int NS = SWA ? 5 : 8; const int sbase = SWA ? (i0 + 1) >> 5 : 0;
#pragma unroll
    for (int s = 0; s < NS; ++s)
#pragma unroll
        for (int h = 0; h < 2; ++h) { f32x4 c = (f32x4){0.f, 0.f, 0.f, 0.f}; const LAS unsigned char* kp = Kl + (32 * (sbase + s) + krow + 4 * h) * KST + 16 * g;
#pragma unroll
            for (int ks = 0; ks < NKS; ++ks) c = __builtin_amdgcn_mfma_f32_16x16x32_bf16(*(const LAS bf16x8*)(kp + 64 * ks), qf[ks], c, 0, 0, 0);
            sacc[s][h] = c; if (h == 1) __builtin_amdgcn_sched_barrier(0); }
    float mr = -3.0e38f;
#pragma unroll
    for (int s = 0; s < NS; ++s) {
        if (SWA && (s == 0 || s == NS - 1 || !has_prev)) {
#pragma unroll
            for (int h = 0; h < 2; ++h)
#pragma unroll
                for (int r = 0; r < 4; ++r) { const int kb = 32 * (sbase + s) + 8 * g + 4 * h + r, delta = 128 + i0 + qi - kb; const bool ok = (delta >= 0) && (delta < 128) && (has_prev || kb >= 128);
                    sacc[s][h][r] = ok ? sacc[s][h][r] : -1.0e30f; } }
#pragma unroll
        for (int h = 0; h < 2; ++h) mr = fmaxf(fmaxf(mr, fmaxf(sacc[s][h][0], sacc[s][h][1])), fmaxf(sacc[s][h][2], sacc[s][h][3])); }
    mr = fmaxf(mr, shx(mr, 16)); mr = fmaxf(mr, shx(mr, 32));
    float m = mr * sc; if (SWA) m = fmaxf(m, sink_l2);
    float sum = 0.f;
#pragma unroll
    for (int s = 0; s < NS; ++s)
#pragma unroll
        for (int h = 0; h < 2; ++h)
#pragma unroll
            for (int r = 0; r < 4; ++r) { const float p = __builtin_amdgcn_exp2f(__builtin_fmaf(sacc[s][h][r], sc, -m)); sacc[s][h][r] = p; sum += p; }
    sum += shx(sum, 16); sum += shx(sum, 32);
    if (SWA) sum += __builtin_amdgcn_exp2f(sink_l2 - m);
    const float inv = 1.f / sum;
    bf16x8 pf[NS];
#pragma unroll
    for (int s = 0; s < NS; ++s) { v4u w; w.x = pg8::cvt_pk_bf16(sacc[s][0][0], sacc[s][0][1]); w.y = pg8::cvt_pk_bf16(sacc[s][0][2], sacc[s][0][3]);
        w.z = pg8::cvt_pk_bf16(sacc[s][1][0], sacc[s][1][1]); w.w = pg8::cvt_pk_bf16(sacc[s][1][2], sacc[s][1][3]); pf[s] = __builtin_bit_cast(bf16x8, w); }
#pragma unroll
    for (int dt = 0; dt < NDT; dt += 2) { f32x4 o0 = (f32x4){0.f, 0.f, 0.f, 0.f}, o1 = o0;
        const LAS unsigned char* vp = Vl + (16 * dt + qi) * VST + 16 * g + 64 * sbase;
#pragma unroll
        for (int s = 0; s < NS; ++s) { o0 = __builtin_amdgcn_mfma_f32_16x16x32_bf16(*(const LAS bf16x8*)(vp + 64 * s), pf[s], o0, 0, 0, 0);
            o1 = __builtin_amdgcn_mfma_f32_16x16x32_bf16(*(const LAS bf16x8*)(vp + 16 * VST + 64 * s), pf[s], o1, 0, 0, 0); }
        v2u w; w.x = pg8::cvt_pk_bf16(o0[0] * inv, o0[1] * inv); w.y = pg8::cvt_pk_bf16(o0[2] * inv, o0[3] * inv);
        *(v2u*)(orow0 + (size_t)qi * ldo + 16 * dt + 4 * g) = w;
        w.x = pg8::cvt_pk_bf16(o1[0] * inv, o1[1] * inv); w.y = pg8::cvt_pk_bf16(o1[2] * inv, o1[3] * inv);
        *(v2u*)(orow0 + (size_t)qi * ldo + 16 * dt + 16 + 4 * g) = w; __builtin_amdgcn_sched_barrier(0); }
}
template <int DH>
__device__ __forceinline__ void vt_load(v4u (&va)[DH / 32], v4u (&vb)[DH / 32], const bf16* vsrc, int ldv, int kmin, int tid) {
    constexpr int NC = DH / 8;
#pragma unroll
    for (int i = 0; i < DH / 32; ++i) { const int id = tid + 512 * i, c = id % NC, kp = id / NC; const bool ok = 2 * kp >= kmin; const int r = ok ? 2 * kp : kmin;
        const v4u a = *(const v4u*)(vsrc + (long)r * ldv + 8 * c), b = *(const v4u*)(vsrc + (long)(r + 1) * ldv + 8 * c);
        va[i] = ok ? a : (v4u){0u, 0u, 0u, 0u}; vb[i] = ok ? b : (v4u){0u, 0u, 0u, 0u}; }
}
template <int DH>
__device__ __forceinline__ void vt_store(LAS unsigned char* Vl, const v4u (&va)[DH / 32], const v4u (&vb)[DH / 32], int tid) {
    constexpr int NC = DH / 8;
#pragma unroll
    for (int i = 0; i < DH / 32; ++i) { const int id = tid + 512 * i, c = id % NC, kp = id / NC; LAS unsigned char* dst = Vl + (8 * c) * VST + 4 * kp;
        const unsigned aw[4] = {va[i].x, va[i].y, va[i].z, va[i].w}, bw[4] = {vb[i].x, vb[i].y, vb[i].z, vb[i].w};
#pragma unroll
        for (int e = 0; e < 4; ++e) { *(LAS unsigned*)(dst + (2 * e) * VST) = (aw[e] & 0xffffu) | (bw[e] << 16); *(LAS unsigned*)(dst + (2 * e + 1) * VST) = (aw[e] >> 16) | (bw[e] & 0xffff0000u); } }
}
struct SwaRegs { bf16x8 qa[4][2]; v4u kr[4]; v4u va[2], vb[2]; };
__device__ __forceinline__ void swa_load(Frame& F, int u, SwaRegs& R) {
    const int tid_ = F.ftid(), lane_ = tid_ & 63;
    const int hk = u & 1, n = (u >> 1) & 63, b = u >> 7;
    unsigned char* dout = (unsigned char*)F.out();
    const bf16* q = (const bf16*)(dout + DO_Q); const bf16* k = (const bf16*)(dout + DO_K); const bf16* v = (const bf16*)(dout + DO_V);
    const int rowb = b * SEQ + 128 * (n - 1), kmin = (n == 0) ? 128 : 0;
    const int hq = 4 * hk + (F.wave >> 1), r0 = 64 * (F.wave & 1);
#pragma unroll
    for (int mt = 0; mt < 4; ++mt)
#pragma unroll
        for (int ks = 0; ks < 2; ++ks) R.qa[mt][ks] = *(const bf16x8*)(q + ((size_t)b * SEQ + 128 * n + r0 + 16 * mt + (lane_ & 15)) * 512 + hq * 64 + 8 * (lane_ >> 4) + 32 * ks);
#pragma unroll
    for (int i = 0; i < 4; ++i) { const int id = tid_ + 512 * i, key = id >> 3, c = id & 7; const bool ok = key >= kmin;
        const v4u w = *(const v4u*)(k + ((long)(rowb + (ok ? key : kmin)) * 128 + hk * 64 + 8 * c)); R.kr[i] = ok ? w : (v4u){0u, 0u, 0u, 0u}; }
    vt_load<64>(R.va, R.vb, v + ((long)rowb * 128 + hk * 64), 128, kmin, tid_);
}
__device__ __forceinline__ void swa_run(Frame& F, int u, const SwaRegs& R) {
    const int tid_ = F.ftid(), lane_ = tid_ & 63;
    const int hk = u & 1, n = (u >> 1) & 63, b = u >> 7;
    bf16* acts = (bf16*)(F.ws() + WS_ACTS);
    LAS unsigned char* Kl = F.lds; LAS unsigned char* Vl = F.lds + 256 * KST64;
    const int hq = 4 * hk + (F.wave >> 1), r0 = 64 * (F.wave & 1);
#pragma unroll
    for (int i = 0; i < 4; ++i) { const int id = tid_ + 512 * i, key = id >> 3, c = id & 7; *(LAS v4u*)(Kl + key * KST64 + 16 * c) = R.kr[i]; }
    vt_store<64>(Vl, R.va, R.vb, tid_);
    __syncthreads();
    const float sink_l2 = F.in(7)[hq] * 1.4426950408889634f;
#pragma unroll
    for (int mt = 0; mt < 4; ++mt) { const int i0 = r0 + 16 * mt; const size_t tok0 = (size_t)b * SEQ + 128 * n + i0;
        attn256_mtile<64, true>(Kl, Vl, R.qa[mt], acts + tok0 * 1536 + hq * 64, 1536, sink_l2, i0, n > 0, lane_); }
    __syncthreads();
}
struct XatRegs { bf16x8 qa[2][4]; v4u kr[8]; v4u va[4], vb[4]; };
__device__ __forceinline__ void xattn_load(Frame& F, int u, XatRegs& R) {
    const int tid_ = F.ftid(), lane_ = tid_ & 63;
    const int qb = u & 31, h = (u >> 5) & 3, b = u >> 7;
    const bf16* mkv = (const bf16*)(F.ws() + WS_MKV); const bf16* xq = (const bf16*)(F.ws() + WS_XQ);
#pragma unroll
    for (int mt = 0; mt < 2; ++mt)
#pragma unroll
        for (int ks = 0; ks < 4; ++ks) R.qa[mt][ks] = *(const bf16x8*)(xq + ((size_t)b * SEQ + 256 * qb + 32 * F.wave + 16 * mt + (lane_ & 15)) * 512 + h * 128 + 8 * (lane_ >> 4) + 32 * ks);
    const int c = tid_ & 15;
#pragma unroll
    for (int i = 0; i < 8; ++i) { const int key = (tid_ >> 4) + 32 * i; R.kr[i] = *(const v4u*)(mkv + (size_t)(b * 256 + key) * 1024 + h * 128 + 8 * c); }
    vt_load<128>(R.va, R.vb, mkv + (size_t)(b * 256) * 1024 + 512 + h * 128, 1024, 0, tid_);
}
__device__ __forceinline__ void xattn_run(Frame& F, int u, const XatRegs& R) {
    const int tid_ = F.ftid(), lane_ = tid_ & 63;
    const int qb = u & 31, h = (u >> 5) & 3, b = u >> 7;
    bf16* acts = (bf16*)(F.ws() + WS_ACTS);
    LAS unsigned char* Kl = F.lds; LAS unsigned char* Vl = F.lds + 256 * KST128;
    { const int c = tid_ & 15; const f32x4 ga = *(const f32x4*)(F.in(17) + 8 * c), gb = *(const f32x4*)(F.in(17) + 8 * c + 4), qa = *(const f32x4*)(F.in(16) + 8 * c), qc = *(const f32x4*)(F.in(16) + 8 * c + 4);
      const f32x4 g0 = ga * qa, g1 = gb * qc;
#pragma unroll
      for (int i = 0; i < 8; ++i) { const int key = (tid_ >> 4) + 32 * i; const v4u w = R.kr[i];
          f32x4 x0 = (f32x4){bflo(w.x), bfhi(w.x), bflo(w.y), bfhi(w.y)}, x1 = (f32x4){bflo(w.z), bfhi(w.z), bflo(w.w), bfhi(w.w)};
          float ss = (x0[0] * x0[0] + x0[1] * x0[1]) + (x0[2] * x0[2] + x0[3] * x0[3]) + (x1[0] * x1[0] + x1[1] * x1[1]) + (x1[2] * x1[2] + x1[3] * x1[3]);
          ss += shx(ss, 1); ss += shx(ss, 2); ss += shx(ss, 4); ss += shx(ss, 8);
          const float r = rsqrtf(ss * (1.f / 128.f) + 1e-6f); x0 = x0 * r * g0; x1 = x1 * r * g1;
          *(LAS v4u*)(Kl + key * KST128 + 16 * c) = pack8(x0, x1); } }
    vt_store<128>(Vl, R.va, R.vb, tid_);
    __syncthreads();
#pragma unroll
    for (int mt = 0; mt < 2; ++mt) { const size_t tok0 = (size_t)b * SEQ + 256 * qb + 32 * F.wave + 16 * mt;
        attn256_mtile<128, false>(Kl, Vl, R.qa[mt], acts + tok0 * 1536 + 1024 + h * 128, 1536, 0.f, 0, true, lane_); }
    __syncthreads();
}
__device__ __forceinline__ void conv_load(Frame& F, int cu, v4u (&pre)[8]) {
    const int tid_ = F.ftid(); const bf16* u = (const bf16*)(F.ws() + WS_U);
    const int t0 = 32 * cu, s0 = t0 & (SEQ - 1);
#pragma unroll
    for (int i = 0; i < 8; ++i) { const int id = tid_ + 512 * i, j0 = id >> 6, c = id & 63, j = j0 < 62 ? j0 : 61; const bool ok = s0 - 30 + j >= 0;
        const v4u w = *(const v4u*)(u + (long)(t0 - 30 + (ok ? j : 30)) * 512 + 8 * c); pre[i] = ok ? w : (v4u){0u, 0u, 0u, 0u}; }
}
__device__ __forceinline__ void conv_run(Frame& F, int cu, const v4u (&pre)[8]) {
    const int tid_ = F.ftid(), lane_ = tid_ & 63;
    bf16* acts = (bf16*)(F.ws() + WS_ACTS);
    LAS unsigned char* Ul = F.lds; LAS float* Yl = (LAS float*)(F.lds + 62 * 1024);
    const int t0 = 32 * cu;
#pragma unroll
    for (int i = 0; i < 8; ++i) { const int id = tid_ + 512 * i, j = id >> 6, c = id & 63; if (id < 62 * 64) *(LAS v4u*)(Ul + j * 1024 + 16 * c) = pre[i]; }
    __syncthreads();
    { const int cp = tid_ & 255, th = tid_ >> 8;
      const float* wdw = F.in(9); const float2 bias = *(const float2*)(F.in(10) + 2 * cp);
      f32x2v w[31];
#pragma unroll
      for (int j = 0; j < 31; ++j) { const float2 t = *(const float2*)(wdw + j * 512 + 2 * cp); w[j] = (f32x2v){t.x, t.y}; }
#pragma unroll 1
      for (int ch = 0; ch < 2; ++ch) { const int i0 = 16 * th + 8 * ch;
          f32x2v acc[8];
#pragma unroll
          for (int i = 0; i < 8; ++i) acc[i] = (f32x2v){bias.x, bias.y};
#pragma unroll
          for (int r = 0; r < 38; ++r) { const unsigned x = *(const LAS unsigned*)(Ul + (i0 + r) * 1024 + 4 * cp); const f32x2v xv = (f32x2v){bflo(x), bfhi(x)};
#pragma unroll
              for (int i = 0; i < 8; ++i) { const int j = r - i; if (j >= 0 && j < 31) acc[i] = __builtin_elementwise_fma(w[j], xv, acc[i]); } }
#pragma unroll
          for (int i = 0; i < 8; ++i) *(LAS f32x2v*)(Yl + (i0 + i) * 512 + 2 * cp) = acc[i]; }
    }
    __syncthreads();
    { const int lane = lane_; const f32x4 ga = *(const f32x4*)(F.in(11) + 8 * lane), gb = *(const f32x4*)(F.in(11) + 8 * lane + 4), ba = *(const f32x4*)(F.in(12) + 8 * lane), bb = *(const f32x4*)(F.in(12) + 8 * lane + 4);
#pragma unroll
      for (int i = 0; i < 4; ++i) { const int tk = 4 * F.wave + i; const f32x4 y0 = *(const LAS f32x4*)(Yl + tk * 512 + 8 * lane), y1 = *(const LAS f32x4*)(Yl + tk * 512 + 8 * lane + 4);
          const float mean = wave_sum((y0[0] + y0[1]) + (y0[2] + y0[3]) + (y1[0] + y1[1]) + (y1[2] + y1[3])) * (1.f / 512.f);
          const f32x4 d0 = y0 - mean, d1 = y1 - mean;
          const float var = wave_sum((d0[0] * d0[0] + d0[1] * d0[1]) + (d0[2] * d0[2] + d0[3] * d0[3]) + (d1[0] * d1[0] + d1[1] * d1[1]) + (d1[2] * d1[2] + d1[3] * d1[3])) * (1.f / 512.f);
          const float rstd = rsqrtf(var + 1e-5f);
          f32x4 z0 = d0 * rstd * ga + ba, z1 = d1 * rstd * gb + bb;
#pragma unroll
          for (int e = 0; e < 4; ++e) { z0[e] = z0[e] * fsigmoid(z0[e]); z1[e] = z1[e] * fsigmoid(z1[e]); }
          *(v4u*)(acts + (size_t)(t0 + tk) * 1536 + 512 + 8 * lane) = pack8(z0, z1); } }
    __syncthreads();
}
__device__ __forceinline__ void p2_mixers(Frame& F) {
    for (int u = F.vcu; u < 256; u += F.G) {
        v4u c1[8], c2[8]; conv_load(F, 2 * u, c1); conv_load(F, 2 * u + 1, c2);
        SwaRegs S; TSUB_BEG(0) conv_run(F, 2 * u, c1); TSUB_END(0) swa_load(F, u, S);
        TSUB_BEG(1) conv_run(F, 2 * u + 1, c2); TSUB_END(1)
        XatRegs X; xattn_load(F, u, X);
        TSUB_BEG(2) swa_run(F, u, S); TSUB_END(2)
        TSUB_BEG(3) xattn_run(F, u, X); TSUB_END(3)
    }
}
__global__ void __launch_bounds__(NWAVES * 64, 2) mk_fwd(Args args) {
    extern __shared__ __attribute__((aligned(16))) unsigned char lds[];
    Frame F;
    F.lds = (LAS unsigned char*)lds;
    F.MISC = (volatile LAS unsigned*)(F.lds + MISC_OFF);
    const int tid_ = F.ftid(); F.wave = __builtin_amdgcn_readfirstlane(tid_ >> 6);
    F.G = gridDim.x; { const int bx = blockIdx.x; F.vcu = (F.G % 8 == 0) ? (bx % 8) * (F.G / 8) + bx / 8 : bx; }
    F.ctl = (gu32*)(args.ws + WS_CTL);
    for (int u = tid_; u < (LDS_BYTES - LDSCTL_OFF) / 4; u += NWAVES * 64) ((LAS unsigned*)(F.lds + LDSCTL_OFF))[u] = 0u;
    __syncthreads();
    if (tid_ < 30) ((LAS unsigned long long*)(F.lds + PARG_OFF))[tid_] = tid_ < 28 ? (unsigned long long)args.in[tid_] : (tid_ == 28 ? (unsigned long long)args.out : (unsigned long long)args.ws);
    __syncthreads();
    XcdBarrier bar = xcd_barrier_post((unsigned*)(F.ctl + CW_BAR) + args.li * XCD_BAR_WORDS, F.MISC + 8);
    const int lo = args.ph_lo, hi = args.ph_hi;
#define IN(k) (lo <= (k) && (k) < hi)
#define BOTH(k) (IN(k) && IN((k) + 1))

#ifndef MK_REP
#define MK_REP 0
#endif
#ifndef MK_XBAR
#define MK_XBAR 0
#endif
#ifndef MK_TPROBE
#define MK_TPROBE -1
#endif
    unsigned long long tp0 = 0, tp1 = 0;
#define RUN(kk, BODY) if (IN(kk)) { if (MK_TPROBE == (kk)) tp0 = __builtin_amdgcn_s_memrealtime(); BODY if (BOTH(kk) || MK_TPROBE == (kk)) xcd_barrier(bar); if (MK_TPROBE == (kk)) tp1 = __builtin_amdgcn_s_memrealtime(); }
#define PH0 { p0_prologue(F); }
#define PH1 { unsigned char* ws = F.ws(); unsigned char* dout = (unsigned char*)F.out(); SchedP1 S{F.G, (int)blockIdx.x, (const char*)(dout + DO_H), (const char*)(ws + WS_W1), (const char*)(ws + WS_MEMN), (const char*)(ws + WS_WKV)}; \
        EpiP1 E{(bf16*)(dout + DO_Q), (bf16*)(dout + DO_K), (bf16*)(dout + DO_V), (bf16*)(ws + WS_U), (bf16*)(ws + WS_XQ), (bf16*)(ws + WS_GATES), (bf16*)(ws + WS_MKV), (const float2*)(ws + WS_CS), F.in(5), F.in(6)}; \
        pg8::gemm_phase<EpiP1, SchedP1, true, false, false, 16, 2048u, 2048u>(F.lds + RING_OFF, S, E); convert_b_tail(F); }
#define PH2 { p2_mixers(F); }
#define PH3 { unsigned char* ws = F.ws(); SchedP3 S{F.G, (int)blockIdx.x, (const char*)(ws + WS_ACTS), (const char*)(ws + WS_WO3)}; EpiP3 E{(const unsigned char*)(ws + WS_GATES), (bf16*)(ws + WS_MERGED)}; \
        pg8::gemm_phase<EpiP3, SchedP3, true, false, false, 8, 3072u, 1024u>(F.lds + RING_OFF, S, E); }
#define PH4 { unsigned char* ws = F.ws(); SchedP4 S{F.G, (int)blockIdx.x, (const char*)(ws + WS_MERGED), (const char*)(ws + WS_WOUT)}; \
        EpiP4F E{(const bf16*)((unsigned char*)F.out() + DO_H), (const float*)(ws + WS_RINV), (bf16*)(ws + WS_H2), F.in(20), (const bf16*)(ws + WS_WRT), (float*)(ws + WS_PART), (unsigned*)(ws + WS_CTL), F.in(22), F.in(24), (int*)(ws + WS_ROUTE + RT_TOKC), (f32x4*)(ws + WS_ROUTE + RT_SWT), F.in(3)}; \
        pg8::gemm_phase<EpiP4F, SchedP4, false, false, false, 16, 2048u, 2048u>(F.lds + RING_OFF, S, E); }
#define PH6 { }
#define MOE_SCHEDS unsigned char* ws = F.ws(); const LAS int* tab_ = (const LAS int*)(F.lds + TB_TAB); const LAS int* tot_ = (const LAS int*)(F.lds + TB_TOTAL); \
        EpiP7 E7{(bf16*)(ws + WS_HID), (const f32x4*)(ws + WS_ROUTE + RT_SWT), (unsigned*)(ws + WS_CTL)}; EpiP8 E8{F.out(), (const bf16*)(ws + WS_H2), F.in(20)};
#define SCHED7(first, nmax) SchedP7{F.G, F.vcu, tab_, tot_, (const char*)(ws + WS_H2), (const char*)(ws + WS_WGU), (const int*)(ws + WS_ROUTE + RT_TOKC), (first), (nmax)}
#define SCHED8(first, nmax) SchedP8{F.G, F.vcu, tab_, tot_, (const char*)(ws + WS_HID), (const char*)(ws + WS_WDT), (const int*)(ws + WS_ROUTE + RT_TOKC), (unsigned*)(ws + WS_CTL), (first), (nmax)}
#define GEMM7(S) pg8::gemm_phase<EpiP7, SchedP7, true, true, false, 16, 2048u, 2048u>(F.lds + RING_OFF, S, E7)
#define GEMM8(S) pg8::gemm_phase<EpiP8, SchedP8, true, false, true, 16, 2048u, 1024u>(F.lds + RING_OFF, S, E8)
#define PH7 { moe_tables(F); convert_b2_all(F); MOE_SCHEDS const SchedP7 S = SCHED7(0, 2); GEMM7(S); }
#define PH8 { MOE_SCHEDS const int R8 = 8 * tab_[0], m7 = R8 > 2 * F.G ? R8 - 2 * F.G : 0; \
        if (F.vcu < m7) { const SchedP7 S = SCHED7(2 * F.G, 1); GEMM7(S); } else { const SchedP8 S = SCHED8(-m7, 1); GEMM8(S); } }
#define PH9 { MOE_SCHEDS const int R8 = 8 * tab_[0], m7 = R8 > 2 * F.G ? R8 - 2 * F.G : 0; const SchedP8 S = SCHED8(F.G - m7, 1 << 20); GEMM8(S); }
    RUN(0, PH0) RUN(1, PH1) RUN(2, PH2) RUN(3, PH3) RUN(4, PH4) RUN(7, PH7) RUN(8, PH8) RUN(9, PH9)
#ifdef MK_TSUB
    if (MK_TSUB >= 0 && blockIdx.x == 0) { const unsigned long long d = (((LAS unsigned long long*)(F.lds + PARG_OFF + 256))[1] - ((LAS unsigned long long*)(F.lds + PARG_OFF + 256))[0]) * 8ull, ts = __builtin_amdgcn_s_memrealtime(); while (__builtin_amdgcn_s_memrealtime() - ts < d) __builtin_amdgcn_s_sleep(8); }
#endif
    if (MK_TPROBE >= 0 && blockIdx.x == 0) { const unsigned long long d = (tp1 - tp0) * 8ull, ts = __builtin_amdgcn_s_memrealtime(); while (__builtin_amdgcn_s_memrealtime() - ts < d) __builtin_amdgcn_s_sleep(8); }
#undef IN
#undef BOTH
}

static void launch_mk(Args a, int lo, int hi, int li, int grid, hipStream_t stream) {
    a.ph_lo = lo; a.ph_hi = hi; a.li = li; a.pad = 0;
    hipLaunchKernelGGL(mk_fwd, dim3(grid), dim3(NWAVES * 64), LDS_BYTES, stream, a);
}
extern "C" void kernel_launch(void* const* d_in, const int* in_sizes, int n_in, void* d_out, int out_size, void* d_ws, size_t ws_size, hipStream_t stream) {
    static int grid = 0;
    if (grid == 0) {
        int dev = 0, cus = 0, per_cu = 0;
        if (n_in != 28 || out_size != T * D || ws_size < WS_END || hipGetDevice(&dev) != hipSuccess || hipDeviceGetAttribute(&cus, hipDeviceAttributeMultiprocessorCount, dev) != hipSuccess) {
            fprintf(stderr, "kernel_launch: built for 28 inputs, %d outputs and >= %zu bytes of workspace (n_in %d, out %d, ws %zu); nothing launched\n", T * D, (size_t)WS_END, n_in, out_size, ws_size); grid = -1; return; }
        if (hipFuncSetAttribute((const void*)mk_fwd, hipFuncAttributeMaxDynamicSharedMemorySize, LDS_BYTES) != hipSuccess) { fprintf(stderr, "kernel_launch: hipFuncSetAttribute failed\n"); grid = -1; return; }
        if (hipOccupancyMaxActiveBlocksPerMultiprocessor(&per_cu, (const void*)mk_fwd, NWAVES * 64, LDS_BYTES) != hipSuccess || per_cu < 1) { fprintf(stderr, "kernel_launch: occupancy query reports %d workgroups per CU; nothing launched\n", per_cu); grid = -1; (void)hipGetLastError(); return; }
        grid = cus;
        if (grid != 256) fprintf(stderr, "kernel_launch: note: tuned for 256 CUs, running on %d\n", grid);
    }
    if (grid < 0) return;
    if (hipMemsetAsync((char*)d_ws + WS_CTL, 0, CTL_ZERO_BYTES, stream) != hipSuccess) { fprintf(stderr, "kernel_launch: hipMemsetAsync failed\n"); return; }
    Args a{};
    for (int i = 0; i < 28; ++i) a.in[i] = (const float*)d_in[i];
    a.out = (float*)d_out; a.ws = (unsigned char*)d_ws;
    launch_mk(a, 0, 10, 0, grid, stream);
}
```

```cpp
#include <hip/hip_runtime.h>
#include <cstdint>
#include <cstdio>
#define MK_LEVEL 4
#define MK_GTB 0
#define MK_SPLIT_HI 9
#define MK_SPLIT_LO 9
#define MK_MIXN 0
#define MK_SPLIT01 0
constexpr int NWAVES = 8;
constexpr int T = 16384, SEQ = 8192, D = 1024, INW = 5376;
constexpr size_t MiB = 1u << 20;
constexpr size_t WS_CTL = 0, CTL_ZERO_BYTES = 1 * MiB;
constexpr size_t WS_W1 = 1 * MiB;
constexpr size_t WS_WO3 = 12 * MiB;
constexpr size_t WS_WOUT = 15 * MiB;
constexpr size_t WS_WKV = 17 * MiB;
constexpr size_t WS_WGU = 19 * MiB;
constexpr size_t WS_WDT = 51 * MiB;
constexpr size_t WS_CS = 67 * MiB;
constexpr size_t WS_MEMN = 71 * MiB;
constexpr size_t WS_MKV = 72 * MiB;
constexpr size_t WS_ROUTE = 73 * MiB;
constexpr size_t WS_RINV = WS_ROUTE + 1792 * 1024;
constexpr size_t WS_U = 76 * MiB;
constexpr size_t WS_XQ = 92 * MiB;
constexpr size_t WS_MERGED = 76 * MiB;
constexpr size_t WS_GATES = 108 * MiB;
constexpr size_t WS_H2 = 212 * MiB;
constexpr size_t WS_HID = 156 * MiB;
constexpr size_t WS_ACTS = 204 * MiB;
constexpr size_t WS_END = 252 * MiB;
constexpr size_t DO_H = 0, DO_Q = 32 * MiB, DO_K = 48 * MiB, DO_V = 52 * MiB;
constexpr size_t RT_CLS = 0;
constexpr size_t RT_W = 64 * 1024;
constexpr size_t RT_CNT = 192 * 1024;
constexpr size_t RT_TOK = 256 * 1024;
constexpr size_t RT_SW = 384 * 1024;
constexpr int CW_TMO = 0, CW_BAR = 4096;
constexpr int RING_OFF = 0, RING_BYTES = 131072;
constexpr int LDS_BYTES = 147456;
constexpr int LDSCTL_OFF = LDS_BYTES - 4096, MISC_OFF = LDSCTL_OFF + 320;
constexpr int TAB_OFF = LDSCTL_OFF + 1024;

#define GAS __attribute__((address_space(1)))
#define LAS __attribute__((address_space(3)))
typedef unsigned short bf16;
typedef unsigned v4u __attribute__((ext_vector_type(4)));
typedef unsigned v2u __attribute__((ext_vector_type(2)));
typedef float f32x4 __attribute__((ext_vector_type(4)));
typedef short bf16x8 __attribute__((ext_vector_type(8)));
typedef GAS unsigned gu32;
#define RLX_AGENT __ATOMIC_RELAXED, __HIP_MEMORY_SCOPE_AGENT
#define LDS_WAIT() asm volatile("s_waitcnt lgkmcnt(0)" ::: "memory")
#define VM_WAIT() asm volatile("s_waitcnt vmcnt(0)" ::: "memory")
__device__ __forceinline__ unsigned f2bf(float f) { unsigned u = __builtin_bit_cast(unsigned, f); return (u + 0x7fffu + ((u >> 16) & 1u)) >> 16; }
__device__ __forceinline__ unsigned pk2(float lo, float hi) { return f2bf(lo) | (f2bf(hi) << 16); }
__device__ __forceinline__ float bf2f(bf16 v) { return __uint_as_float((unsigned)v << 16); }
__device__ __forceinline__ float bflo(unsigned w) { return __uint_as_float(w << 16); }
__device__ __forceinline__ float bfhi(unsigned w) { return __uint_as_float(w & 0xffff0000u); }
__device__ __forceinline__ float shx(float v, int mask) { int l = threadIdx.x; asm volatile("" : "+v"(l));
    return __builtin_bit_cast(float, __builtin_amdgcn_ds_bpermute(((l ^ mask) & 63) << 2, __builtin_bit_cast(int, v))); }
__device__ __forceinline__ float wave_sum(float v) {
    v += __builtin_bit_cast(float, __builtin_amdgcn_update_dpp(0, __builtin_bit_cast(int, v), 0xB1, 0xF, 0xF, true));
    v += __builtin_bit_cast(float, __builtin_amdgcn_update_dpp(0, __builtin_bit_cast(int, v), 0x4E, 0xF, 0xF, true));
    v += __builtin_bit_cast(float, __builtin_amdgcn_update_dpp(0, __builtin_bit_cast(int, v), 0x141, 0xF, 0xF, true));
    v += __builtin_bit_cast(float, __builtin_amdgcn_update_dpp(0, __builtin_bit_cast(int, v), 0x140, 0xF, 0xF, true));
    v += shx(v, 16); v += shx(v, 32);
    return v;
}
__device__ __forceinline__ float wave_max(float v) {
#pragma unroll
    for (int o = 1; o < 64; o <<= 1) v = fmaxf(v, shx(v, o));
    return v;
}
__device__ __forceinline__ float fsigmoid(float x) { return __builtin_amdgcn_rcpf(1.f + __expf(-x)); }

#define XB_TMO      128
#define XB_XCNT(j)  (256  + 64 * (j))
#define XB_XSUB(j)  (1280 + 64 * (j))
#define XB_XGEN(j)  (2304 + 64 * (j))
#define XB_TOP      3328
#define XB_TOPGEN   3392
#define XCD_BAR_WORDS 3456
#define XB_SPIN_CAP (1u << 18)
__device__ __forceinline__ unsigned xb_ld(unsigned* p)              { return __hip_atomic_load(p, __ATOMIC_RELAXED, __HIP_MEMORY_SCOPE_AGENT); }
__device__ __forceinline__ unsigned xb_add(unsigned* p, unsigned v) { return __hip_atomic_fetch_add(p, v, __ATOMIC_RELAXED, __HIP_MEMORY_SCOPE_AGENT); }
__device__ __forceinline__ unsigned xb_xcc_id() { return (unsigned)__builtin_amdgcn_s_getreg((3 << 11) | 20) & 0xFu; }
#define XB_SPIN(cond, bar) do { unsigned _sp = 0; while (cond) { __builtin_amdgcn_s_sleep(1); \
    if ((++_sp & 255u) == 0u) { if (xb_ld(&(bar)[XB_TMO])) break; if (_sp > XB_SPIN_CAP) { atomicAdd(&(bar)[XB_TMO], 1u); break; } } } } while (0)
struct XcdBarrier { unsigned* bar; unsigned x; volatile LAS unsigned* st; };
__device__ __forceinline__ XcdBarrier xcd_barrier_post(unsigned* bar, volatile LAS unsigned* st) {
    XcdBarrier b; b.bar = bar; b.x = xb_xcc_id(); b.st = st;
    if (threadIdx.x == 0) (void)xb_add(&bar[XB_XCNT(b.x)], 1u);
    return b;
}
__device__ __forceinline__ void xcd_barrier_complete(unsigned* bar, unsigned x, unsigned& nloc, unsigned& nx) {
    const unsigned G = gridDim.x * gridDim.y * gridDim.z;
    unsigned sum, cnt, mine, sp = 0u;
    for (;;) {
        sum = 0u; cnt = 0u; mine = 0u;
#pragma unroll
        for (unsigned j = 0; j < 16; ++j) { const unsigned c = xb_ld(&bar[XB_XCNT(j)]); sum += c; cnt += (c > 0u) ? 1u : 0u; mine = (j == x) ? c : mine; }
        if (sum == G) break;
        __builtin_amdgcn_s_sleep(1);
        if ((++sp & 255u) == 0u) { if (xb_ld(&bar[XB_TMO])) break; if (sp > XB_SPIN_CAP) { atomicAdd(&bar[XB_TMO], 1u); break; } }
    }
    nloc = mine > 0u ? mine : 1u; nx = cnt > 0u ? cnt : 1u;
}
__device__ __forceinline__ void xcd_barrier(const XcdBarrier& b) {
    asm volatile("s_waitcnt vmcnt(0)" ::: "memory");
    __syncthreads();
    if (threadIdx.x == 0) {
        unsigned* bar = b.bar;
        __builtin_amdgcn_s_waitcnt(0);
        unsigned nloc = b.st[0], nx = b.st[1];
        if (nloc == 0u) { xcd_barrier_complete(bar, b.x, nloc, nx); b.st[0] = nloc; b.st[1] = nx; }
        const unsigned old = xb_add(&bar[XB_XSUB(b.x)], 1u);
        const unsigned gen = old / nloc;
        if (old + 1u == (gen + 1u) * nloc) {
            __builtin_amdgcn_fence(__ATOMIC_RELEASE, "agent");
            asm volatile("s_waitcnt vmcnt(0)" ::: "memory");
            const unsigned og = xb_add(&bar[XB_TOP], 1u);
            const unsigned tg = og / nx;
            if (og + 1u == (tg + 1u) * nx) xb_add(&bar[XB_TOPGEN], 1u);
            else XB_SPIN(xb_ld(&bar[XB_TOPGEN]) == tg, bar);
            __builtin_amdgcn_fence(__ATOMIC_ACQUIRE, "agent");
            xb_add(&bar[XB_XGEN(b.x)], 1u);
            asm volatile("s_waitcnt vmcnt(0)" ::: "memory");
        } else {
            XB_SPIN(xb_ld(&bar[XB_XGEN(b.x)]) == gen, bar);
            __builtin_amdgcn_fence(__ATOMIC_ACQUIRE, "agent");
            asm volatile("s_waitcnt vmcnt(0)" ::: "memory");
        }
    }
    __syncthreads();
}

struct Args { const float* in[28]; float* out; unsigned char* ws; int ph_lo, ph_hi, li, pad; };
constexpr int PARG_OFF = LDSCTL_OFF + 512;
struct Frame {
    LAS unsigned char* lds; volatile LAS unsigned* MISC; gu32* ctl;
    int wave, vcu, G;
    __device__ __forceinline__ int ftid() const { int t = threadIdx.x; asm volatile("" : "+v"(t)); return t; }
    __device__ __forceinline__ unsigned long long ldp(int i) const { const unsigned long long v = ((const LAS unsigned long long*)(lds + PARG_OFF))[i];
        const unsigned lo = __builtin_amdgcn_readfirstlane((unsigned)v), hi = __builtin_amdgcn_readfirstlane((unsigned)(v >> 32)); return ((unsigned long long)hi << 32) | lo; }
    __device__ __forceinline__ const float* in(int i) const { return (const float*)(const GAS float*)ldp(i); }
    __device__ __forceinline__ float* out() const { return (float*)(GAS float*)ldp(28); }
    __device__ __forceinline__ unsigned char* ws() const { return (unsigned char*)(GAS unsigned char*)ldp(29); }
};
namespace pg8 {
#define PG8_LAS __attribute__((address_space(3)))
typedef unsigned short bf16_t;
typedef short bf16x8 __attribute__((ext_vector_type(8)));
typedef float f32x4 __attribute__((ext_vector_type(4)));
typedef unsigned u32x4 __attribute__((ext_vector_type(4)));
typedef unsigned u32x2 __attribute__((ext_vector_type(2)));
constexpr int BM = 256, BK = 64, HALF = 128, HTB = HALF * BK * 2  , STAGE_BYTES = 8 * HTB, NXCD = 8, WGM = 8;

__host__ __device__ __forceinline__ int lds_byte(int r, int c) { const int st = (r >> 4) * 2 + (c >> 5), rr = r & 15, cc = c & 31, ob = rr * 64 + cc * 2; return st * 1024 + (ob ^ (((ob >> 9) & 1) << 5)); }
__host__ __device__ __forceinline__ void stage_rc(int b, int& R, int& C) { const int st = b / 1024, sb = b % 1024, swz = sb ^ (((sb >> 9) & 1) << 5); R = (st >> 1) * 16 + swz / 64; C = (st & 1) * 32 + (swz % 64) / 2; }
__host__ __device__ __forceinline__ int perm32(int rho) { const int n = rho >> 4, i = rho & 15; return 8 * (i >> 2) + 4 * n + (i & 3); }

struct Unit { int pm, pn, aux, ksplit; const char* A; const char* B0; const char* B1; const int* ridx; };

typedef float f32x2_t __attribute__((ext_vector_type(2))); typedef __bf16 bf16x2_t __attribute__((ext_vector_type(2)));
__device__ __forceinline__ unsigned cvt_pk_bf16(float lo, float hi) { f32x2_t v = {lo, hi}; bf16x2_t b = __builtin_convertvector(v, bf16x2_t); return __builtin_bit_cast(unsigned, b); }

__device__ __forceinline__ bool static_tile(int L, int nM, int nN, int& pm, int& pn) {
    const int nwg = nM * nN; if (L >= nwg) return false;
    int wgid = L; { const int q = nwg / NXCD, r = nwg % NXCD, xcd = wgid % NXCD, off = wgid / NXCD; wgid = (xcd < r ? xcd * (q + 1) : r * (q + 1) + (xcd - r) * q) + off; }
    const int nig = WGM * nN, gid = wgid / nig, fm = gid * WGM, gsz = (nM - fm) < WGM ? (nM - fm) : WGM;
    pm = fm + ((wgid % nig) % gsz); pn = (wgid % nig) / gsz; return true;
}

template <class Epi, class Sched, bool ALIGN_EPI, bool GATHER, bool SPLIT, int nt, unsigned lda, unsigned ldb>
__device__ __forceinline__ void gemm_phase(PG8_LAS unsigned char* lds, const Sched& S, const Epi& E) {
    const int tid = threadIdx.x, wid = __builtin_amdgcn_readfirstlane(tid >> 6), lane = tid & 63, wr = wid >> 2, wc = wid & 3, fr = lane & 15, fq = lane >> 4;
    unsigned voffA[2], voffB[2];
#pragma unroll
    for (int i = 0; i < 2; ++i) { int R, C; stage_rc(tid * 16 + i * 8192, R, C); const int Rb = Epi::PERM ? ((R & ~31) + perm32(R & 31)) : R;
        voffA[i] = (unsigned)R * lda + (unsigned)C * 2u; voffB[i] = (unsigned)Rb * ldb + (unsigned)C * 2u; }
    const size_t kstep = (size_t)(BK * 2);
    const size_t hstepA = (size_t)HALF * lda, hstepB = (size_t)HALF * ldb;
    const unsigned ldsw = (unsigned)wid * 1024u;
    const int aoff = lds_byte(wr * 64 + fr, fq * 8), boff = lds_byte(wc * 32 + fr, fq * 8);
#define PG8_SA(b, h) (((b) * 2 + (h)) * HTB)
#define PG8_SB(b, h) ((4 + (b) * 2 + (h)) * HTB)
#define PG8_STAGE(bufoff, gbase, voff) do { const __amdgpu_buffer_rsrc_t _rs = __builtin_amdgcn_make_buffer_rsrc((void*)(gbase), 0, 0x7fffffff, 0x00020000); _Pragma("unroll") for (int _i = 0; _i < 2; ++_i) \
        __builtin_amdgcn_raw_ptr_buffer_load_lds(_rs, (PG8_LAS unsigned*)(lds + (bufoff) + ldsw + _i * 8192), 16, (int)(voff)[_i], 0, 0, 0); } while (0)
#define PG8_LDA(dst, b, h) do { _Pragma("unroll") for (int m = 0; m < 4; ++m) _Pragma("unroll") for (int k = 0; k < 2; ++k) dst[m][k] = *(const PG8_LAS bf16x8*)(lds + PG8_SA(b, h) + aoff + m * 2048 + k * 1024); } while (0)
#define PG8_LDB(dst, b, h) do { _Pragma("unroll") for (int n = 0; n < 2; ++n) _Pragma("unroll") for (int k = 0; k < 2; ++k) dst[n][k] = *(const PG8_LAS bf16x8*)(lds + PG8_SB(b, h) + boff + n * 2048 + k * 1024); } while (0)
#define PG8_MMA(ai, bj, At, Bt) do { __builtin_amdgcn_s_setprio(1); _Pragma("unroll") for (int m = 0; m < 4; ++m) _Pragma("unroll") for (int n = 0; n < 2; ++n) _Pragma("unroll") for (int k = 0; k < 2; ++k) \
        acc[ai][bj][m][n] = __builtin_amdgcn_mfma_f32_16x16x32_bf16(Bt[n][k], At[m][k], acc[ai][bj][m][n], 0, 0, 0); __builtin_amdgcn_s_setprio(0); } while (0)
#define PG8_WAIT_V(n) asm volatile("s_waitcnt vmcnt(" #n ")" ::: "memory")
#define PG8_WAIT_L(n) asm volatile("s_waitcnt lgkmcnt(" #n ")" ::: "memory")
#define PG8_BAR __builtin_amdgcn_s_barrier()
#define PG8_SCHED __builtin_amdgcn_sched_barrier(0)
#ifndef MK_GT
#define MK_GT -1
#endif
#define PG8_TMARK(cat) do { if (MK_GT >= 0) { if (tid == 0) { PG8_LAS unsigned long long* ts_ = (PG8_LAS unsigned long long*)(lds - RING_OFF + PARG_OFF + 256); if (ts_[2]) { const unsigned long long t_ = __builtin_amdgcn_s_memrealtime(); ts_[4 + (cat)] += t_ - ts_[3]; ts_[3] = t_; } } } } while (0)
#define PG8_APTR(u, h, t) ((u).A + (GATHER ? (size_t)0 : (size_t)(h) * hstepA) + (size_t)(t) * kstep)
#define PG8_BPTR(u, h, t) ((SPLIT ? ((t) < (u).ksplit ? (u).B0 + (size_t)(t) * kstep : (u).B1 + (size_t)((t) - (u).ksplit) * kstep) : (u).B0 + (size_t)(t) * kstep) + (size_t)(h) * hstepB)
#define PG8_STAGE_A(bufoff, u, g, h, t) do { if (GATHER) { unsigned _vo[2]; int _tid = tid; asm volatile("" : "+v"(_tid)); _Pragma("unroll") for (int _i = 0; _i < 2; ++_i) { int _R, _C; stage_rc(_tid * 16 + _i * 8192, _R, _C); \
            _vo[_i] = (((g)[h] >> (16 * _i)) & 0xffffu) * lda + (unsigned)_C * 2u; } PG8_STAGE(bufoff, PG8_APTR(u, h, t), _vo); } else PG8_STAGE(bufoff, PG8_APTR(u, h, t), voffA); } while (0)
#define PG8_STAGE_B(bufoff, u, h, t) PG8_STAGE(bufoff, PG8_BPTR(u, h, t), voffB)
#define PG8_GIDX(g, u) do { if (GATHER) { _Pragma("unroll") for (int _h = 0; _h < 2; ++_h) { unsigned _p = 0u; _Pragma("unroll") for (int _i = 0; _i < 2; ++_i) { int _R, _C; stage_rc(tid * 16 + _i * 8192, _R, _C); \
            const int _j = _h * HALF + _R, _t = (u).ridx[_j < (u).aux ? _j : (u).aux - 1]; _p |= (unsigned)_t << (16 * _i); } (g)[_h] = _p; } } } while (0)
    PG8_TMARK(0);
    Unit cur, nxt; int ui = 0;
    if (!S.next(0, cur)) return;
    f32x4 acc[2][2][4][2];
#pragma unroll
    for (int a = 0; a < 2; ++a)
#pragma unroll
        for (int b = 0; b < 2; ++b)
#pragma unroll
            for (int m = 0; m < 4; ++m)
#pragma unroll
                for (int n = 0; n < 2; ++n) acc[a][b][m][n] = (f32x4){0.f, 0.f, 0.f, 0.f};
    bf16x8 At[4][2], B0[2][2], B1[2][2];
    unsigned gC[2] = {0u, 0u}, gN[2] = {0u, 0u};
    S.a_ready(cur);
    PG8_GIDX(gC, cur);
    if constexpr (Epi::PREFETCH) E.prefetch(cur, lds + STAGE_BYTES + wid * 256, tid);
    PG8_STAGE_B(PG8_SB(0, 0), cur, 0, 0); PG8_STAGE_B(PG8_SB(0, 1), cur, 1, 0); PG8_STAGE_A(PG8_SA(0, 0), cur, gC, 0, 0); PG8_STAGE_A(PG8_SA(0, 1), cur, gC, 1, 0);
    if (wr == 1) PG8_BAR;
    PG8_WAIT_V(2); PG8_BAR;
    PG8_STAGE_B(PG8_SB(1, 0), cur, 0, 1); PG8_STAGE_A(PG8_SA(1, 0), cur, gC, 0, 1); PG8_STAGE_B(PG8_SB(1, 1), cur, 1, 1);
    PG8_WAIT_V(6); PG8_BAR;
    PG8_TMARK(1);
    for (;;) {
        const bool has_next = S.next(ui + 1, nxt);
        if (!has_next) nxt = cur;
        if (GATHER) { if (has_next) { PG8_GIDX(gN, nxt); } else { gN[0] = gC[0]; gN[1] = gC[1]; } }
        for (int t = 0; t < nt; t += 2) {
            const bool last = (t == nt - 2);
            if (last && has_next) S.a_ready(nxt);
            PG8_LDB(B0, 0, 0); PG8_LDB(B1, 0, 1); PG8_SCHED; PG8_LDA(At, 0, 0); PG8_STAGE_A(PG8_SA(1, 1), cur, gC, 1, t + 1);
            PG8_WAIT_V(8); PG8_WAIT_L(0); PG8_BAR; PG8_MMA(0, 0, At, B0); PG8_MMA(0, 1, At, B1); PG8_BAR; PG8_SCHED;
            PG8_LDA(At, 0, 1);
            if (!last) { PG8_STAGE_B(PG8_SB(0, 0), cur, 0, t + 2); PG8_STAGE_B(PG8_SB(0, 1), cur, 1, t + 2); PG8_STAGE_A(PG8_SA(0, 0), cur, gC, 0, t + 2); }
            else       { PG8_STAGE_B(PG8_SB(0, 0), nxt, 0, 0);     PG8_STAGE_B(PG8_SB(0, 1), nxt, 1, 0);     PG8_STAGE_A(PG8_SA(0, 0), nxt, gN, 0, 0); }
            PG8_WAIT_V(8); PG8_WAIT_L(0); PG8_BAR; PG8_MMA(1, 0, At, B0); PG8_MMA(1, 1, At, B1); PG8_BAR; PG8_SCHED;
            PG8_LDB(B0, 1, 0); PG8_LDB(B1, 1, 1); PG8_SCHED; PG8_LDA(At, 1, 0);
            if (!last) { PG8_STAGE_A(PG8_SA(0, 1), cur, gC, 1, t + 2); } else { PG8_STAGE_A(PG8_SA(0, 1), nxt, gN, 1, 0); }
            PG8_WAIT_V(8); PG8_WAIT_L(0); PG8_BAR; PG8_MMA(0, 0, At, B0); PG8_MMA(0, 1, At, B1); PG8_BAR; PG8_SCHED;
            PG8_LDA(At, 1, 1);
            if (!last) { PG8_STAGE_B(PG8_SB(1, 0), cur, 0, t + 3); PG8_STAGE_B(PG8_SB(1, 1), cur, 1, t + 3); PG8_STAGE_A(PG8_SA(1, 0), cur, gC, 0, t + 3); }
            else       { PG8_STAGE_B(PG8_SB(1, 0), nxt, 0, 1);     PG8_STAGE_B(PG8_SB(1, 1), nxt, 1, 1);     PG8_STAGE_A(PG8_SA(1, 0), nxt, gN, 0, 1); }
            PG8_WAIT_V(8); PG8_WAIT_L(0); PG8_BAR; PG8_MMA(1, 0, At, B0); PG8_MMA(1, 1, At, B1); PG8_BAR; PG8_SCHED;
        }
        if constexpr (ALIGN_EPI) { if (wr == 0) PG8_BAR; }
        PG8_TMARK(2);
        int fr_ = fr, fq_ = fq; asm volatile("" : "+v"(fr_), "+v"(fq_));
        bool zero = true;
        asm volatile("" ::: "memory");
        if constexpr (!Epi::AFTER_DRAIN) zero = E(acc, cur, wr, wc, fr_, fq_);
        asm volatile("" ::: "memory");
        PG8_TMARK(3);
        if (!has_next) break;
        if (zero) {
#pragma unroll
            for (int a = 0; a < 2; ++a)
#pragma unroll
                for (int b = 0; b < 2; ++b)
#pragma unroll
                    for (int m = 0; m < 4; ++m)
#pragma unroll
                        for (int n = 0; n < 2; ++n) acc[a][b][m][n] = (f32x4){0.f, 0.f, 0.f, 0.f};
        }
        cur = nxt; ++ui;
        if constexpr (Epi::PREFETCH) E.prefetch(cur, lds + STAGE_BYTES + wid * 256, tid);
        if (GATHER) { gC[0] = gN[0]; gC[1] = gN[1]; }
        if constexpr (ALIGN_EPI) { if (wr == 1) PG8_BAR; }
        PG8_TMARK(4);
    }
    PG8_WAIT_V(0);
    if constexpr (!ALIGN_EPI) { if (wr == 0) PG8_BAR; }
    PG8_BAR;
    PG8_TMARK(5);
    if constexpr (Epi::AFTER_DRAIN) { int fr_ = fr, fq_ = fq; asm volatile("" : "+v"(fr_), "+v"(fq_)); E.fused(acc, cur, wr, wc, fr_, fq_, lds, wid, lane); }
    PG8_TMARK(6);
#undef PG8_SA
#undef PG8_SB
#undef PG8_STAGE
#undef PG8_LDA
#undef PG8_LDB
#undef PG8_MMA
#undef PG8_WAIT_V
#undef PG8_WAIT_L
#undef PG8_BAR
#undef PG8_SCHED
#undef PG8_APTR
#undef PG8_BPTR
#undef PG8_STAGE_A
#undef PG8_STAGE_B
#undef PG8_GIDX
#undef PG8_TMARK
}
}
#ifndef MK_TSUB
#define MK_TSUB -1
#endif
#ifndef TSUB_BEG
#define TSUB_BEG(k) if (MK_TSUB == (k)) { __syncthreads(); if (threadIdx.x == 0) ((LAS unsigned long long*)(F.lds + PARG_OFF + 256))[0] = __builtin_amdgcn_s_memrealtime(); }
#define TSUB_END(k) if (MK_TSUB == (k)) { __syncthreads(); if (threadIdx.x == 0) ((LAS unsigned long long*)(F.lds + PARG_OFF + 256))[1] = __builtin_amdgcn_s_memrealtime(); }
#endif
__device__ __forceinline__ int map_win(int n) {
    if (n < 512) { const int hq = n >> 6, d = n & 63; return 256 * (hq >> 2) + (d >> 5) * 128 + 32 * (hq & 3) + (d & 31); }
    if (n < 768) { const int j = n - 512, hh = j >> 6, d = j & 63; return 512 + (d >> 5) * 128 + 32 * hh + (d & 31); }
    if (n < 1792) { const int j = n - 768; const int c = j & 511; return 768 + 8 * (c >> 2) + (j >= 512 ? 4 : 0) + (c & 3); }
    return n;
}
__device__ __forceinline__ int map_row(int mode, int n) {
    if (mode == 1) return map_win(n);
    if (mode == 2) return 8 * (n >> 2) + (n & 3);
    if (mode == 3) return 8 * (n >> 2) + 4 + (n & 3);
    return n;
}
constexpr int TSCR = 64 * 65 * 4;
__device__ __forceinline__ void p0_transpose_item(const float* W, int N, bf16* WT, int ldt, int mode, LAS float* scr, int kb, int nb, int lane) {
    const int k0 = 64 * kb, n0 = 64 * nb, kk = lane >> 4, nq = lane & 15;
    const GAS f32x4* src = (const GAS f32x4*)(W + (size_t)(k0 + kk) * N + n0 + 4 * nq);
#pragma unroll 8
    for (int i = 0; i < 16; ++i) { const f32x4 v = src[(size_t)i * N]; LAS float* d = scr + (4 * i + kk) * 65 + 4 * nq; d[0] = v[0]; d[1] = v[1]; d[2] = v[2]; d[3] = v[3]; }
    LDS_WAIT(); asm volatile("" ::: "memory");
    const int c = lane & 7, nn = lane >> 3;
#pragma unroll
    for (int j = 0; j < 8; ++j) { const int n = nn + 8 * j; const LAS float* s = scr + (8 * c) * 65 + n;
        v4u o; o.x = pk2(s[0 * 65], s[1 * 65]); o.y = pk2(s[2 * 65], s[3 * 65]); o.z = pk2(s[4 * 65], s[5 * 65]); o.w = pk2(s[6 * 65], s[7 * 65]);
        *(GAS v4u*)(WT + (size_t)map_row(mode, n0 + n) * ldt + k0 + 8 * c) = o; }
    LDS_WAIT(); asm volatile("" ::: "memory");
}
constexpr int IA_WIN = 16 * 84, IA_KV = 16 * 16, NITEMS_A = IA_WIN + IA_KV;
constexpr int IB_WO = 8 * 16, IB_OUT = 16 * 16, IB_GU = 16 * 16 * 8, IB_DN = 16 * 8 * 16, NITEMS_B = 3 * IB_WO + IB_OUT + 2 * IB_GU, NITEMS_B2 = IB_DN;
__device__ __forceinline__ void convert_item_a(Frame& F, unsigned char* ws, LAS float* scr, int r, int lane) {
    if (r < IA_WIN) { p0_transpose_item(F.in(4), INW, (bf16*)(ws + WS_W1), 1024, 1, scr, r / 84, r % 84, lane); return; } r -= IA_WIN;
    p0_transpose_item(F.in(15), 1024, (bf16*)(ws + WS_WKV), 1024, 0, scr, r / 16, r % 16, lane);
}
__device__ __forceinline__ void convert_item_b(Frame& F, unsigned char* ws, LAS float* scr, int r, int lane) {
    if (r < 3 * IB_WO) { const int b = r / IB_WO, q = r % IB_WO; const float* W = b == 0 ? F.in(8) : (b == 1 ? F.in(13) : F.in(18));
        p0_transpose_item(W, 1024, (bf16*)(ws + WS_WO3) + (size_t)b * 1024 * 512, 512, 0, scr, q / 16, q % 16, lane); return; } r -= 3 * IB_WO;
    if (r < IB_OUT) { p0_transpose_item(F.in(19), 1024, (bf16*)(ws + WS_WOUT), 1024, 0, scr, r / 16, r % 16, lane); return; } r -= IB_OUT;
    if (r < 2 * IB_GU) { const int up = r / IB_GU, q = r % IB_GU, e = q / 128, qq = q % 128; const float* W = (up ? F.in(26) : F.in(25)) + (size_t)e * 1024 * 512;
        p0_transpose_item(W, 512, (bf16*)(ws + WS_WGU) + (size_t)e * 1024 * 1024, 1024, 2 + up, scr, qq / 8, qq % 8, lane); return; }
}
__device__ __forceinline__ void convert_item_b2(Frame& F, unsigned char* ws, LAS float* scr, int r, int lane) {
    { const int e = r / 128, qq = r % 128; p0_transpose_item(F.in(27) + (size_t)e * 512 * 1024, 1024, (bf16*)(ws + WS_WDT) + (size_t)e * 1024 * 512, 512, 0, scr, qq / 16, qq % 16, lane); }
}
__device__ __forceinline__ void convert_b2_tail(Frame& F, int nunits) {
    const int rem = nunits % F.G, first = rem, cnt = rem ? F.G - rem : F.G, idx = rem ? F.vcu - rem : F.vcu;
    if (idx < 0) return; (void)first;
    const int tid_ = F.ftid(), lane_ = tid_ & 63; unsigned char* ws = F.ws();
    LAS float* scr = (LAS float*)(F.lds + RING_OFF + F.wave * TSCR);
    for (int it = idx * NWAVES + F.wave; it < NITEMS_B2; it += cnt * NWAVES) convert_item_b2(F, ws, scr, it, lane_);
}
__device__ __forceinline__ void convert_b2_all(Frame& F) {
    const int tid_ = F.ftid(), lane_ = tid_ & 63; unsigned char* ws = F.ws();
    LAS float* scr = (LAS float*)(F.lds + RING_OFF + F.wave * TSCR);
    for (int it = F.vcu * NWAVES + F.wave; it < NITEMS_B2; it += F.G * NWAVES) convert_item_b2(F, ws, scr, it, lane_);
    __syncthreads();
}
constexpr int P1_LONG = 72;
__device__ __forceinline__ void convert_b_tail(Frame& F) {
    if (F.G <= P1_LONG || (int)blockIdx.x < P1_LONG) return;
    const int tid_ = F.ftid(), lane_ = tid_ & 63; unsigned char* ws = F.ws();
    LAS float* scr = (LAS float*)(F.lds + RING_OFF + F.wave * TSCR);
    const int gw = ((int)blockIdx.x - P1_LONG) * NWAVES + F.wave, NGW = (F.G - P1_LONG) * NWAVES;
    for (int it = gw; it < NITEMS_B; it += NGW) convert_item_b(F, ws, scr, it, lane_);
}
template <int NR>
__device__ __forceinline__ void rms_rows_load(f32x4 (&v)[NR][4], int lane, const float* xrow, size_t stride) {
#pragma unroll
    for (int i = 0; i < NR; ++i) { const GAS f32x4* xr = (const GAS f32x4*)(xrow + i * stride) + lane;
#pragma unroll
        for (int j = 0; j < 4; ++j) v[i][j] = xr[64 * j]; }
}
template <int NR>
__device__ __forceinline__ void rms_rows_finish(const f32x4 (&v)[NR][4], int lane, size_t stride, const float* g, bf16* orow, float* rinv = nullptr, int rstride = 0) {
    float s[NR]; f32x4 gg[4];
#pragma unroll
    for (int j = 0; j < 4; ++j) gg[j] = *((const GAS f32x4*)g + lane + 64 * j);
#pragma unroll
    for (int i = 0; i < NR; ++i) { s[i] = 0.f;
#pragma unroll
        for (int j = 0; j < 4; ++j) s[i] += (v[i][j].x * v[i][j].x + v[i][j].y * v[i][j].y) + (v[i][j].z * v[i][j].z + v[i][j].w * v[i][j].w); }
#pragma unroll
    for (int i = 0; i < NR; ++i) s[i] = wave_sum(s[i]);
#pragma unroll
    for (int i = 0; i < NR; ++i) { const float r = rsqrtf(s[i] * (1.f / 1024.f) + 1e-6f); GAS unsigned long long* o8 = (GAS unsigned long long*)(orow + i * stride) + lane;
        if (rinv != nullptr && lane == 0) rinv[i * rstride] = 1.f / r;
#pragma unroll
        for (int j = 0; j < 4; ++j) o8[64 * j] = (unsigned long long)pg8::cvt_pk_bf16(v[i][j].x * r * gg[j].x, v[i][j].y * r * gg[j].y) | ((unsigned long long)pg8::cvt_pk_bf16(v[i][j].z * r * gg[j].z, v[i][j].w * r * gg[j].w) << 32); }
}
template <int NR>
__device__ __forceinline__ void rms_rows_to_bf16(int lane, const float* xrow, size_t stride, const float* g, bf16* orow) { f32x4 v[NR][4]; rms_rows_load<NR>(v, lane, xrow, stride); rms_rows_finish<NR>(v, lane, stride, g, orow); }
__device__ __forceinline__ void p0_prologue(Frame& F) {
    const int tid_ = F.ftid(), lane_ = tid_ & 63; (void)lane_;
    LAS float* scr = (LAS float*)(F.lds + RING_OFF + F.wave * TSCR);
    const int gw = F.vcu * NWAVES + F.wave, NGW = F.G * NWAVES;
    unsigned char* ws = F.ws();
    if (T == 8 * NGW) {
        f32x4 v[8][4]; rms_rows_load<8>(v, lane_, F.in(0) + (size_t)gw * D, (size_t)NGW * D);
        for (int it = gw; it < NITEMS_A; it += NGW) convert_item_a(F, ws, scr, it, lane_);
        rms_rows_finish<8>(v, lane_, (size_t)NGW * D, F.in(3), (bf16*)((unsigned char*)F.out() + DO_H) + (size_t)gw * D, (float*)(ws + WS_RINV) + gw, NGW);
    } else {
        for (int it = gw; it < NITEMS_A; it += NGW) convert_item_a(F, ws, scr, it, lane_);
        for (int m = gw; m < T; m += NGW) { f32x4 v1[1][4]; rms_rows_load<1>(v1, lane_, F.in(0) + (size_t)m * D, 0); rms_rows_finish<1>(v1, lane_, 0, F.in(3), (bf16*)((unsigned char*)F.out() + DO_H) + (size_t)m * D, (float*)(ws + WS_RINV) + m, 0); }
    }
    for (int m = gw; m < 512; m += NGW) rms_rows_to_bf16<1>(lane_, F.in(1) + (size_t)m * D, 0, F.in(14), (bf16*)(ws + WS_MEMN) + (size_t)m * D);
    {
        const float* g2 = F.in(20); const float* wg = F.in(21); const float* wrt = F.in(23); bf16* WR = (bf16*)(ws + WS_ROUTE + 2 * MiB);
        const int gt = F.vcu * 512 + tid_, NT_ = F.G * 512;
        for (int id = gt; id < 4 * 32 * 256; id += NT_) { const int pn = id >> 13, n = (id >> 8) & 31, s = id & 255, gidx = s >> 5, kg = (s >> 3) & 3, j = s & 7;
            const int col = 256 * pn + 128 * (gidx >> 2) + 32 * (gidx & 3) + (j < 4 ? 4 * kg + j : 16 + 4 * kg + j - 4); float w = 0.f;
            if (n < 20) w = g2[col] * (n < 4 ? wg[col * 4 + n] : wrt[col * 16 + (n - 4)]);
            const unsigned hi = f2bf(w), lo = f2bf(w - __uint_as_float(hi << 16));
            WR[(size_t)((pn * 2 + 0) * 32 + n) * 256 + s] = (bf16)hi; WR[(size_t)((pn * 2 + 1) * 32 + n) * 256 + s] = (bf16)lo; }
    }
    {
        const int* positions = (const int*)F.in(2); float2* cs = (float2*)(ws + WS_CS);
        const int gt = F.vcu * 512 + tid_, NT_ = F.G * 512;
        for (int idx = gt; idx < T * 32; idx += NT_) { const int t = idx >> 5, i = idx & 31;
            const float inv = 1.0f / powf(10000.f, (float)(2 * i) / 64.f); const float ang = (float)positions[t] * inv;
            double s, c; sincos((double)ang, &s, &c); cs[idx] = make_float2((float)c, (float)s); }
    }
}

struct SchedP1 {
    __device__ __forceinline__ void a_ready(const pg8::Unit&) const {}
    int G, c; const char* Ah; const char* W1; const char* Amem; const char* Wkv;
    __device__ __forceinline__ bool next(int i, pg8::Unit& u) const {
        const int L = i * G + c; u.ksplit = 1 << 30; u.ridx = nullptr;
        if (L < 64 * 21) { int pm, pn; pg8::static_tile(L, 64, 21, pm, pn); u.pm = pm; u.pn = pn; u.aux = 0; u.A = Ah + (size_t)pm * 256 * 2048; u.B0 = W1 + (size_t)pn * 256 * 2048; u.B1 = u.B0; return true; }
        const int j = L - 64 * 21; if (j >= 8) return false;
        u.pm = j & 1; u.pn = j >> 1; u.aux = 1; u.A = Amem + (size_t)u.pm * 256 * 2048; u.B0 = Wkv + (size_t)u.pn * 256 * 2048; u.B1 = u.B0; return true;
    }
};
__device__ __forceinline__ v4u pack8(const f32x4 a, const f32x4 b) { v4u w; w.x = pg8::cvt_pk_bf16(a[0], a[1]); w.y = pg8::cvt_pk_bf16(a[2], a[3]); w.z = pg8::cvt_pk_bf16(b[0], b[1]); w.w = pg8::cvt_pk_bf16(b[2], b[3]); return w; }
struct EpiP1 {
    static constexpr bool PERM = true, AFTER_DRAIN = false, PREFETCH = false;
    bf16 *q, *k, *v, *u, *xq, *gates, *mkv; const float2* cs; const float *gq, *gk;
    __device__ __forceinline__ void qk_rope(const f32x4 (&acc)[2][2][4][2], int row0, bf16* dst, int ld, int head, const float* g, int fq) const {
        f32x4 g1[2], g2[2];
#pragma unroll
        for (int n = 0; n < 2; ++n) { g1[n] = *(const f32x4*)(g + 8 * fq + 4 * n); g2[n] = *(const f32x4*)(g + 32 + 8 * fq + 4 * n); }
#pragma unroll
        for (int ai = 0; ai < 2; ++ai)
#pragma unroll
            for (int m = 0; m < 4; ++m) {
                const int row = row0 + ai * 128 + m * 16;
                float ss = 0.f;
#pragma unroll
                for (int bj = 0; bj < 2; ++bj)
#pragma unroll
                    for (int n = 0; n < 2; ++n) { const f32x4 x = acc[ai][bj][m][n]; ss += (x[0] * x[0] + x[1] * x[1]) + (x[2] * x[2] + x[3] * x[3]); }
                ss += shx(ss, 16); ss += shx(ss, 32);
                const float r = rsqrtf(ss * (1.f / 64.f) + 1e-6f);
                const f32x4* cp = (const f32x4*)(cs + (size_t)row * 32 + 8 * fq);
                f32x4 o1[2], o2[2];
#pragma unroll
                for (int n = 0; n < 2; ++n) { const f32x4 ca = cp[2 * n], cb = cp[2 * n + 1];
                    const f32x4 y1 = acc[ai][0][m][n] * r * g1[n], y2 = acc[ai][1][m][n] * r * g2[n];
                    o1[n] = (f32x4){y1[0] * ca[0] - y2[0] * ca[1], y1[1] * ca[2] - y2[1] * ca[3], y1[2] * cb[0] - y2[2] * cb[1], y1[3] * cb[2] - y2[3] * cb[3]};
                    o2[n] = (f32x4){y2[0] * ca[0] + y1[0] * ca[1], y2[1] * ca[2] + y1[1] * ca[3], y2[2] * cb[0] + y1[2] * cb[1], y2[3] * cb[2] + y1[3] * cb[3]}; }
                bf16* p = dst + (size_t)row * ld + head * 64 + 8 * fq;
                *(v4u*)p = pack8(o1[0], o1[1]); *(v4u*)(p + 32) = pack8(o2[0], o2[1]);
            }
    }
    __device__ __forceinline__ bool operator()(f32x4 (&acc)[2][2][4][2], const pg8::Unit& un, int wr, int wc, int fr, int fq) const {
        const int row0 = un.pm * 256 + wr * 64 + fr;
        if (un.aux == 1) {
#pragma unroll
            for (int ai = 0; ai < 2; ++ai)
#pragma unroll
                for (int m = 0; m < 4; ++m)
#pragma unroll
                    for (int bj = 0; bj < 2; ++bj) *(v4u*)(mkv + (size_t)(row0 + ai * 128 + m * 16) * 1024 + un.pn * 256 + bj * 128 + wc * 32 + 8 * fq) = pack8(acc[ai][bj][m][0], acc[ai][bj][m][1]);
            return true;
        }
        const int pn = un.pn;
        if (pn < 2) { qk_rope(acc, row0, q, 512, 4 * pn + wc, gq, fq); return true; }
        if (pn == 2) {
            if (wc < 2) { qk_rope(acc, row0, k, 128, wc, gk, fq); return true; }
#pragma unroll
            for (int ai = 0; ai < 2; ++ai)
#pragma unroll
                for (int m = 0; m < 4; ++m)
#pragma unroll
                    for (int bj = 0; bj < 2; ++bj) *(v4u*)(v + (size_t)(row0 + ai * 128 + m * 16) * 128 + (wc - 2) * 64 + bj * 32 + 8 * fq) = pack8(acc[ai][bj][m][0], acc[ai][bj][m][1]);
            return true;
        }
        if (pn < 7) {
#pragma unroll
            for (int ai = 0; ai < 2; ++ai)
#pragma unroll
                for (int m = 0; m < 4; ++m)
#pragma unroll
                    for (int bj = 0; bj < 2; ++bj) { const f32x4 av = acc[ai][bj][m][0], bv = acc[ai][bj][m][1];
                        v2u w; w.x = pg8::cvt_pk_bf16(av[0] * fsigmoid(bv[0]), av[1] * fsigmoid(bv[1])); w.y = pg8::cvt_pk_bf16(av[2] * fsigmoid(bv[2]), av[3] * fsigmoid(bv[3]));
                        *(v2u*)(u + (size_t)(row0 + ai * 128 + m * 16) * 512 + 128 * (pn - 3) + 64 * bj + 16 * wc + 4 * fq) = w; }
            return true;
        }
        if (pn < 9) {
#pragma unroll
            for (int ai = 0; ai < 2; ++ai)
#pragma unroll
                for (int m = 0; m < 4; ++m)
#pragma unroll
                    for (int bj = 0; bj < 2; ++bj) *(v4u*)(xq + (size_t)(row0 + ai * 128 + m * 16) * 512 + (pn - 7) * 256 + bj * 128 + wc * 32 + 8 * fq) = pack8(acc[ai][bj][m][0], acc[ai][bj][m][1]);
            return true;
        }
        unsigned char* g8 = (unsigned char*)gates;
#pragma unroll
        for (int ai = 0; ai < 2; ++ai)
#pragma unroll
            for (int m = 0; m < 4; ++m)
#pragma unroll
                for (int bj = 0; bj < 2; ++bj) { const f32x4 a0 = acc[ai][bj][m][0], a1 = acc[ai][bj][m][1]; v2u w; w.x = 0u; w.y = 0u;
#pragma unroll
                    for (int e = 0; e < 4; ++e) { w.x = __builtin_amdgcn_cvt_pk_u8_f32(fmaxf(fsigmoid(a0[e]) * 255.f, 1.f), e, w.x); w.y = __builtin_amdgcn_cvt_pk_u8_f32(fmaxf(fsigmoid(a1[e]) * 255.f, 1.f), e, w.y); }
                    *(v2u*)(g8 + (size_t)(row0 + ai * 128 + m * 16) * 3072 + (pn - 9) * 256 + bj * 128 + wc * 32 + 8 * fq) = w; }
        return true;
    }
};

struct SchedP3 {
    __device__ __forceinline__ void a_ready(const pg8::Unit&) const {}
    int G, c; const char* acts; const char* Wo3;
    __device__ __forceinline__ bool next(int i, pg8::Unit& u) const {
        const int j = i / 3, b = i - 3 * j; const int L = j * G + c; int pm, pn;
        if (!pg8::static_tile(L, 64, 4, pm, pn)) return false;
        u.pm = pm; u.pn = pn; u.aux = b; u.ksplit = 1 << 30; u.ridx = nullptr;
        u.A = acts + (size_t)pm * 256 * 3072 + (size_t)b * 1024; u.B0 = Wo3 + (size_t)b * (1024 * 1024) + (size_t)pn * 256 * 1024; u.B1 = u.B0; return true;
    }
};
struct EpiP3 {
    static constexpr bool PERM = true, AFTER_DRAIN = false, PREFETCH = false;
    const unsigned char* gates; bf16* merged;
    __device__ __forceinline__ void prefetch(const pg8::Unit&, LAS unsigned char*, int) const {}
    static __device__ __forceinline__ f32x4 ub4(unsigned w) { return (f32x4){(float)(w & 255u), (float)((w >> 8) & 255u), (float)((w >> 16) & 255u), (float)(w >> 24)}; }
    __device__ __forceinline__ bool operator()(f32x4 (&acc)[2][2][4][2], const pg8::Unit& un, int wr, int wc, int fr, int fq) const {
        const int b = un.aux; const bool fin = b == 2;
        const __amdgpu_buffer_rsrc_t rg = __builtin_amdgcn_make_buffer_rsrc((void*)gates, 0, 0x7fffffff, 0x00020000);
        const int vg = fr * 3072 + 8 * fq, sg = (un.pm * 256 + wr * 64) * 3072 + b * 1024 + un.pn * 256 + wc * 32, db = fin ? 0 : 1024;
        v2u ga[2][2], gb[2][2];
#define EPI3_LD(g) do { const int so_ = sg + ((g >> 2) * 128 + (g & 3) * 16) * 3072; _Pragma("unroll") for (int bj = 0; bj < 2; ++bj) { \
            ga[(g) & 1][bj] = __builtin_amdgcn_raw_buffer_load_b64(rg, vg, so_ + bj * 128, 0); gb[(g) & 1][bj] = __builtin_amdgcn_raw_buffer_load_b64(rg, vg, so_ + bj * 128 + db, 0); } } while (0)
        EPI3_LD(0);
#pragma unroll
        for (int g = 0; g < 8; ++g) {
            if (g + 1 < 8) EPI3_LD(g + 1);
#pragma unroll
            for (int bj = 0; bj < 2; ++bj) {
                f32x4 s0 = ub4(ga[g & 1][bj].x), s1 = ub4(ga[g & 1][bj].y); const f32x4 d0 = ub4(gb[g & 1][bj].x), d1 = ub4(gb[g & 1][bj].y);
#pragma unroll
                for (int e = 0; e < 4; ++e) { s0[e] *= fin ? (1.f / 255.f) : __builtin_amdgcn_rcpf(d0[e]); s1[e] *= fin ? (1.f / 255.f) : __builtin_amdgcn_rcpf(d1[e]); }
                acc[g >> 2][bj][g & 3][0] *= s0; acc[g >> 2][bj][g & 3][1] *= s1; }
            __builtin_amdgcn_sched_barrier(0); }
#undef EPI3_LD
        if (fin) {
            const __amdgpu_buffer_rsrc_t rm = __builtin_amdgcn_make_buffer_rsrc((void*)merged, 0, 0x7fffffff, 0x00020000);
            const int vm = fr * 2048 + 16 * fq, sm = (un.pm * 256 + wr * 64) * 2048 + (un.pn * 256 + wc * 32) * 2;
#pragma unroll
            for (int ai = 0; ai < 2; ++ai)
#pragma unroll
                for (int m = 0; m < 4; ++m)
#pragma unroll
                    for (int bj = 0; bj < 2; ++bj)
                        __builtin_amdgcn_raw_buffer_store_b128(pack8(acc[ai][bj][m][0], acc[ai][bj][m][1]), rm, vm, sm + (ai * 128 + m * 16) * 2048 + bj * 256, 0);
        }
        return fin;
    }
};

struct SchedP4 {
    __device__ __forceinline__ void a_ready(const pg8::Unit&) const {}
    int G, c; const char* A; const char* W;
    __device__ __forceinline__ bool next(int i, pg8::Unit& u) const {
        const int L = i * G + c; int pm, pn; if (!pg8::static_tile(L, 64, 4, pm, pn)) return false;
        u.pm = pm; u.pn = pn; u.aux = 0; u.ksplit = 1 << 30; u.ridx = nullptr; u.A = A + (size_t)pm * 256 * 2048; u.B0 = W + (size_t)pn * 256 * 2048; u.B1 = u.B0; return true;
    }
};
struct EpiP4 {
    static constexpr bool PERM = false, AFTER_DRAIN = false, PREFETCH = false;
    const float* x; float* out;
    __device__ __forceinline__ bool operator()(f32x4 (&acc)[2][2][4][2], const pg8::Unit& un, int wr, int wc, int fr, int fq) const {
        const int row0 = un.pm * 256 + wr * 64 + fr, col0 = un.pn * 256 + wc * 32 + 4 * fq;
#pragma unroll
        for (int ai = 0; ai < 2; ++ai)
#pragma unroll
            for (int m = 0; m < 4; ++m) { const size_t off = (size_t)(row0 + ai * 128 + m * 16) * 1024 + col0;
#pragma unroll
                for (int bj = 0; bj < 2; ++bj)
#pragma unroll
                    for (int n = 0; n < 2; ++n) *(f32x4*)(out + off + bj * 128 + n * 16) = *(const f32x4*)(x + off + bj * 128 + n * 16) + acc[ai][bj][m][n]; }
        return true;
    }
};
constexpr size_t RT_TOKC = 0, RT_SWT = 1536 * 1024;
constexpr int CW_CCNT = 1024, CCNT_STRIDE = 64;
constexpr int TB_TOTAL = TAB_OFF, TB_TAB = TAB_OFF + 256;
typedef float f32x2v __attribute__((ext_vector_type(2)));
constexpr int WST = 2064;
__device__ __forceinline__ void route_token(const LAS float* lg, const float* bg, const float* br, int& cls, float& wa, float& wb) {
    float l0 = lg[0] + bg[0], l1 = lg[1] + bg[1], l2 = lg[2] + bg[2], l3 = lg[3] + bg[3];
    int gi = 0; float gm = l0;
    if (l1 > gm) { gm = l1; gi = 1; } if (l2 > gm) { gm = l2; gi = 2; } if (l3 > gm) { gm = l3; gi = 3; }
    const float pg = 1.f / (__expf(l0 - gm) + __expf(l1 - gm) + __expf(l2 - gm) + __expf(l3 - gm));
    const float e0 = lg[4 + gi * 4 + 0] + br[gi * 4 + 0], e1 = lg[4 + gi * 4 + 1] + br[gi * 4 + 1], e2 = lg[4 + gi * 4 + 2] + br[gi * 4 + 2], e3 = lg[4 + gi * 4 + 3] + br[gi * 4 + 3];
    int i1 = 0; float v1 = e0;
    if (e1 > v1) { v1 = e1; i1 = 1; } if (e2 > v1) { v1 = e2; i1 = 2; } if (e3 > v1) { v1 = e3; i1 = 3; }
    int i2 = -1; float v2 = -3.0e38f;
    if (i1 != 0 && e0 > v2) { v2 = e0; i2 = 0; } if (i1 != 1 && e1 > v2) { v2 = e1; i2 = 1; } if (i1 != 2 && e2 > v2) { v2 = e2; i2 = 2; } if (i1 != 3 && e3 > v2) { v2 = e3; i2 = 3; }
    const float q2 = __expf(v2 - v1), p1 = 1.f / (1.f + q2), p2 = q2 * p1;
    const int a = i1 < i2 ? i1 : i2, b = i1 < i2 ? i2 : i1;
    wa = pg * (i1 < i2 ? p1 : p2); wb = pg * (i1 < i2 ? p2 : p1);
    cls = gi * 6 + (a * (7 - a)) / 2 + (b - a - 1);
}
constexpr size_t WS_WRT = WS_ROUTE + 2 * MiB;
constexpr size_t WS_PART = WS_ACTS;
constexpr int CW_PCNT = 2600, CW_WDT = 2700;
#ifndef MK_GT
#define MK_GT -1
#endif
#define P4_TMARK(cat) do { if (MK_GT >= 0) { if (tid == 0) { LAS unsigned long long* ts_ = (LAS unsigned long long*)(lds - RING_OFF + PARG_OFF + 256); if (ts_[2]) { const unsigned long long t_ = __builtin_amdgcn_s_memrealtime(); ts_[4 + (cat)] += t_ - ts_[3]; ts_[3] = t_; } } } } while (0)
constexpr int WR_LST = 528;
struct EpiP4F {
    static constexpr bool PERM = false, AFTER_DRAIN = true, PREFETCH = false;
    __device__ __forceinline__ void prefetch(const pg8::Unit&, LAS unsigned char*, int) const {}
    const bf16* h; const float* rinv; bf16* h2; const float* g2; const bf16* WR; float* gpart; unsigned* ctl; const float* bg; const float* br; int* rtokc; f32x4* swt; const float* g1;
    __device__ __forceinline__ bool operator()(f32x4 (&)[2][2][4][2], const pg8::Unit&, int, int, int, int) const { return true; }
    __device__ __forceinline__ void fused(f32x4 (&acc)[2][2][4][2], const pg8::Unit& un, int wr, int wc, int fr, int fq, LAS unsigned char* lds, int wid, int lane) const {
        const int tid = wid * 64 + lane;
        const int row0 = un.pm * 256 + wr * 64 + fr, col0 = un.pn * 256 + wc * 32 + 4 * fq;
        {
          const __amdgpu_buffer_rsrc_t rx = __builtin_amdgcn_make_buffer_rsrc((void*)h, 0, 0x7fffffff, 0x00020000), rh = __builtin_amdgcn_make_buffer_rsrc((void*)h2, 0, 0x7fffffff, 0x00020000);
          const int vh = fr * 2048 + (wc * 32 + 4 * fq) * 2, sh = ((un.pm * 256 + wr * 64) * 1024 + un.pn * 256) * 2;
          v2u xb[4][2][2];
#define EPI4_LD(g) do { _Pragma("unroll") for (int bj = 0; bj < 2; ++bj) _Pragma("unroll") for (int n = 0; n < 2; ++n) \
              xb[(g) & 3][bj][n] = __builtin_amdgcn_raw_buffer_load_b64(rx, vh + bj * 256 + n * 32, sh + (((g) >> 2) * 128 + ((g) & 3) * 16) * 2048, 0); } while (0)
          EPI4_LD(0); EPI4_LD(1); EPI4_LD(2); EPI4_LD(3);
          v4u wt[4]; const v4u* src = (const v4u*)(WR + (size_t)un.pn * (2 * 32 * 256));
#pragma unroll
          for (int i = 0; i < 4; ++i) wt[i] = src[tid + 512 * i];
          f32x4 g2v[2][2], gi1[2][2]; float ri[8];
#pragma unroll
          for (int bj = 0; bj < 2; ++bj)
#pragma unroll
              for (int n = 0; n < 2; ++n) { g2v[bj][n] = *(const f32x4*)(g2 + col0 + bj * 128 + n * 16); gi1[bj][n] = *(const f32x4*)(g1 + col0 + bj * 128 + n * 16); }
#pragma unroll
          for (int g = 0; g < 8; ++g) ri[g] = rinv[row0 + (g >> 2) * 128 + (g & 3) * 16];
          __builtin_amdgcn_sched_barrier(0);
#pragma unroll
          for (int i = 0; i < 4; ++i) { const int L = tid + 512 * i; *(LAS v4u*)(lds + (L >> 5) * WR_LST + (L & 31) * 16) = wt[i]; }
#pragma unroll
          for (int bj = 0; bj < 2; ++bj)
#pragma unroll
              for (int n = 0; n < 2; ++n) { const f32x4 g = gi1[bj][n]; gi1[bj][n] = (f32x4){1.f / g[0], 1.f / g[1], 1.f / g[2], 1.f / g[3]}; }
#pragma unroll
          for (int g = 0; g < 8; ++g) { const int ai = g >> 2, m = g & 3;
#pragma unroll
              for (int bj = 0; bj < 2; ++bj)
#pragma unroll
                  for (int n = 0; n < 2; ++n) { const v2u hx = xb[g & 3][bj][n];
                      const f32x4 v = (f32x4){bflo(hx.x), bfhi(hx.x), bflo(hx.y), bfhi(hx.y)} * gi1[bj][n] * ri[g] + acc[ai][bj][m][n]; acc[ai][bj][m][n] = v;
                      const f32x4 hv = v * g2v[bj][n];
                      v2u w; w.x = pg8::cvt_pk_bf16(hv[0], hv[1]); w.y = pg8::cvt_pk_bf16(hv[2], hv[3]);
                      __builtin_amdgcn_raw_buffer_store_b64(w, rh, vh + bj * 256 + n * 32, sh + (ai * 128 + m * 16) * 2048, 0); }
              if (g + 4 < 8) EPI4_LD(g + 4);
              __builtin_amdgcn_sched_barrier(0); }
#undef EPI4_LD
        }
        __syncthreads(); P4_TMARK(8);
        LAS float* P = (LAS float*)(lds + 36864);
#pragma unroll
        for (int ai = 0; ai < 2; ++ai)
#pragma unroll
            for (int m = 0; m < 4; ++m) { float ss = 0.f; f32x4 l0 = (f32x4){0.f, 0.f, 0.f, 0.f}, l1 = l0;
#pragma unroll
                for (int bj = 0; bj < 2; ++bj) { const f32x4 v0 = acc[ai][bj][m][0], v1 = acc[ai][bj][m][1];
                    ss += (v0[0] * v0[0] + v0[1] * v0[1]) + (v0[2] * v0[2] + v0[3] * v0[3]) + (v1[0] * v1[0] + v1[1] * v1[1]) + (v1[2] * v1[2] + v1[3] * v1[3]);
                    const v4u hi = pack8(v0, v1);
                    const v4u lo = pack8(v0 - (f32x4){bflo(hi.x), bfhi(hi.x), bflo(hi.y), bfhi(hi.y)}, v1 - (f32x4){bflo(hi.z), bfhi(hi.z), bflo(hi.w), bfhi(hi.w)});
                    const bf16x8 Bh = __builtin_bit_cast(bf16x8, hi), Bl = __builtin_bit_cast(bf16x8, lo);
                    const LAS unsigned char* wp = lds + fr * WR_LST + (bj * 4 + wc) * 64 + fq * 16;
                    const bf16x8 Ah0 = *(const LAS bf16x8*)wp, Ah1 = *(const LAS bf16x8*)(wp + 16 * WR_LST), Al0 = *(const LAS bf16x8*)(wp + 32 * WR_LST), Al1 = *(const LAS bf16x8*)(wp + 48 * WR_LST);
                    l0 = __builtin_amdgcn_mfma_f32_16x16x32_bf16(Ah0, Bh, l0, 0, 0, 0); l0 = __builtin_amdgcn_mfma_f32_16x16x32_bf16(Ah0, Bl, l0, 0, 0, 0); l0 = __builtin_amdgcn_mfma_f32_16x16x32_bf16(Al0, Bh, l0, 0, 0, 0);
                    l1 = __builtin_amdgcn_mfma_f32_16x16x32_bf16(Ah1, Bh, l1, 0, 0, 0); l1 = __builtin_amdgcn_mfma_f32_16x16x32_bf16(Ah1, Bl, l1, 0, 0, 0); l1 = __builtin_amdgcn_mfma_f32_16x16x32_bf16(Al1, Bh, l1, 0, 0, 0); }
                ss += shx(ss, 16); ss += shx(ss, 32);
                LAS float* pr = P + (ai * 128 + wr * 64 + m * 16 + fr) * 100 + wc * 24;
                *(LAS f32x4*)(pr + 4 * fq) = l0;
                if (fq == 0) *(LAS f32x4*)(pr + 16) = l1;
                if (fq == 1) *(LAS f32x4*)(pr + 20) = (f32x4){ss, 0.f, 0.f, 0.f}; }
        __syncthreads(); P4_TMARK(9);
        float* gp = gpart + (size_t)(un.pm * 4 + un.pn) * (256 * 24);
        { const int row = tid >> 1, half = tid & 1;
#pragma unroll
          for (int q = 0; q < 3; ++q) { const LAS float* pr = P + row * 100 + half * 12 + 4 * q;
              const f32x4 s = ((*(const LAS f32x4*)pr + *(const LAS f32x4*)(pr + 24)) + *(const LAS f32x4*)(pr + 48)) + *(const LAS f32x4*)(pr + 72);
              unsigned long long* g8 = (unsigned long long*)(gp + row * 24 + half * 12 + 4 * q);
              __hip_atomic_store(g8, ((unsigned long long)__float_as_uint(s[1]) << 32) | __float_as_uint(s[0]), __ATOMIC_RELAXED, __HIP_MEMORY_SCOPE_AGENT);
              __hip_atomic_store(g8 + 1, ((unsigned long long)__float_as_uint(s[3]) << 32) | __float_as_uint(s[2]), __ATOMIC_RELAXED, __HIP_MEMORY_SCOPE_AGENT); } }
        asm volatile("s_waitcnt vmcnt(0)" ::: "memory");
        __syncthreads(); P4_TMARK(10);
        if (tid == 0) {
            const unsigned old = __hip_atomic_fetch_add(ctl + CW_PCNT + un.pm, 1u, __ATOMIC_RELAXED, __HIP_MEMORY_SCOPE_AGENT);
            if (old == 3u) { __builtin_amdgcn_fence(__ATOMIC_ACQUIRE, "agent"); asm volatile("s_waitcnt vmcnt(0)" ::: "memory"); }
            *(LAS unsigned*)lds = old; }
        __syncthreads();
        const unsigned old = (unsigned)__builtin_amdgcn_readfirstlane((int)*(const LAS unsigned*)lds);
        __syncthreads(); P4_TMARK(11);
        if (old == 3u) {
            LAS int* hist = (LAS int*)(lds + 512); LAS int* cbase = (LAS int*)(lds + 768);
            if (tid < 32) hist[tid] = 0;
            __syncthreads();
            int cls = 0, rank = 0; float wa = 0.f, wb = 0.f, r = 0.f;
            if (tid < 256) {
                f32x4 s[6];
#pragma unroll
                for (int q = 0; q < 6; ++q) s[q] = (f32x4){0.f, 0.f, 0.f, 0.f};
                const float* pp = gpart + (size_t)(un.pm * 4) * (256 * 24) + tid * 24;
#pragma unroll
                for (int t4 = 0; t4 < 4; ++t4)
#pragma unroll
                    for (int q = 0; q < 6; ++q) s[q] += *(const f32x4*)(pp + (size_t)t4 * (256 * 24) + 4 * q);
                r = rsqrtf(s[5][0] * (1.f / 1024.f) + 1e-6f);
                LAS float* lg = (LAS float*)(lds + 1024) + tid * 24;
#pragma unroll
                for (int q = 0; q < 5; ++q) *(LAS f32x4*)(lg + 4 * q) = s[q] * r;
                route_token(lg, bg, br, cls, wa, wb);
                rank = __hip_atomic_fetch_add(hist + cls, 1, __ATOMIC_RELAXED, __HIP_MEMORY_SCOPE_WORKGROUP);
            }
            __syncthreads();
            if (tid < 24) cbase[tid] = (int)__hip_atomic_fetch_add(ctl + CW_CCNT + CCNT_STRIDE * tid, (unsigned)hist[tid], __ATOMIC_RELAXED, __HIP_MEMORY_SCOPE_AGENT);
            __syncthreads();
            if (tid < 256) { const int token = un.pm * 256 + tid; rtokc[cls * T + cbase[cls] + rank] = token; swt[token] = (f32x4){wa, wb, r, 0.f}; } P4_TMARK(12);
        }
    }
};
__device__ __forceinline__ void class_experts(int c, int& ea, int& eb) {
    const int g = c / 6, p = c - 6 * g; const int a = p < 3 ? 0 : (p < 5 ? 1 : 2), b = p < 3 ? p + 1 : (p < 5 ? p - 1 : 3); ea = g * 4 + a; eb = g * 4 + b;
}
__device__ __forceinline__ void moe_tables(Frame& F) {
    const int tid_ = F.ftid(), lane_ = tid_ & 63; (void)lane_;
    LAS int* total = (LAS int*)(F.lds + TB_TOTAL); LAS int* tab = (LAS int*)(F.lds + TB_TAB);
    if (tid_ < 24) total[tid_] = (int)__hip_atomic_load((unsigned*)(F.ws() + WS_CTL) + CW_CCNT + CCNT_STRIDE * tid_, __ATOMIC_RELAXED, __HIP_MEMORY_SCOPE_AGENT);
    __syncthreads();
    if (tid_ == 0) { int tb = 0;
        for (int c = 0; c < 24; ++c) { const int nt_ = (total[c] + 255) >> 8; for (int r = 0; r < nt_; ++r) tab[1 + tb + r] = c | (r << 8); tb += nt_; }
        tab[0] = tb; }
    __syncthreads();
}
constexpr int CW_RT = 16384, RT_STRIDE = 64;
struct SchedP7 {
    __device__ __forceinline__ void a_ready(const pg8::Unit&) const {}
    int G, vcu; const LAS int* tab; const LAS int* total; const char* h2; const char* Wgu; const int* rtokc; int first, nmax;
    __device__ __forceinline__ bool next(int i, pg8::Unit& u) const {
        const int L = first + i * G + vcu, R = tab[0]; if (i >= nmax || L >= R * 8) return false;
        const int r = L >> 3, pn = L & 7, tv = tab[1 + r], c = tv & 255, rp = tv >> 8; int ea, eb; class_experts(c, ea, eb); const int e = pn < 4 ? ea : eb;
        const int nv = total[c] - 256 * rp;
        u.pm = r; u.pn = pn; u.aux = nv < 256 ? nv : 256; u.ksplit = 1 << 30; u.A = h2; u.ridx = rtokc + c * T + 256 * rp;
        u.B0 = Wgu + (size_t)e * (1024 * 2048) + (size_t)(pn & 3) * 256 * 2048; u.B1 = u.B0; return true;
    }
};
struct EpiP7 {
    static constexpr bool PERM = true, AFTER_DRAIN = false, PREFETCH = false;
    bf16* hid; const f32x4* swt; unsigned* ctl;
    __device__ __forceinline__ bool operator()(f32x4 (&acc)[2][2][4][2], const pg8::Unit& un, int wr, int wc, int fr, int fq) const {
        const int rl0 = wr * 64 + fr, sel = un.pn >> 2, col0 = sel * 512 + 128 * (un.pn & 3) + 16 * wc + 4 * fq, last = un.aux - 1;
        const __amdgpu_buffer_rsrc_t rs = __builtin_amdgcn_make_buffer_rsrc((void*)swt, 0, 0x7fffffff, 0x00020000);
        int tok[8]; float w[8], r[8];
#pragma unroll
        for (int g = 0; g < 8; ++g) { const int rl = rl0 + (g >> 2) * 128 + (g & 3) * 16; tok[g] = un.ridx[rl < last ? rl : last]; }
#pragma unroll
        for (int g = 0; g < 8; ++g) { w[g] = __builtin_bit_cast(float, __builtin_amdgcn_raw_buffer_load_b32(rs, tok[g] * 16, sel * 4, 0)); r[g] = __builtin_bit_cast(float, __builtin_amdgcn_raw_buffer_load_b32(rs, tok[g] * 16 + 8, 0, 0)); }
        __builtin_amdgcn_sched_barrier(0);
#pragma unroll
        for (int g = 0; g < 8; ++g) { const int ai = g >> 2, m = g & 3, rl = rl0 + ai * 128 + m * 16; const bool ok = rl <= last; const float rr = ok ? r[g] : 0.f, rw = ok ? r[g] * w[g] : 0.f;
#pragma unroll
            for (int bj = 0; bj < 2; ++bj) { const f32x4 gv = acc[ai][bj][m][0] * rr, uv = acc[ai][bj][m][1] * rw; f32x4 hh;
#pragma unroll
                for (int e = 0; e < 4; ++e) hh[e] = gv[e] * fsigmoid(gv[e]) * uv[e];
                v2u o; o.x = pg8::cvt_pk_bf16(hh[0], hh[1]); o.y = pg8::cvt_pk_bf16(hh[2], hh[3]);
                *(v2u*)(hid + (size_t)(un.pm * 256 + rl) * 1024 + col0 + 64 * bj) = o; } }
        return true;
    }
};
struct SchedP8 {
    int G, vcu; const LAS int* tab; const LAS int* total; const char* hid; const char* WdT; const int* rtokc; unsigned* ctl; int first, nmax;
    __device__ __forceinline__ bool next(int i, pg8::Unit& u) const {
        const int L = first + i * G + vcu, R = tab[0]; if (i >= nmax || L < 0 || L >= R * 4) return false;
        const int r = L >> 2, pn = L & 3, tv = tab[1 + r], c = tv & 255, rp = tv >> 8; int ea, eb; class_experts(c, ea, eb);
        const int nv = total[c] - 256 * rp;
        u.pm = r; u.pn = pn; u.aux = nv < 256 ? nv : 256; u.ksplit = 8; u.A = hid + (size_t)r * 256 * 2048; u.ridx = rtokc + c * T + 256 * rp;
        u.B0 = WdT + (size_t)ea * (1024 * 1024) + (size_t)pn * 256 * 1024; u.B1 = WdT + (size_t)eb * (1024 * 1024) + (size_t)pn * 256 * 1024; return true;
    }
    __device__ __forceinline__ void a_ready(const pg8::Unit&) const {}
};
struct EpiP8 {
    static constexpr bool PERM = false, AFTER_DRAIN = false, PREFETCH = false;
    float* out; const bf16* h2; const float* g2;
    __device__ __forceinline__ bool operator()(f32x4 (&acc)[2][2][4][2], const pg8::Unit& un, int wr, int wc, int fr, int fq) const {
        const int rl0 = wr * 64 + fr, col0 = un.pn * 256 + wc * 32 + 4 * fq, last = un.aux - 1;
        const __amdgpu_buffer_rsrc_t rh = __builtin_amdgcn_make_buffer_rsrc((void*)h2, 0, 0x7fffffff, 0x00020000), ro = __builtin_amdgcn_make_buffer_rsrc((void*)out, 0, T * 1024 * 4, 0x00020000);
        int tok[8];
#pragma unroll
        for (int g = 0; g < 8; ++g) { const int rl = rl0 + (g >> 2) * 128 + (g & 3) * 16; tok[g] = un.ridx[rl < last ? rl : last]; }
        f32x4 gi[2][2];
#pragma unroll
        for (int bj = 0; bj < 2; ++bj)
#pragma unroll
            for (int n = 0; n < 2; ++n) { const f32x4 g = *(const f32x4*)(g2 + col0 + bj * 128 + n * 16); gi[bj][n] = (f32x4){1.f / g[0], 1.f / g[1], 1.f / g[2], 1.f / g[3]}; }
        v2u hw[2][2][2];
#define EPI8_LD(g) do { const int vo_ = tok[g] * 2048 + col0 * 2; _Pragma("unroll") for (int bj = 0; bj < 2; ++bj) _Pragma("unroll") for (int n = 0; n < 2; ++n) \
            hw[(g) & 1][bj][n] = __builtin_amdgcn_raw_buffer_load_b64(rh, vo_ + bj * 256 + n * 32, 0, 0); } while (0)
        EPI8_LD(0);
#pragma unroll
        for (int g = 0; g < 8; ++g) { const int ai = g >> 2, m = g & 3, rl = rl0 + ai * 128 + m * 16;
            if (g + 1 < 8) EPI8_LD(g + 1);
            const int so = rl <= last ? tok[g] * 4096 + col0 * 4 : 0x70000000;
#pragma unroll
            for (int bj = 0; bj < 2; ++bj)
#pragma unroll
                for (int n = 0; n < 2; ++n) { const v2u h = hw[g & 1][bj][n];
                    const f32x4 xm = (f32x4){bflo(h.x), bfhi(h.x), bflo(h.y), bfhi(h.y)} * gi[bj][n] + acc[ai][bj][m][n];
                    __builtin_amdgcn_raw_buffer_store_b128(__builtin_bit_cast(v4u, xm), ro, so + bj * 512 + n * 64, 0, 0); }
            __builtin_amdgcn_sched_barrier(0); }
#undef EPI8_LD
        return true;
    }
};
constexpr int KST64 = 144, KST128 = 272, VST = 528;
template <int DH, bool SWA>
__device__ __forceinline__ void attn256_mtile(const LAS unsigned char* Kl, const LAS unsigned char* Vl, const bf16x8 (&qf)[DH / 32], bf16* orow0, int ldo,
                                              float sink_l2, int i0, bool has_prev, int lane) {
    constexpr int KST = DH * 2 + 16, NKS = DH / 32, NDT = DH / 16;
    const int qi = lane & 15, g = lane >> 4;
    float ssq = 0.f;
#pragma unroll
    for (int ks = 0; ks < NKS; ++ks) {
        if (!SWA) {
#pragma unroll
            for (int e = 0; e < 8; ++e) { const float x = bf2f((bf16)qf[ks][e]); ssq += x * x; } } }
    float sc;
    if (SWA) sc = 0.125f * 1.4426950408889634f;
    else { ssq += shx(ssq, 16); ssq += shx(ssq, 32); sc = rsqrtf(ssq * (1.f / 128.f) + 1e-6f) * (0.08838834764831845f * 1.4426950408889634f); }
    f32x4 sacc[SWA ? 5 : 8][2];
    const int krow = 8 * (qi >> 2) + (qi & 3);
    constexpr int NS = SWA ? 5 : 8; const int sbase = SWA ? (i0 + 1) >> 5 : 0;
#pragma unroll
    for (int s = 0; s < NS; ++s)
#pragma unroll
        for (int h = 0; h < 2; ++h) { f32x4 c = (f32x4){0.f, 0.f, 0.f, 0.f}; const LAS unsigned char* kp = Kl + (32 * (sbase + s) + krow + 4 * h) * KST + 16 * g;
#pragma unroll
            for (int ks = 0; ks < NKS; ++ks) c = __builtin_amdgcn_mfma_f32_16x16x32_bf16(*(const LAS bf16x8*)(kp + 64 * ks), qf[ks], c, 0, 0, 0);
            sacc[s][h] = c; if (h == 1) __builtin_amdgcn_sched_barrier(0); }
    float mr = -3.0e38f;
#pragma unroll
    for (int s = 0; s < NS; ++s) {
        if (SWA && (s == 0 || s == NS - 1 || !has_prev)) {
#pragma unroll
            for (int h = 0; h < 2; ++h)
#pragma unroll
                for (int r = 0; r < 4; ++r) { const int kb = 32 * (sbase + s) + 8 * g + 4 * h + r, delta = 128 + i0 + qi - kb; const bool ok = (delta >= 0) && (delta < 128) && (has_prev || kb >= 128);
                    sacc[s][h][r] = ok ? sacc[s][h][r] : -1.0e30f; } }
#pragma unroll
        for (int h = 0; h < 2; ++h) mr = fmaxf(fmaxf(mr, fmaxf(sacc[s][h][0], sacc[s][h][1])), fmaxf(sacc[s][h][2], sacc[s][h][3])); }
    mr = fmaxf(mr, shx(mr, 16)); mr = fmaxf(mr, shx(mr, 32));
    float m = mr * sc; if (SWA) m = fmaxf(m, sink_l2);
    float sum = 0.f;
#pragma unroll
    for (int s = 0; s < NS; ++s)
#pragma unroll
        for (int h = 0; h < 2; ++h)
#pragma unroll
            for (int r = 0; r < 4; ++r) { const float p = __builtin_amdgcn_exp2f(__builtin_fmaf(sacc[s][h][r], sc, -m)); sacc[s][h][r] = p; sum += p; }
    sum += shx(sum, 16); sum += shx(sum, 32);
    if (SWA) sum += __builtin_amdgcn_exp2f(sink_l2 - m);
    const float inv = 1.f / sum;
    bf16x8 pf[NS];
#pragma unroll
    for (int s = 0; s < NS; ++s) { v4u w; w.x = pg8::cvt_pk_bf16(sacc[s][0][0], sacc[s][0][1]); w.y = pg8::cvt_pk_bf16(sacc[s][0][2], sacc[s][0][3]);
        w.z = pg8::cvt_pk_bf16(sacc[s][1][0], sacc[s][1][1]); w.w = pg8::cvt_pk_bf16(sacc[s][1][2], sacc[s][1][3]); pf[s] = __builtin_bit_cast(bf16x8, w); }
#pragma unroll
    for (int dt = 0; dt < NDT; dt += 2) { f32x4 o0 = (f32x4){0.f, 0.f, 0.f, 0.f}, o1 = o0;
        const LAS unsigned char* vp = Vl + (16 * dt + qi) * VST + 16 * g + 64 * sbase;
#pragma unroll
        for (int s = 0; s < NS; ++s) { o0 = __builtin_amdgcn_mfma_f32_16x16x32_bf16(*(const LAS bf16x8*)(vp + 64 * s), pf[s], o0, 0, 0, 0);
            o1 = __builtin_amdgcn_mfma_f32_16x16x32_bf16(*(const LAS bf16x8*)(vp + 16 * VST + 64 * s), pf[s], o1, 0, 0, 0); }
        v2u w; w.x = pg8::cvt_pk_bf16(o0[0] * inv, o0[1] * inv); w.y = pg8::cvt_pk_bf16(o0[2] * inv, o0[3] * inv);
        *(v2u*)(orow0 + (size_t)qi * ldo + 16 * dt + 4 * g) = w;
        w.x = pg8::cvt_pk_bf16(o1[0] * inv, o1[1] * inv); w.y = pg8::cvt_pk_bf16(o1[2] * inv, o1[3] * inv);
        *(v2u*)(orow0 + (size_t)qi * ldo + 16 * dt + 16 + 4 * g) = w; __builtin_amdgcn_sched_barrier(0); }
}
template <int DH>
__device__ __forceinline__ void vt_load(v4u (&va)[DH / 32], v4u (&vb)[DH / 32], const bf16* vsrc, int ldv, int kmin, int tid) {
    constexpr int NC = DH / 8;
#pragma unroll
    for (int i = 0; i < DH / 32; ++i) { const int id = tid + 512 * i, c = id % NC, kp = id / NC; const bool ok = 2 * kp >= kmin; const int r = ok ? 2 * kp : kmin;
        const v4u a = *(const v4u*)(vsrc + (long)r * ldv + 8 * c), b = *(const v4u*)(vsrc + (long)(r + 1) * ldv + 8 * c);
        va[i] = ok ? a : (v4u){0u, 0u, 0u, 0u}; vb[i] = ok ? b : (v4u){0u, 0u, 0u, 0u}; }
}
template <int DH>
__device__ __forceinline__ void vt_store(LAS unsigned char* Vl, const v4u (&va)[DH / 32], const v4u (&vb)[DH / 32], int tid) {
    constexpr int NC = DH / 8;
#pragma unroll
    for (int i = 0; i < DH / 32; ++i) { const int id = tid + 512 * i, c = id % NC, kp = id / NC; LAS unsigned char* dst = Vl + (8 * c) * VST + 4 * kp;
        const unsigned aw[4] = {va[i].x, va[i].y, va[i].z, va[i].w}, bw[4] = {vb[i].x, vb[i].y, vb[i].z, vb[i].w};
#pragma unroll
        for (int e = 0; e < 4; ++e) { *(LAS unsigned*)(dst + (2 * e) * VST) = (aw[e] & 0xffffu) | (bw[e] << 16); *(LAS unsigned*)(dst + (2 * e + 1) * VST) = (aw[e] >> 16) | (bw[e] & 0xffff0000u); } }
}
struct SwaRegs { bf16x8 qa[4][2]; v4u kr[4]; v4u va[2], vb[2]; };
__device__ __forceinline__ void swa_load(Frame& F, int u, SwaRegs& R) {
    const int tid_ = F.ftid(), lane_ = tid_ & 63;
    const int hk = u & 1, n = (u >> 1) & 63, b = u >> 7;
    unsigned char* dout = (unsigned char*)F.out();
    const bf16* q = (const bf16*)(dout + DO_Q); const bf16* k = (const bf16*)(dout + DO_K); const bf16* v = (const bf16*)(dout + DO_V);
    const int rowb = b * SEQ + 128 * (n - 1), kmin = (n == 0) ? 128 : 0;
    const int hq = 4 * hk + (F.wave >> 1), r0 = 64 * (F.wave & 1);
#pragma unroll
    for (int mt = 0; mt < 4; ++mt)
#pragma unroll
        for (int ks = 0; ks < 2; ++ks) R.qa[mt][ks] = *(const bf16x8*)(q + ((size_t)b * SEQ + 128 * n + r0 + 16 * mt + (lane_ & 15)) * 512 + hq * 64 + 8 * (lane_ >> 4) + 32 * ks);
#pragma unroll
    for (int i = 0; i < 4; ++i) { const int id = tid_ + 512 * i, key = id >> 3, c = id & 7; const bool ok = key >= kmin;
        const v4u w = *(const v4u*)(k + ((long)(rowb + (ok ? key : kmin)) * 128 + hk * 64 + 8 * c)); R.kr[i] = ok ? w : (v4u){0u, 0u, 0u, 0u}; }
    vt_load<64>(R.va, R.vb, v + ((long)rowb * 128 + hk * 64), 128, kmin, tid_);
}
__device__ __forceinline__ void swa_run(Frame& F, int u, const SwaRegs& R) {
    const int tid_ = F.ftid(), lane_ = tid_ & 63;
    const int hk = u & 1, n = (u >> 1) & 63, b = u >> 7;
    bf16* acts = (bf16*)(F.ws() + WS_ACTS);
    LAS unsigned char* Kl = F.lds; LAS unsigned char* Vl = F.lds + 256 * KST64;
    const int hq = 4 * hk + (F.wave >> 1), r0 = 64 * (F.wave & 1);
#pragma unroll
    for (int i = 0; i < 4; ++i) { const int id = tid_ + 512 * i, key = id >> 3, c = id & 7; *(LAS v4u*)(Kl + key * KST64 + 16 * c) = R.kr[i]; }
    vt_store<64>(Vl, R.va, R.vb, tid_);
    __syncthreads();
    const float sink_l2 = F.in(7)[hq] * 1.4426950408889634f;
#pragma unroll
    for (int mt = 0; mt < 4; ++mt) { const int i0 = r0 + 16 * mt; const size_t tok0 = (size_t)b * SEQ + 128 * n + i0;
        attn256_mtile<64, true>(Kl, Vl, R.qa[mt], acts + tok0 * 1536 + hq * 64, 1536, sink_l2, i0, n > 0, lane_); }
    __syncthreads();
}
struct XatRegs { bf16x8 qa[2][4]; v4u kr[8]; v4u va[4], vb[4]; };
__device__ __forceinline__ void xattn_load(Frame& F, int u, XatRegs& R) {
    const int tid_ = F.ftid(), lane_ = tid_ & 63;
    const int qb = u & 31, h = (u >> 5) & 3, b = u >> 7;
    const bf16* mkv = (const bf16*)(F.ws() + WS_MKV); const bf16* xq = (const bf16*)(F.ws() + WS_XQ);
#pragma unroll
    for (int mt = 0; mt < 2; ++mt)
#pragma unroll
        for (int ks = 0; ks < 4; ++ks) R.qa[mt][ks] = *(const bf16x8*)(xq + ((size_t)b * SEQ + 256 * qb + 32 * F.wave + 16 * mt + (lane_ & 15)) * 512 + h * 128 + 8 * (lane_ >> 4) + 32 * ks);
    const int c = tid_ & 15;
#pragma unroll
    for (int i = 0; i < 8; ++i) { const int key = (tid_ >> 4) + 32 * i; R.kr[i] = *(const v4u*)(mkv + (size_t)(b * 256 + key) * 1024 + h * 128 + 8 * c); }
    vt_load<128>(R.va, R.vb, mkv + (size_t)(b * 256) * 1024 + 512 + h * 128, 1024, 0, tid_);
}
__device__ __forceinline__ void xattn_run(Frame& F, int u, const XatRegs& R) {
    const int tid_ = F.ftid(), lane_ = tid_ & 63;
    const int qb = u & 31, h = (u >> 5) & 3, b = u >> 7;
    bf16* acts = (bf16*)(F.ws() + WS_ACTS);
    LAS unsigned char* Kl = F.lds; LAS unsigned char* Vl = F.lds + 256 * KST128;
    { const int c = tid_ & 15; const f32x4 ga = *(const f32x4*)(F.in(17) + 8 * c), gb = *(const f32x4*)(F.in(17) + 8 * c + 4), qa = *(const f32x4*)(F.in(16) + 8 * c), qc = *(const f32x4*)(F.in(16) + 8 * c + 4);
      const f32x4 g0 = ga * qa, g1 = gb * qc;
#pragma unroll
      for (int i = 0; i < 8; ++i) { const int key = (tid_ >> 4) + 32 * i; const v4u w = R.kr[i];
          f32x4 x0 = (f32x4){bflo(w.x), bfhi(w.x), bflo(w.y), bfhi(w.y)}, x1 = (f32x4){bflo(w.z), bfhi(w.z), bflo(w.w), bfhi(w.w)};
          float ss = (x0[0] * x0[0] + x0[1] * x0[1]) + (x0[2] * x0[2] + x0[3] * x0[3]) + (x1[0] * x1[0] + x1[1] * x1[1]) + (x1[2] * x1[2] + x1[3] * x1[3]);
          ss += shx(ss, 1); ss += shx(ss, 2); ss += shx(ss, 4); ss += shx(ss, 8);
          const float r = rsqrtf(ss * (1.f / 128.f) + 1e-6f); x0 = x0 * r * g0; x1 = x1 * r * g1;
          *(LAS v4u*)(Kl + key * KST128 + 16 * c) = pack8(x0, x1); } }
    vt_store<128>(Vl, R.va, R.vb, tid_);
    __syncthreads();
#pragma unroll
    for (int mt = 0; mt < 2; ++mt) { const size_t tok0 = (size_t)b * SEQ + 256 * qb + 32 * F.wave + 16 * mt;
        attn256_mtile<128, false>(Kl, Vl, R.qa[mt], acts + tok0 * 1536 + 1024 + h * 128, 1536, 0.f, 0, true, lane_); }
    __syncthreads();
}
__device__ __forceinline__ void conv_load(Frame& F, int cu, v4u (&pre)[8]) {
    const int tid_ = F.ftid(); const bf16* u = (const bf16*)(F.ws() + WS_U);
    const int t0 = 32 * cu, s0 = t0 & (SEQ - 1);
#pragma unroll
    for (int i = 0; i < 8; ++i) { const int id = tid_ + 512 * i, j0 = id >> 6, c = id & 63, j = j0 < 62 ? j0 : 61; const bool ok = s0 - 30 + j >= 0;
        const v4u w = *(const v4u*)(u + (long)(t0 - 30 + (ok ? j : 30)) * 512 + 8 * c); pre[i] = ok ? w : (v4u){0u, 0u, 0u, 0u}; }
}
__device__ __forceinline__ void conv_run(Frame& F, int cu, const v4u (&pre)[8]) {
    const int tid_ = F.ftid(), lane_ = tid_ & 63;
    bf16* acts = (bf16*)(F.ws() + WS_ACTS);
    LAS unsigned char* Ul = F.lds; LAS float* Yl = (LAS float*)(F.lds + 62 * 1024);
    const int t0 = 32 * cu;
#pragma unroll
    for (int i = 0; i < 8; ++i) { const int id = tid_ + 512 * i, j = id >> 6, c = id & 63; if (id < 62 * 64) *(LAS v4u*)(Ul + j * 1024 + 16 * c) = pre[i]; }
    __syncthreads();
    { const int cp = tid_ & 255, th = tid_ >> 8;
      const float* wdw = F.in(9); const float2 bias = *(const float2*)(F.in(10) + 2 * cp);
      f32x2v w[31];
#pragma unroll
      for (int j = 0; j < 31; ++j) { const float2 t = *(const float2*)(wdw + j * 512 + 2 * cp); w[j] = (f32x2v){t.x, t.y}; }
#pragma unroll 1
      for (int ch = 0; ch < 2; ++ch) { const int i0 = 16 * th + 8 * ch;
          f32x2v acc[8];
#pragma unroll
          for (int i = 0; i < 8; ++i) acc[i] = (f32x2v){bias.x, bias.y};
#pragma unroll
          for (int r = 0; r < 38; ++r) { const unsigned x = *(const LAS unsigned*)(Ul + (i0 + r) * 1024 + 4 * cp); const f32x2v xv = (f32x2v){bflo(x), bfhi(x)};
#pragma unroll
              for (int i = 0; i < 8; ++i) { const int j = r - i; if (j >= 0 && j < 31) acc[i] = __builtin_elementwise_fma(w[j], xv, acc[i]); } }
#pragma unroll
          for (int i = 0; i < 8; ++i) *(LAS f32x2v*)(Yl + (i0 + i) * 512 + 2 * cp) = acc[i]; }
    }
    __syncthreads();
    { const int lane = lane_; const f32x4 ga = *(const f32x4*)(F.in(11) + 8 * lane), gb = *(const f32x4*)(F.in(11) + 8 * lane + 4), ba = *(const f32x4*)(F.in(12) + 8 * lane), bb = *(const f32x4*)(F.in(12) + 8 * lane + 4);
#pragma unroll
      for (int i = 0; i < 4; ++i) { const int tk = 4 * F.wave + i; const f32x4 y0 = *(const LAS f32x4*)(Yl + tk * 512 + 8 * lane), y1 = *(const LAS f32x4*)(Yl + tk * 512 + 8 * lane + 4);
          const float mean = wave_sum((y0[0] + y0[1]) + (y0[2] + y0[3]) + (y1[0] + y1[1]) + (y1[2] + y1[3])) * (1.f / 512.f);
          const f32x4 d0 = y0 - mean, d1 = y1 - mean;
          const float var = wave_sum((d0[0] * d0[0] + d0[1] * d0[1]) + (d0[2] * d0[2] + d0[3] * d0[3]) + (d1[0] * d1[0] + d1[1] * d1[1]) + (d1[2] * d1[2] + d1[3] * d1[3])) * (1.f / 512.f);
          const float rstd = rsqrtf(var + 1e-5f);
          f32x4 z0 = d0 * rstd * ga + ba, z1 = d1 * rstd * gb + bb;
#pragma unroll
          for (int e = 0; e < 4; ++e) { z0[e] = z0[e] * fsigmoid(z0[e]); z1[e] = z1[e] * fsigmoid(z1[e]); }
          *(v4u*)(acts + (size_t)(t0 + tk) * 1536 + 512 + 8 * lane) = pack8(z0, z1); } }
    __syncthreads();
}
__device__ __forceinline__ void p2_mixers(Frame& F) {
    for (int u = F.vcu; u < 256; u += F.G) {
        v4u c1[8], c2[8]; conv_load(F, 2 * u, c1); conv_load(F, 2 * u + 1, c2);
        SwaRegs S; TSUB_BEG(0) conv_run(F, 2 * u, c1); TSUB_END(0) swa_load(F, u, S);
        TSUB_BEG(1) conv_run(F, 2 * u + 1, c2); TSUB_END(1)
        XatRegs X; xattn_load(F, u, X);
        TSUB_BEG(2) swa_run(F, u, S); TSUB_END(2)
        TSUB_BEG(3) xattn_run(F, u, X); TSUB_END(3)
    }
}
__global__ void __launch_bounds__(NWAVES * 64, 2) mk_fwd(Args args) {
    extern __shared__ __attribute__((aligned(16))) unsigned char lds[];
    Frame F;
    F.lds = (LAS unsigned char*)lds;
    F.MISC = (volatile LAS unsigned*)(F.lds + MISC_OFF);
    const int tid_ = F.ftid(); F.wave = __builtin_amdgcn_readfirstlane(tid_ >> 6);
    F.G = gridDim.x; { const int bx = blockIdx.x; F.vcu = (F.G % 8 == 0) ? (bx % 8) * (F.G / 8) + bx / 8 : bx; }
    F.ctl = (gu32*)(args.ws + WS_CTL);
    for (int u = tid_; u < (LDS_BYTES - LDSCTL_OFF) / 4; u += NWAVES * 64) ((LAS unsigned*)(F.lds + LDSCTL_OFF))[u] = 0u;
    __syncthreads();
    if (tid_ < 30) ((LAS unsigned long long*)(F.lds + PARG_OFF))[tid_] = tid_ < 28 ? (unsigned long long)args.in[tid_] : (tid_ == 28 ? (unsigned long long)args.out : (unsigned long long)args.ws);
    __syncthreads();
    XcdBarrier bar = xcd_barrier_post((unsigned*)(F.ctl + CW_BAR) + args.li * XCD_BAR_WORDS, F.MISC + 8);
    const int lo = args.ph_lo, hi = args.ph_hi;
#define IN(k) (lo <= (k) && (k) < hi)
#define BOTH(k) (IN(k) && IN((k) + 1))

#ifndef MK_REP
#define MK_REP 0
#endif
#ifndef MK_XBAR
#define MK_XBAR 0
#endif
#ifndef MK_TPROBE
#define MK_TPROBE -1
#endif
    unsigned long long tp0 = 0, tp1 = 0;
#define RUN(kk, BODY) if (IN(kk)) { if (MK_TPROBE == (kk)) tp0 = __builtin_amdgcn_s_memrealtime(); BODY if (BOTH(kk) || MK_TPROBE == (kk)) xcd_barrier(bar); if (MK_TPROBE == (kk)) tp1 = __builtin_amdgcn_s_memrealtime(); }
#define PH0 { p0_prologue(F); }
#define PH1 { unsigned char* ws = F.ws(); unsigned char* dout = (unsigned char*)F.out(); SchedP1 S{F.G, (int)blockIdx.x, (const char*)(dout + DO_H), (const char*)(ws + WS_W1), (const char*)(ws + WS_MEMN), (const char*)(ws + WS_WKV)}; \
        EpiP1 E{(bf16*)(dout + DO_Q), (bf16*)(dout + DO_K), (bf16*)(dout + DO_V), (bf16*)(ws + WS_U), (bf16*)(ws + WS_XQ), (bf16*)(ws + WS_GATES), (bf16*)(ws + WS_MKV), (const float2*)(ws + WS_CS), F.in(5), F.in(6)}; \
        pg8::gemm_phase<EpiP1, SchedP1, true, false, false, 16, 2048u, 2048u>(F.lds + RING_OFF, S, E); convert_b_tail(F); }
#define PH2 { p2_mixers(F); }
#define PH3 { unsigned char* ws = F.ws(); SchedP3 S{F.G, (int)blockIdx.x, (const char*)(ws + WS_ACTS), (const char*)(ws + WS_WO3)}; EpiP3 E{(const unsigned char*)(ws + WS_GATES), (bf16*)(ws + WS_MERGED)}; \
        pg8::gemm_phase<EpiP3, SchedP3, true, false, false, 8, 3072u, 1024u>(F.lds + RING_OFF, S, E); }
#define PH4 { unsigned char* ws = F.ws(); SchedP4 S{F.G, (int)blockIdx.x, (const char*)(ws + WS_MERGED), (const char*)(ws + WS_WOUT)}; \
        EpiP4F E{(const bf16*)((unsigned char*)F.out() + DO_H), (const float*)(ws + WS_RINV), (bf16*)(ws + WS_H2), F.in(20), (const bf16*)(ws + WS_WRT), (float*)(ws + WS_PART), (unsigned*)(ws + WS_CTL), F.in(22), F.in(24), (int*)(ws + WS_ROUTE + RT_TOKC), (f32x4*)(ws + WS_ROUTE + RT_SWT), F.in(3)}; \
        pg8::gemm_phase<EpiP4F, SchedP4, false, false, false, 16, 2048u, 2048u>(F.lds + RING_OFF, S, E); }
#define PH6 { }
#define MOE_SCHEDS unsigned char* ws = F.ws(); const LAS int* tab_ = (const LAS int*)(F.lds + TB_TAB); const LAS int* tot_ = (const LAS int*)(F.lds + TB_TOTAL); \
        EpiP7 E7{(bf16*)(ws + WS_HID), (const f32x4*)(ws + WS_ROUTE + RT_SWT), (unsigned*)(ws + WS_CTL)}; EpiP8 E8{F.out(), (const bf16*)(ws + WS_H2), F.in(20)};
#define SCHED7(first, nmax) SchedP7{F.G, F.vcu, tab_, tot_, (const char*)(ws + WS_H2), (const char*)(ws + WS_WGU), (const int*)(ws + WS_ROUTE + RT_TOKC), (first), (nmax)}
#define SCHED8(first, nmax) SchedP8{F.G, F.vcu, tab_, tot_, (const char*)(ws + WS_HID), (const char*)(ws + WS_WDT), (const int*)(ws + WS_ROUTE + RT_TOKC), (unsigned*)(ws + WS_CTL), (first), (nmax)}
#define GEMM7(S) pg8::gemm_phase<EpiP7, SchedP7, true, true, false, 16, 2048u, 2048u>(F.lds + RING_OFF, S, E7)
#define GEMM8(S) pg8::gemm_phase<EpiP8, SchedP8, true, false, true, 16, 2048u, 1024u>(F.lds + RING_OFF, S, E8)
#define PH7 { moe_tables(F); convert_b2_all(F); MOE_SCHEDS const SchedP7 S = SCHED7(0, 2); GEMM7(S); }
#define PH8 { MOE_SCHEDS const int R8 = 8 * tab_[0], m7 = R8 > 2 * F.G ? R8 - 2 * F.G : 0; \
        if (F.vcu < m7) { const SchedP7 S = SCHED7(2 * F.G, 1); GEMM7(S); } else { const SchedP8 S = SCHED8(-m7, 1); GEMM8(S); } }
#define PH9 { MOE_SCHEDS const int R8 = 8 * tab_[0], m7 = R8 > 2 * F.G ? R8 - 2 * F.G : 0; const SchedP8 S = SCHED8(F.G - m7, 1 << 20); GEMM8(S); }
    RUN(0, PH0) RUN(1, PH1) RUN(2, PH2) RUN(3, PH3) RUN(4, PH4) RUN(7, PH7) RUN(8, PH8) RUN(9, PH9)
#ifdef MK_TSUB
    if (MK_TSUB >= 0 && blockIdx.x == 0) { const unsigned long long d = (((LAS unsigned long long*)(F.lds + PARG_OFF + 256))[1] - ((LAS unsigned long long*)(F.lds + PARG_OFF + 256))[0]) * 8ull, ts = __builtin_amdgcn_s_memrealtime(); while (__builtin_amdgcn_s_memrealtime() - ts < d) __builtin_amdgcn_s_sleep(8); }
#endif
    if (MK_TPROBE >= 0 && blockIdx.x == 0) { const unsigned long long d = (tp1 - tp0) * 8ull, ts = __builtin_amdgcn_s_memrealtime(); while (__builtin_amdgcn_s_memrealtime() - ts < d) __builtin_amdgcn_s_sleep(8); }
#undef IN
#undef BOTH
}

static void launch_mk(Args a, int lo, int hi, int li, int grid, hipStream_t stream) {
    a.ph_lo = lo; a.ph_hi = hi; a.li = li; a.pad = 0;
    hipLaunchKernelGGL(mk_fwd, dim3(grid), dim3(NWAVES * 64), LDS_BYTES, stream, a);
}
extern "C" void kernel_launch(void* const* d_in, const int* in_sizes, int n_in, void* d_out, int out_size, void* d_ws, size_t ws_size, hipStream_t stream) {
    static int grid = 0;
    if (grid == 0) {
        int dev = 0, cus = 0, per_cu = 0;
        if (n_in != 28 || out_size != T * D || ws_size < WS_END || hipGetDevice(&dev) != hipSuccess || hipDeviceGetAttribute(&cus, hipDeviceAttributeMultiprocessorCount, dev) != hipSuccess) {
            fprintf(stderr, "kernel_launch: built for 28 inputs, %d outputs and >= %zu bytes of workspace (n_in %d, out %d, ws %zu); nothing launched\n", T * D, (size_t)WS_END, n_in, out_size, ws_size); grid = -1; return; }
        if (hipFuncSetAttribute((const void*)mk_fwd, hipFuncAttributeMaxDynamicSharedMemorySize, LDS_BYTES) != hipSuccess) { fprintf(stderr, "kernel_launch: hipFuncSetAttribute failed\n"); grid = -1; return; }
        if (hipOccupancyMaxActiveBlocksPerMultiprocessor(&per_cu, (const void*)mk_fwd, NWAVES * 64, LDS_BYTES) != hipSuccess || per_cu < 1) { fprintf(stderr, "kernel_launch: occupancy query reports %d workgroups per CU; nothing launched\n", per_cu); grid = -1; (void)hipGetLastError(); return; }
        grid = cus;
        if (grid != 256) fprintf(stderr, "kernel_launch: note: tuned for 256 CUs, running on %d\n", grid);
    }
    if (grid < 0) return;
    if (hipMemsetAsync((char*)d_ws + WS_CTL, 0, CTL_ZERO_BYTES, stream) != hipSuccess) { fprintf(stderr, "kernel_launch: hipMemsetAsync failed\n"); return; }
    Args a{};
    for (int i = 0; i < 28; ++i) a.in[i] = (const float*)d_in[i];
    a.out = (float*)d_out; a.ws = (unsigned char*)d_ws;
    launch_mk(a, 0, 10, 0, grid, stream);
}
```

```cpp
#include <hip/hip_runtime.h>
#include <cstdint>
#include <cstdio>
#define MK_LEVEL 4
#define MK_GTB 0
#define MK_SPLIT_HI 9
#define MK_SPLIT_LO 9
#define MK_MIXN 0
#define MK_SPLIT01 0
constexpr int NWAVES = 8;
constexpr int T = 16384, SEQ = 8192, D = 1024, INW = 5376;
constexpr size_t MiB = 1u << 20;
constexpr size_t WS_CTL = 0, CTL_ZERO_BYTES = 1 * MiB;
constexpr size_t WS_W1 = 1 * MiB;
constexpr size_t WS_WO3 = 12 * MiB;
constexpr size_t WS_WOUT = 15 * MiB;
constexpr size_t WS_WKV = 17 * MiB;
constexpr size_t WS_WGU = 19 * MiB;
constexpr size_t WS_WDT = 51 * MiB;
constexpr size_t WS_CS = 67 * MiB;
constexpr size_t WS_MEMN = 71 * MiB;
constexpr size_t WS_MKV = 72 * MiB;
constexpr size_t WS_ROUTE = 73 * MiB;
constexpr size_t WS_RINV = WS_ROUTE + 1792 * 1024;
constexpr size_t WS_U = 76 * MiB;
constexpr size_t WS_XQ = 92 * MiB;
constexpr size_t WS_MERGED = 76 * MiB;
constexpr size_t WS_GATES = 108 * MiB;
constexpr size_t WS_H2 = 212 * MiB;
constexpr size_t WS_HID = 156 * MiB;
constexpr size_t WS_ACTS = 204 * MiB;
constexpr size_t WS_END = 252 * MiB;
constexpr size_t DO_H = 0, DO_Q = 32 * MiB, DO_K = 48 * MiB, DO_V = 52 * MiB;
constexpr size_t RT_CLS = 0;
constexpr size_t RT_W = 64 * 1024;
constexpr size_t RT_CNT = 192 * 1024;
constexpr size_t RT_TOK = 256 * 1024;
constexpr size_t RT_SW = 384 * 1024;
constexpr int CW_TMO = 0, CW_BAR = 4096;
constexpr int RING_OFF = 0, RING_BYTES = 131072;
constexpr int LDS_BYTES = 147456;
constexpr int LDSCTL_OFF = LDS_BYTES - 4096, MISC_OFF = LDSCTL_OFF + 320;
constexpr int TAB_OFF = LDSCTL_OFF + 1024;

#define GAS __attribute__((address_space(1)))
#define LAS __attribute__((address_space(3)))
typedef unsigned short bf16;
typedef unsigned v4u __attribute__((ext_vector_type(4)));
typedef unsigned v2u __attribute__((ext_vector_type(2)));
typedef float f32x4 __attribute__((ext_vector_type(4)));
typedef short bf16x8 __attribute__((ext_vector_type(8)));
typedef GAS unsigned gu32;
#define RLX_AGENT __ATOMIC_RELAXED, __HIP_MEMORY_SCOPE_AGENT
#define LDS_WAIT() asm volatile("s_waitcnt lgkmcnt(0)" ::: "memory")
#define VM_WAIT() asm volatile("s_waitcnt vmcnt(0)" ::: "memory")
__device__ __forceinline__ unsigned f2bf(float f) { unsigned u = __builtin_bit_cast(unsigned, f); return (u + 0x7fffu + ((u >> 16) & 1u)) >> 16; }
__device__ __forceinline__ unsigned pk2(float lo, float hi) { return f2bf(lo) | (f2bf(hi) << 16); }
__device__ __forceinline__ float bf2f(bf16 v) { return __uint_as_float((unsigned)v << 16); }
__device__ __forceinline__ float bflo(unsigned w) { return __uint_as_float(w << 16); }
__device__ __forceinline__ float bfhi(unsigned w) { return __uint_as_float(w & 0xffff0000u); }
__device__ __forceinline__ float shx(float v, int mask) { int l = threadIdx.x; asm volatile("" : "+v"(l));
    return __builtin_bit_cast(float, __builtin_amdgcn_ds_bpermute(((l ^ mask) & 63) << 2, __builtin_bit_cast(int, v))); }
__device__ __forceinline__ float wave_sum(float v) {
    v += __builtin_bit_cast(float, __builtin_amdgcn_update_dpp(0, __builtin_bit_cast(int, v), 0xB1, 0xF, 0xF, true));
    v += __builtin_bit_cast(float, __builtin_amdgcn_update_dpp(0, __builtin_bit_cast(int, v), 0x4E, 0xF, 0xF, true));
    v += __builtin_bit_cast(float, __builtin_amdgcn_update_dpp(0, __builtin_bit_cast(int, v), 0x141, 0xF, 0xF, true));
    v += __builtin_bit_cast(float, __builtin_amdgcn_update_dpp(0, __builtin_bit_cast(int, v), 0x140, 0xF, 0xF, true));
    v += shx(v, 16); v += shx(v, 32);
    return v;
}
__device__ __forceinline__ float wave_max(float v) {
#pragma unroll
    for (int o = 1; o < 64; o <<= 1) v = fmaxf(v, shx(v, o));
    return v;
}
__device__ __forceinline__ float fsigmoid(float x) { return __builtin_amdgcn_rcpf(1.f + __expf(-x)); }

#define XB_TMO      128
#define XB_XCNT(j)  (256  + 64 * (j))
#define XB_XSUB(j)  (1280 + 64 * (j))
#define XB_XGEN(j)  (2304 + 64 * (j))
#define XB_TOP      3328
#define XB_TOPGEN   3392
#define XCD_BAR_WORDS 3456
#define XB_SPIN_CAP (1u << 18)
__device__ __forceinline__ unsigned xb_ld(unsigned* p)              { return __hip_atomic_load(p, __ATOMIC_RELAXED, __HIP_MEMORY_SCOPE_AGENT); }
__device__ __forceinline__ unsigned xb_add(unsigned* p, unsigned v) { return __hip_atomic_fetch_add(p, v, __ATOMIC_RELAXED, __HIP_MEMORY_SCOPE_AGENT); }
__device__ __forceinline__ unsigned xb_xcc_id() { return (unsigned)__builtin_amdgcn_s_getreg((3 << 11) | 20) & 0xFu; }
#define XB_SPIN(cond, bar) do { unsigned _sp = 0; while (cond) { __builtin_amdgcn_s_sleep(1); \
    if ((++_sp & 255u) == 0u) { if (xb_ld(&(bar)[XB_TMO])) break; if (_sp > XB_SPIN_CAP) { atomicAdd(&(bar)[XB_TMO], 1u); break; } } } } while (0)
struct XcdBarrier { unsigned* bar; unsigned x; volatile LAS unsigned* st; };
__device__ __forceinline__ XcdBarrier xcd_barrier_post(unsigned* bar, volatile LAS unsigned* st) {
    XcdBarrier b; b.bar = bar; b.x = xb_xcc_id(); b.st = st;
    if (threadIdx.x == 0) (void)xb_add(&bar[XB_XCNT(b.x)], 1u);
    return b;
}
__device__ __forceinline__ void xcd_barrier_complete(unsigned* bar, unsigned x, unsigned& nloc, unsigned& nx) {
    const unsigned G = gridDim.x * gridDim.y * gridDim.z;
    unsigned sum, cnt, mine, sp = 0u;
    for (;;) {
        sum = 0u; cnt = 0u; mine = 0u;
#pragma unroll
        for (unsigned j = 0; j < 16; ++j) { const unsigned c = xb_ld(&bar[XB_XCNT(j)]); sum += c; cnt += (c > 0u) ? 1u : 0u; mine = (j == x) ? c : mine; }
        if (sum == G) break;
        __builtin_amdgcn_s_sleep(1);
        if ((++sp & 255u) == 0u) { if (xb_ld(&bar[XB_TMO])) break; if (sp > XB_SPIN_CAP) { atomicAdd(&bar[XB_TMO], 1u); break; } }
    }
    nloc = mine > 0u ? mine : 1u; nx = cnt > 0u ? cnt : 1u;
}
__device__ __forceinline__ void xcd_barrier(const XcdBarrier& b) {
    asm volatile("s_waitcnt vmcnt(0)" ::: "memory");
    __syncthreads();
    if (threadIdx.x == 0) {
        unsigned* bar = b.bar;
        __builtin_amdgcn_s_waitcnt(0);
        unsigned nloc = b.st[0], nx = b.st[1];
        if (nloc == 0u) { xcd_barrier_complete(bar, b.x, nloc, nx); b.st[0] = nloc; b.st[1] = nx; }
        const unsigned old = xb_add(&bar[XB_XSUB(b.x)], 1u);
        const unsigned gen = old / nloc;
        if (old + 1u == (gen + 1u) * nloc) {
            __builtin_amdgcn_fence(__ATOMIC_RELEASE, "agent");
            asm volatile("s_waitcnt vmcnt(0)" ::: "memory");
            const unsigned og = xb_add(&bar[XB_TOP], 1u);
            const unsigned tg = og / nx;
            if (og + 1u == (tg + 1u) * nx) xb_add(&bar[XB_TOPGEN], 1u);
            else XB_SPIN(xb_ld(&bar[XB_TOPGEN]) == tg, bar);
            __builtin_amdgcn_fence(__ATOMIC_ACQUIRE, "agent");
            xb_add(&bar[XB_XGEN(b.x)], 1u);
            asm volatile("s_waitcnt vmcnt(0)" ::: "memory");
        } else {
            XB_SPIN(xb_ld(&bar[XB_XGEN(b.x)]) == gen, bar);
            __builtin_amdgcn_fence(__ATOMIC_ACQUIRE, "agent");
            asm volatile("s_waitcnt vmcnt(0)" ::: "memory");
        }
    }
    __syncthreads();
}

struct Args { const float* in[28]; float* out; unsigned char* ws; int ph_lo, ph_hi, li, pad; };
constexpr int PARG_OFF = LDSCTL_OFF + 512;
struct Frame {
    LAS unsigned char* lds; volatile LAS unsigned* MISC; gu32* ctl;
    int wave, vcu, G;
    __device__ __forceinline__ int ftid() const { int t = threadIdx.x; asm volatile("" : "+v"(t)); return t; }
    __device__ __forceinline__ unsigned long long ldp(int i) const { const unsigned long long v = ((const LAS unsigned long long*)(lds + PARG_OFF))[i];
        const unsigned lo = __builtin_amdgcn_readfirstlane((unsigned)v), hi = __builtin_amdgcn_readfirstlane((unsigned)(v >> 32)); return ((unsigned long long)hi << 32) | lo; }
    __device__ __forceinline__ const float* in(int i) const { return (const float*)(const GAS float*)ldp(i); }
    __device__ __forceinline__ float* out() const { return (float*)(GAS float*)ldp(28); }
    __device__ __forceinline__ unsigned char* ws() const { return (unsigned char*)(GAS unsigned char*)ldp(29); }
};
namespace pg8 {
#define PG8_LAS __attribute__((address_space(3)))
typedef unsigned short bf16_t;
typedef short bf16x8 __attribute__((ext_vector_type(8)));
typedef float f32x4 __attribute__((ext_vector_type(4)));
typedef unsigned u32x4 __attribute__((ext_vector_type(4)));
typedef unsigned u32x2 __attribute__((ext_vector_type(2)));
constexpr int BM = 256, BK = 64, HALF = 128, HTB = HALF * BK * 2  , STAGE_BYTES = 8 * HTB, NXCD = 8, WGM = 8;

__host__ __device__ __forceinline__ int lds_byte(int r, int c) { const int st = (r >> 4) * 2 + (c >> 5), rr = r & 15, cc = c & 31, ob = rr * 64 + cc * 2; return st * 1024 + (ob ^ (((ob >> 9) & 1) << 5)); }
__host__ __device__ __forceinline__ void stage_rc(int b, int& R, int& C) { const int st = b / 1024, sb = b % 1024, swz = sb ^ (((sb >> 9) & 1) << 5); R = (st >> 1) * 16 + swz / 64; C = (st & 1) * 32 + (swz % 64) / 2; }
__host__ __device__ __forceinline__ int perm32(int rho) { const int n = rho >> 4, i = rho & 15; return 8 * (i >> 2) + 4 * n + (i & 3); }

struct Unit { int pm, pn, aux, ksplit; const char* A; const char* B0; const char* B1; const int* ridx; };

typedef float f32x2_t __attribute__((ext_vector_type(2))); typedef __bf16 bf16x2_t __attribute__((ext_vector_type(2)));
__device__ __forceinline__ unsigned cvt_pk_bf16(float lo, float hi) { f32x2_t v = {lo, hi}; bf16x2_t b = __builtin_convertvector(v, bf16x2_t); return __builtin_bit_cast(unsigned, b); }

__device__ __forceinline__ bool static_tile(int L, int nM, int nN, int& pm, int& pn) {
    const int nwg = nM * nN; if (L >= nwg) return false;
    int wgid = L; { const int q = nwg / NXCD, r = nwg % NXCD, xcd = wgid % NXCD, off = wgid / NXCD; wgid = (xcd < r ? xcd * (q + 1) : r * (q + 1) + (xcd - r) * q) + off; }
    const int nig = WGM * nN, gid = wgid / nig, fm = gid * WGM, gsz = (nM - fm) < WGM ? (nM - fm) : WGM;
    pm = fm + ((wgid % nig) % gsz); pn = (wgid % nig) / gsz; return true;
}

template <class Epi, class Sched, bool ALIGN_EPI, bool GATHER, bool SPLIT, int nt, unsigned lda, unsigned ldb>
__device__ __forceinline__ void gemm_phase(PG8_LAS unsigned char* lds, const Sched& S, const Epi& E) {
    const int tid = threadIdx.x, wid = __builtin_amdgcn_readfirstlane(tid >> 6), lane = tid & 63, wr = wid >> 2, wc = wid & 3, fr = lane & 15, fq = lane >> 4;
    unsigned voffA[2], voffB[2];
#pragma unroll
    for (int i = 0; i < 2; ++i) { int R, C; stage_rc(tid * 16 + i * 8192, R, C); const int Rb = Epi::PERM ? ((R & ~31) + perm32(R & 31)) : R;
        voffA[i] = (unsigned)R * lda + (unsigned)C * 2u; voffB[i] = (unsigned)Rb * ldb + (unsigned)C * 2u; }
    const size_t kstep = (size_t)(BK * 2);
    const size_t hstepA = (size_t)HALF * lda, hstepB = (size_t)HALF * ldb;
    const unsigned ldsw = (unsigned)wid * 1024u;
    const int aoff = lds_byte(wr * 64 + fr, fq * 8), boff = lds_byte(wc * 32 + fr, fq * 8);
#define PG8_SA(b, h) (((b) * 2 + (h)) * HTB)
#define PG8_SB(b, h) ((4 + (b) * 2 + (h)) * HTB)
#define PG8_STAGE(bufoff, gbase, voff) do { const __amdgpu_buffer_rsrc_t _rs = __builtin_amdgcn_make_buffer_rsrc((void*)(gbase), 0, 0x7fffffff, 0x00020000); _Pragma("unroll") for (int _i = 0; _i < 2; ++_i) \
        __builtin_amdgcn_raw_ptr_buffer_load_lds(_rs, (PG8_LAS unsigned*)(lds + (bufoff) + ldsw + _i * 8192), 16, (int)(voff)[_i], 0, 0, 0); } while (0)
#define PG8_LDA(dst, b, h) do { _Pragma("unroll") for (int m = 0; m < 4; ++m) _Pragma("unroll") for (int k = 0; k < 2; ++k) dst[m][k] = *(const PG8_LAS bf16x8*)(lds + PG8_SA(b, h) + aoff + m * 2048 + k * 1024); } while (0)
#define PG8_LDB(dst, b, h) do { _Pragma("unroll") for (int n = 0; n < 2; ++n) _Pragma("unroll") for (int k = 0; k < 2; ++k) dst[n][k] = *(const PG8_LAS bf16x8*)(lds + PG8_SB(b, h) + boff + n * 2048 + k * 1024); } while (0)
#define PG8_MMA(ai, bj, At, Bt) do { __builtin_amdgcn_s_setprio(1); _Pragma("unroll") for (int m = 0; m < 4; ++m) _Pragma("unroll") for (int n = 0; n < 2; ++n) _Pragma("unroll") for (int k = 0; k < 2; ++k) \
        acc[ai][bj][m][n] = __builtin_amdgcn_mfma_f32_16x16x32_bf16(Bt[n][k], At[m][k], acc[ai][bj][m][n], 0, 0, 0); __builtin_amdgcn_s_setprio(0); } while (0)
#define PG8_WAIT_V(n) asm volatile("s_waitcnt vmcnt(" #n ")" ::: "memory")
#define PG8_WAIT_L(n) asm volatile("s_waitcnt lgkmcnt(" #n ")" ::: "memory")
#define PG8_BAR __builtin_amdgcn_s_barrier()
#define PG8_SCHED __builtin_amdgcn_sched_barrier(0)
#ifndef MK_GT
#define MK_GT -1
#endif
#define PG8_TMARK(cat) do { if (MK_GT >= 0) { if (tid == 0) { PG8_LAS unsigned long long* ts_ = (PG8_LAS unsigned long long*)(lds - RING_OFF + PARG_OFF + 256); if (ts_[2]) { const unsigned long long t_ = __builtin_amdgcn_s_memrealtime(); ts_[4 + (cat)] += t_ - ts_[3]; ts_[3] = t_; } } } } while (0)
#define PG8_APTR(u, h, t) ((u).A + (GATHER ? (size_t)0 : (size_t)(h) * hstepA) + (size_t)(t) * kstep)
#define PG8_BPTR(u, h, t) ((SPLIT ? ((t) < (u).ksplit ? (u).B0 + (size_t)(t) * kstep : (u).B1 + (size_t)((t) - (u).ksplit) * kstep) : (u).B0 + (size_t)(t) * kstep) + (size_t)(h) * hstepB)
#define PG8_STAGE_A(bufoff, u, g, h, t) do { if (GATHER) { unsigned _vo[2]; int _tid = tid; asm volatile("" : "+v"(_tid)); _Pragma("unroll") for (int _i = 0; _i < 2; ++_i) { int _R, _C; stage_rc(_tid * 16 + _i * 8192, _R, _C); \
            _vo[_i] = (((g)[h] >> (16 * _i)) & 0xffffu) * lda + (unsigned)_C * 2u; } PG8_STAGE(bufoff, PG8_APTR(u, h, t), _vo); } else PG8_STAGE(bufoff, PG8_APTR(u, h, t), voffA); } while (0)
#define PG8_STAGE_B(bufoff, u, h, t) PG8_STAGE(bufoff, PG8_BPTR(u, h, t), voffB)
#define PG8_GIDX(g, u) do { if (GATHER) { _Pragma("unroll") for (int _h = 0; _h < 2; ++_h) { unsigned _p = 0u; _Pragma("unroll") for (int _i = 0; _i < 2; ++_i) { int _R, _C; stage_rc(tid * 16 + _i * 8192, _R, _C); \
            const int _j = _h * HALF + _R, _t = (u).ridx[_j < (u).aux ? _j : (u).aux - 1]; _p |= (unsigned)_t << (16 * _i); } (g)[_h] = _p; } } } while (0)
    PG8_TMARK(0);
    Unit cur, nxt; int ui = 0;
    if (!S.next(0, cur)) return;
    f32x4 acc[2][2][4][2];
#pragma unroll
    for (int a = 0; a < 2; ++a)
#pragma unroll
        for (int b = 0; b < 2; ++b)
#pragma unroll
            for (int m = 0; m < 4; ++m)
#pragma unroll
                for (int n = 0; n < 2; ++n) acc[a][b][m][n] = (f32x4){0.f, 0.f, 0.f, 0.f};
    bf16x8 At[4][2], B0[2][2], B1[2][2];
    unsigned gC[2] = {0u, 0u}, gN[2] = {0u, 0u};
    S.a_ready(cur);
    PG8_GIDX(gC, cur);
    if constexpr (Epi::PREFETCH) E.prefetch(cur, lds + STAGE_BYTES + wid * 256, tid);
    PG8_STAGE_B(PG8_SB(0, 0), cur, 0, 0); PG8_STAGE_B(PG8_SB(0, 1), cur, 1, 0); PG8_STAGE_A(PG8_SA(0, 0), cur, gC, 0, 0); PG8_STAGE_A(PG8_SA(0, 1), cur, gC, 1, 0);
    if (wr == 1) PG8_BAR;
    PG8_WAIT_V(2); PG8_BAR;
    PG8_STAGE_B(PG8_SB(1, 0), cur, 0, 1); PG8_STAGE_A(PG8_SA(1, 0), cur, gC, 0, 1); PG8_STAGE_B(PG8_SB(1, 1), cur, 1, 1);
    PG8_WAIT_V(6); PG8_BAR;
    PG8_TMARK(1);
    for (;;) {
        const bool has_next = S.next(ui + 1, nxt);
        if (!has_next) nxt = cur;
        if (GATHER) { if (has_next) { PG8_GIDX(gN, nxt); } else { gN[0] = gC[0]; gN[1] = gC[1]; } }
        for (int t = 0; t < nt; t += 2) {
            const bool last = (t == nt - 2);
            if (last && has_next) S.a_ready(nxt);
            PG8_LDB(B0, 0, 0); PG8_LDB(B1, 0, 1); PG8_SCHED; PG8_LDA(At, 0, 0); PG8_STAGE_A(PG8_SA(1, 1), cur, gC, 1, t + 1);
            PG8_WAIT_V(8); PG8_WAIT_L(0); PG8_BAR; PG8_MMA(0, 0, At, B0); PG8_MMA(0, 1, At, B1); PG8_BAR; PG8_SCHED;
            PG8_LDA(At, 0, 1);
            if (!last) { PG8_STAGE_B(PG8_SB(0, 0), cur, 0, t + 2); PG8_STAGE_B(PG8_SB(0, 1), cur, 1, t + 2); PG8_STAGE_A(PG8_SA(0, 0), cur, gC, 0, t + 2); }
            else       { PG8_STAGE_B(PG8_SB(0, 0), nxt, 0, 0);     PG8_STAGE_B(PG8_SB(0, 1), nxt, 1, 0);     PG8_STAGE_A(PG8_SA(0, 0), nxt, gN, 0, 0); }
            PG8_WAIT_V(8); PG8_WAIT_L(0); PG8_BAR; PG8_MMA(1, 0, At, B0); PG8_MMA(1, 1, At, B1); PG8_BAR; PG8_SCHED;
            PG8_LDB(B0, 1, 0); PG8_LDB(B1, 1, 1); PG8_SCHED; PG8_LDA(At, 1, 0);
            if (!last) { PG8_STAGE_A(PG8_SA(0, 1), cur, gC, 1, t + 2); } else { PG8_STAGE_A(PG8_SA(0, 1), nxt, gN, 1, 0); }
            PG8_WAIT_V(8); PG8_WAIT_L(0); PG8_BAR; PG8_MMA(0, 0, At, B0); PG8_MMA(0, 1, At, B1); PG8_BAR; PG8_SCHED;
            PG8_LDA(At, 1, 1);
            if (!last) { PG8_STAGE_B(PG8_SB(1, 0), cur, 0, t + 3); PG8_STAGE_B(PG8_SB(1, 1), cur, 1, t + 3); PG8_STAGE_A(PG8_SA(1, 0), cur, gC, 0, t + 3); }
            else       { PG8_STAGE_B(PG8_SB(1, 0), nxt, 0, 1);     PG8_STAGE_B(PG8_SB(1, 1), nxt, 1, 1);     PG8_STAGE_A(PG8_SA(1, 0), nxt, gN, 0, 1); }
            PG8_WAIT_V(8); PG8_WAIT_L(0); PG8_BAR; PG8_MMA(1, 0, At, B0); PG8_MMA(1, 1, At, B1); PG8_BAR; PG8_SCHED;
        }
        if constexpr (ALIGN_EPI) { if (wr == 0) PG8_BAR; }
        PG8_TMARK(2);
        int fr_ = fr, fq_ = fq; asm volatile("" : "+v"(fr_), "+v"(fq_));
        bool zero = true;
        asm volatile("" ::: "memory");
        if constexpr (!Epi::AFTER_DRAIN) zero = E(acc, cur, wr, wc, fr_, fq_);
        asm volatile("" ::: "memory");
        PG8_TMARK(3);
        if (!has_next) break;
        if (zero) {
#pragma unroll
            for (int a = 0; a < 2; ++a)
#pragma unroll
                for (int b = 0; b < 2; ++b)
#pragma unroll
                    for (int m = 0; m < 4; ++m)
#pragma unroll
                        for (int n = 0; n < 2; ++n) acc[a][b][m][n] = (f32x4){0.f, 0.f, 0.f, 0.f};
        }
        cur = nxt; ++ui;
        if constexpr (Epi::PREFETCH) E.prefetch(cur, lds + STAGE_BYTES + wid * 256, tid);
        if (GATHER) { gC[0] = gN[0]; gC[1] = gN[1]; }
        if constexpr (ALIGN_EPI) { if (wr == 1) PG8_BAR; }
        PG8_TMARK(4);
    }
    PG8_WAIT_V(0);
    if constexpr (!ALIGN_EPI) { if (wr == 0) PG8_BAR; }
    PG8_BAR;
    PG8_TMARK(5);
    if constexpr (Epi::AFTER_DRAIN) { int fr_ = fr, fq_ = fq; asm volatile("" : "+v"(fr_), "+v"(fq_)); E.fused(acc, cur, wr, wc, fr_, fq_, lds, wid, lane); }
    PG8_TMARK(6);
#undef PG8_SA
#undef PG8_SB
#undef PG8_STAGE
#undef PG8_LDA
#undef PG8_LDB
#undef PG8_MMA
#undef PG8_WAIT_V
#undef PG8_WAIT_L
#undef PG8_BAR
#undef PG8_SCHED
#undef PG8_APTR
#undef PG8_BPTR
#undef PG8_STAGE_A
#undef PG8_STAGE_B
#undef PG8_GIDX
#undef PG8_TMARK
}
}
#ifndef MK_TSUB
#define MK_TSUB -1
#endif
#ifndef TSUB_BEG
#define TSUB_BEG(k) if (MK_TSUB == (k)) { __syncthreads(); if (threadIdx.x == 0) ((LAS unsigned long long*)(F.lds + PARG_OFF + 256))[0] = __builtin_amdgcn_s_memrealtime(); }
#define TSUB_END(k) if (MK_TSUB == (k)) { __syncthreads(); if (threadIdx.x == 0) ((LAS unsigned long long*)(F.lds + PARG_OFF + 256))[1] = __builtin_amdgcn_s_memrealtime(); }
#endif
__device__ __forceinline__ int map_win(int n) {
    if (n < 512) { const int hq = n >> 6, d = n & 63; return 256 * (hq >> 2) + (d >> 5) * 128 + 32 * (hq & 3) + (d & 31); }
    if (n < 768) { const int j = n - 512, hh = j >> 6, d = j & 63; return 512 + (d >> 5) * 128 + 32 * hh + (d & 31); }
    if (n < 1792) { const int j = n - 768; const int c = j & 511; return 768 + 8 * (c >> 2) + (j >= 512 ? 4 : 0) + (c & 3); }
    return n;
}
__device__ __forceinline__ int map_row(int mode, int n) {
    if (mode == 1) return map_win(n);
    if (mode == 2) return 8 * (n >> 2) + (n & 3);
    if (mode == 3) return 8 * (n >> 2) + 4 + (n & 3);
    return n;
}
constexpr int TSCR = 64 * 65 * 4;
__device__ __forceinline__ void p0_transpose_item(const float* W, int N, bf16* WT, int ldt, int mode, LAS float* scr, int kb, int nb, int lane) {
    const int k0 = 64 * kb, n0 = 64 * nb, kk = lane >> 4, nq = lane & 15;
    const GAS f32x4* src = (const GAS f32x4*)(W + (size_t)(k0 + kk) * N + n0 + 4 * nq);
#pragma unroll 8
    for (int i = 0; i < 16; ++i) { const f32x4 v = src[(size_t)i * N]; LAS float* d = scr + (4 * i + kk) * 65 + 4 * nq; d[0] = v[0]; d[1] = v[1]; d[2] = v[2]; d[3] = v[3]; }
    LDS_WAIT(); asm volatile("" ::: "memory");
    const int c = lane & 7, nn = lane >> 3;
#pragma unroll
    for (int j = 0; j < 8; ++j) { const int n = nn + 8 * j; const LAS float* s = scr + (8 * c) * 65 + n;
        v4u o; o.x = pk2(s[0 * 65], s[1 * 65]); o.y = pk2(s[2 * 65], s[3 * 65]); o.z = pk2(s[4 * 65], s[5 * 65]); o.w = pk2(s[6 * 65], s[7 * 65]);
        *(GAS v4u*)(WT + (size_t)map_row(mode, n0 + n) * ldt + k0 + 8 * c) = o; }
    LDS_WAIT(); asm volatile("" ::: "memory");
}
constexpr int IA_WIN = 16 * 84, IA_KV = 16 * 16, NITEMS_A = IA_WIN + IA_KV;
constexpr int IB_WO = 8 * 16, IB_OUT = 16 * 16, IB_GU = 16 * 16 * 8, IB_DN = 16 * 8 * 16, NITEMS_B = 3 * IB_WO + IB_OUT + 2 * IB_GU, NITEMS_B2 = IB_DN;
__device__ __forceinline__ void convert_item_a(Frame& F, unsigned char* ws, LAS float* scr, int r, int lane) {
    if (r < IA_WIN) { p0_transpose_item(F.in(4), INW, (bf16*)(ws + WS_W1), 1024, 1, scr, r / 84, r % 84, lane); return; } r -= IA_WIN;
    p0_transpose_item(F.in(15), 1024, (bf16*)(ws + WS_WKV), 1024, 0, scr, r / 16, r % 16, lane);
}
__device__ __forceinline__ void convert_item_b(Frame& F, unsigned char* ws, LAS float* scr, int r, int lane) {
    if (r < 3 * IB_WO) { const int b = r / IB_WO, q = r % IB_WO; const float* W = b == 0 ? F.in(8) : (b == 1 ? F.in(13) : F.in(18));
        p0_transpose_item(W, 1024, (bf16*)(ws + WS_WO3) + (size_t)b * 1024 * 512, 512, 0, scr, q / 16, q % 16, lane); return; } r -= 3 * IB_WO;
    if (r < IB_OUT) { p0_transpose_item(F.in(19), 1024, (bf16*)(ws + WS_WOUT), 1024, 0, scr, r / 16, r % 16, lane); return; } r -= IB_OUT;
    if (r < 2 * IB_GU) { const int up = r / IB_GU, q = r % IB_GU, e = q / 128, qq = q % 128; const float* W = (up ? F.in(26) : F.in(25)) + (size_t)e * 1024 * 512;
        p0_transpose_item(W, 512, (bf16*)(ws + WS_WGU) + (size_t)e * 1024 * 1024, 1024, 2 + up, scr, qq / 8, qq % 8, lane); return; }
}
__device__ __forceinline__ void convert_item_b2(Frame& F, unsigned char* ws, LAS float* scr, int r, int lane) {
    { const int e = r / 128, qq = r % 128; p0_transpose_item(F.in(27) + (size_t)e * 512 * 1024, 1024, (bf16*)(ws + WS_WDT) + (size_t)e * 1024 * 512, 512, 0, scr, qq / 16, qq % 16, lane); }
}
__device__ __forceinline__ void convert_b2_tail(Frame& F, int nunits) {
    const int rem = nunits % F.G, first = rem, cnt = rem ? F.G - rem : F.G, idx = rem ? F.vcu - rem : F.vcu;
    if (idx < 0) return; (void)first;
    const int tid_ = F.ftid(), lane_ = tid_ & 63; unsigned char* ws = F.ws();
    LAS float* scr = (LAS float*)(F.lds + RING_OFF + F.wave * TSCR);
    for (int it = idx * NWAVES + F.wave; it < NITEMS_B2; it += cnt * NWAVES) convert_item_b2(F, ws, scr, it, lane_);
}
__device__ __forceinline__ void convert_b2_all(Frame& F) {
    const int tid_ = F.ftid(), lane_ = tid_ & 63; unsigned char* ws = F.ws();
    LAS float* scr = (LAS float*)(F.lds + RING_OFF + F.wave * TSCR);
    for (int it = F.vcu * NWAVES + F.wave; it < NITEMS_B2; it += F.G * NWAVES) convert_item_b2(F, ws, scr, it, lane_);
    __syncthreads();
}
constexpr int P1_LONG = 72;
__device__ __forceinline__ void convert_b_tail(Frame& F) {
    if (F.G <= P1_LONG || (int)blockIdx.x < P1_LONG) return;
    const int tid_ = F.ftid(), lane_ = tid_ & 63; unsigned char* ws = F.ws();
    LAS float* scr = (LAS float*)(F.lds + RING_OFF + F.wave * TSCR);
    const int gw = ((int)blockIdx.x - P1_LONG) * NWAVES + F.wave, NGW = (F.G - P1_LONG) * NWAVES;
    for (int it = gw; it < NITEMS_B; it += NGW) convert_item_b(F, ws, scr, it, lane_);
}
template <int NR>
__device__ __forceinline__ void rms_rows_load(f32x4 (&v)[NR][4], int lane, const float* xrow, size_t stride) {
#pragma unroll
    for (int i = 0; i < NR; ++i) { const GAS f32x4* xr = (const GAS f32x4*)(xrow + i * stride) + lane;
#pragma unroll
        for (int j = 0; j < 4; ++j) v[i][j] = xr[64 * j]; }
}
template <int NR>
__device__ __forceinline__ void rms_rows_finish(const f32x4 (&v)[NR][4], int lane, size_t stride, const float* g, bf16* orow, float* rinv = nullptr, int rstride = 0) {
    float s[NR]; f32x4 gg[4];
#pragma unroll
    for (int j = 0; j < 4; ++j) gg[j] = *((const GAS f32x4*)g + lane + 64 * j);
#pragma unroll
    for (int i = 0; i < NR; ++i) { s[i] = 0.f;
#pragma unroll
        for (int j = 0; j < 4; ++j) s[i] += (v[i][j].x * v[i][j].x + v[i][j].y * v[i][j].y) + (v[i][j].z * v[i][j].z + v[i][j].w * v[i][j].w); }
#pragma unroll
    for (int i = 0; i < NR; ++i) s[i] = wave_sum(s[i]);
#pragma unroll
    for (int i = 0; i < NR; ++i) { const float r = rsqrtf(s[i] * (1.f / 1024.f) + 1e-6f); GAS unsigned long long* o8 = (GAS unsigned long long*)(orow + i * stride) + lane;
        if (rinv != nullptr && lane == 0) rinv[i * rstride] = 1.f / r;
#pragma unroll
        for (int j = 0; j < 4; ++j) o8[64 * j] = (unsigned long long)pg8::cvt_pk_bf16(v[i][j].x * r * gg[j].x, v[i][j].y * r * gg[j].y) | ((unsigned long long)pg8::cvt_pk_bf16(v[i][j].z * r * gg[j].z, v[i][j].w * r * gg[j].w) << 32); }
}
template <int NR>
__device__ __forceinline__ void rms_rows_to_bf16(int lane, const float* xrow, size_t stride, const float* g, bf16* orow) { f32x4 v[NR][4]; rms_rows_load<NR>(v, lane, xrow, stride); rms_rows_finish<NR>(v, lane, stride, g, orow); }
__device__ __forceinline__ void p0_prologue(Frame& F) {
    const int tid_ = F.ftid(), lane_ = tid_ & 63; (void)lane_;
    LAS float* scr = (LAS float*)(F.lds + RING_OFF + F.wave * TSCR);
    const int gw = F.vcu * NWAVES + F.wave, NGW = F.G * NWAVES;
    unsigned char* ws = F.ws();
    if (T == 8 * NGW) {
        f32x4 v[8][4]; rms_rows_load<8>(v, lane_, F.in(0) + (size_t)gw * D, (size_t)NGW * D);
        for (int it = gw; it < NITEMS_A; it += NGW) convert_item_a(F, ws, scr, it, lane_);
        rms_rows_finish<8>(v, lane_, (size_t)NGW * D, F.in(3), (bf16*)((unsigned char*)F.out() + DO_H) + (size_t)gw * D, (float*)(ws + WS_RINV) + gw, NGW);
    } else {
        for (int it = gw; it < NITEMS_A; it += NGW) convert_item_a(F, ws, scr, it, lane_);
        for (int m = gw; m < T; m += NGW) { f32x4 v1[1][4]; rms_rows_load<1>(v1, lane_, F.in(0) + (size_t)m * D, 0); rms_rows_finish<1>(v1, lane_, 0, F.in(3), (bf16*)((unsigned char*)F.out() + DO_H) + (size_t)m * D, (float*)(ws + WS_RINV) + m, 0); }
    }
    for (int m = gw; m < 512; m += NGW) rms_rows_to_bf16<1>(lane_, F.in(1) + (size_t)m * D, 0, F.in(14), (bf16*)(ws + WS_MEMN) + (size_t)m * D);
    {
        const float* g2 = F.in(20); const float* wg = F.in(21); const float* wrt = F.in(23); bf16* WR = (bf16*)(ws + WS_ROUTE + 2 * MiB);
        const int gt = F.vcu * 512 + tid_, NT_ = F.G * 512;
        for (int id = gt; id < 4 * 32 * 256; id += NT_) { const int pn = id >> 13, n = (id >> 8) & 31, s = id & 255, gidx = s >> 5, kg = (s >> 3) & 3, j = s & 7;
            const int col = 256 * pn + 128 * (gidx >> 2) + 32 * (gidx & 3) + (j < 4 ? 4 * kg + j : 16 + 4 * kg + j - 4); float w = 0.f;
            if (n < 20) w = g2[col] * (n < 4 ? wg[col * 4 + n] : wrt[col * 16 + (n - 4)]);
            const unsigned hi = f2bf(w), lo = f2bf(w - __uint_as_float(hi << 16));
            WR[(size_t)((pn * 2 + 0) * 32 + n) * 256 + s] = (bf16)hi; WR[(size_t)((pn * 2 + 1) * 32 + n) * 256 + s] = (bf16)lo; }
    }
    {
        const int* positions = (const int*)F.in(2); float2* cs = (float2*)(ws + WS_CS);
        const int gt = F.vcu * 512 + tid_, NT_ = F.G * 512;
        for (int idx = gt; idx < T * 32; idx += NT_) { const int t = idx >> 5, i = idx & 31;
            const float inv = 1.0f / powf(10000.f, (float)(2 * i) / 64.f); const float ang = (float)positions[t] * inv;
            double s, c; sincos((double)ang, &s, &c); cs[idx] = make_float2((float)c, (float)s); }
    }
}

struct SchedP1 {
    __device__ __forceinline__ void a_ready(const pg8::Unit&) const {}
    int G, c; const char* Ah; const char* W1; const char* Amem; const char* Wkv;
    __device__ __forceinline__ bool next(int i, pg8::Unit& u) const {
        const int L = i * G + c; u.ksplit = 1 << 30; u.ridx = nullptr;
        if (L < 64 * 21) { int pm, pn; pg8::static_tile(L, 64, 21, pm, pn); u.pm = pm; u.pn = pn; u.aux = 0; u.A = Ah + (size_t)pm * 256 * 2048; u.B0 = W1 + (size_t)pn * 256 * 2048; u.B1 = u.B0; return true; }
        const int j = L - 64 * 21; if (j >= 8) return false;
        u.pm = j & 1; u.pn = j >> 1; u.aux = 1; u.A = Amem + (size_t)u.pm * 256 * 2048; u.B0 = Wkv + (size_t)u.pn * 256 * 2048; u.B1 = u.B0; return true;
    }
};
__device__ __forceinline__ v4u pack8(const f32x4 a, const f32x4 b) { v4u w; w.x = pg8::cvt_pk_bf16(a[0], a[1]); w.y = pg8::cvt_pk_bf16(a[2], a[3]); w.z = pg8::cvt_pk_bf16(b[0], b[1]); w.w = pg8::cvt_pk_bf16(b[2], b[3]); return w; }
struct EpiP1 {
    static constexpr bool PERM = true, AFTER_DRAIN = false, PREFETCH = false;
    bf16 *q, *k, *v, *u, *xq, *gates, *mkv; const float2* cs; const float *gq, *gk;
    __device__ __forceinline__ void qk_rope(const f32x4 (&acc)[2][2][4][2], int row0, bf16* dst, int ld, int head, const float* g, int fq) const {
        f32x4 g1[2], g2[2];
#pragma unroll
        for (int n = 0; n < 2; ++n) { g1[n] = *(const f32x4*)(g + 8 * fq + 4 * n); g2[n] = *(const f32x4*)(g + 32 + 8 * fq + 4 * n); }
#pragma unroll
        for (int ai = 0; ai < 2; ++ai)
#pragma unroll
            for (int m = 0; m < 4; ++m) {
                const int row = row0 + ai * 128 + m * 16;
                float ss = 0.f;
#pragma unroll
                for (int bj = 0; bj < 2; ++bj)
#pragma unroll
                    for (int n = 0; n < 2; ++n) { const f32x4 x = acc[ai][bj][m][n]; ss += (x[0] * x[0] + x[1] * x[1]) + (x[2] * x[2] + x[3] * x[3]); }
                ss += shx(ss, 16); ss += shx(ss, 32);
                const float r = rsqrtf(ss * (1.f / 64.f) + 1e-6f);
                const f32x4* cp = (const f32x4*)(cs + (size_t)row * 32 + 8 * fq);
                f32x4 o1[2], o2[2];
#pragma unroll
                for (int n = 0; n < 2; ++n) { const f32x4 ca = cp[2 * n], cb = cp[2 * n + 1];
                    const f32x4 y1 = acc[ai][0][m][n] * r * g1[n], y2 = acc[ai][1][m][n] * r * g2[n];
                    o1[n] = (f32x4){y1[0] * ca[0] - y2[0] * ca[1], y1[1] * ca[2] - y2[1] * ca[3], y1[2] * cb[0] - y2[2] * cb[1], y1[3] * cb[2] - y2[3] * cb[3]};
                    o2[n] = (f32x4){y2[0] * ca[0] + y1[0] * ca[1], y2[1] * ca[2] + y1[1] * ca[3], y2[2] * cb[0] + y1[2] * cb[1], y2[3] * cb[2] + y1[3] * cb[3]}; }
                bf16* p = dst + (size_t)row * ld + head * 64 + 8 * fq;
                *(v4u*)p = pack8(o1[0], o1[1]); *(v4u*)(p + 32) = pack8(o2[0], o2[1]);
            }
    }
    __device__ __forceinline__ bool operator()(f32x4 (&acc)[2][2][4][2], const pg8::Unit& un, int wr, int wc, int fr, int fq) const {
        const int row0 = un.pm * 256 + wr * 64 + fr;
        if (un.aux == 1) {
#pragma unroll
            for (int ai = 0; ai < 2; ++ai)
#pragma unroll
                for (int m = 0; m < 4; ++m)
#pragma unroll
                    for (int bj = 0; bj < 2; ++bj) *(v4u*)(mkv + (size_t)(row0 + ai * 128 + m * 16) * 1024 + un.pn * 256 + bj * 128 + wc * 32 + 8 * fq) = pack8(acc[ai][bj][m][0], acc[ai][bj][m][1]);
            return true;
        }
        const int pn = un.pn;
        if (pn < 2) { qk_rope(acc, row0, q, 512, 4 * pn + wc, gq, fq); return true; }
        if (pn == 2) {
            if (wc < 2) { qk_rope(acc, row0, k, 128, wc, gk, fq); return true; }
#pragma unroll
            for (int ai = 0; ai < 2; ++ai)
#pragma unroll
                for (int m = 0; m < 4; ++m)
#pragma unroll
                    for (int bj = 0; bj < 2; ++bj) *(v4u*)(v + (size_t)(row0 + ai * 128 + m * 16) * 128 + (wc - 2) * 64 + bj * 32 + 8 * fq) = pack8(acc[ai][bj][m][0], acc[ai][bj][m][1]);
            return true;
        }
        if (pn < 7) {
#pragma unroll
            for (int ai = 0; ai < 2; ++ai)
#pragma unroll
                for (int m = 0; m < 4; ++m)
#pragma unroll
                    for (int bj = 0; bj < 2; ++bj) { const f32x4 av = acc[ai][bj][m][0], bv = acc[ai][bj][m][1];
                        v2u w; w.x = pg8::cvt_pk_bf16(av[0] * fsigmoid(bv[0]), av[1] * fsigmoid(bv[1])); w.y = pg8::cvt_pk_bf16(av[2] * fsigmoid(bv[2]), av[3] * fsigmoid(bv[3]));
                        *(v2u*)(u + (size_t)(row0 + ai * 128 + m * 16) * 512 + 128 * (pn - 3) + 64 * bj + 16 * wc + 4 * fq) = w; }
            return true;
        }
        if (pn < 9) {
#pragma unroll
            for (int ai = 0; ai < 2; ++ai)
#pragma unroll
                for (int m = 0; m < 4; ++m)
#pragma unroll
                    for (int bj = 0; bj < 2; ++bj) *(v4u*)(xq + (size_t)(row0 + ai * 128 + m * 16) * 512 + (pn - 7) * 256 + bj * 128 + wc * 32 + 8 * fq) = pack8(acc[ai][bj][m][0], acc[ai][bj][m][1]);
            return true;
        }
        unsigned char* g8 = (unsigned char*)gates;
#pragma unroll
        for (int ai = 0; ai < 2; ++ai)
#pragma unroll
            for (int m = 0; m < 4; ++m)
#pragma unroll
                for (int bj = 0; bj < 2; ++bj) { const f32x4 a0 = acc[ai][bj][m][0], a1 = acc[ai][bj][m][1]; v2u w; w.x = 0u; w.y = 0u;
#pragma unroll
                    for (int e = 0; e < 4; ++e) { w.x = __builtin_amdgcn_cvt_pk_u8_f32(fmaxf(fsigmoid(a0[e]) * 255.f, 1.f), e, w.x); w.y = __builtin_amdgcn_cvt_pk_u8_f32(fmaxf(fsigmoid(a1[e]) * 255.f, 1.f), e, w.y); }
                    *(v2u*)(g8 + (size_t)(row0 + ai * 128 + m * 16) * 3072 + (pn - 9) * 256 + bj * 128 + wc * 32 + 8 * fq) = w; }
        return true;
    }
};

struct SchedP3 {
    __device__ __forceinline__ void a_ready(const pg8::Unit&) const {}
    int G, c; const char* acts; const char* Wo3;
    __device__ __forceinline__ bool next(int i, pg8::Unit& u) const {
        const int j = i / 3, b = i - 3 * j; const int L = j * G + c; int pm, pn;
        if (!pg8::static_tile(L, 64, 4, pm, pn)) return false;
        u.pm = pm; u.pn = pn; u.aux = b; u.ksplit = 1 << 30; u.ridx = nullptr;
        u.A = acts + (size_t)pm * 256 * 3072 + (size_t)b * 1024; u.B0 = Wo3 + (size_t)b * (1024 * 1024) + (size_t)pn * 256 * 1024; u.B1 = u.B0; return true;
    }
};
struct EpiP3 {
    static constexpr bool PERM = true, AFTER_DRAIN = false, PREFETCH = false;
    const unsigned char* gates; bf16* merged;
    __device__ __forceinline__ void prefetch(const pg8::Unit&, LAS unsigned char*, int) const {}
    static __device__ __forceinline__ f32x4 ub4(unsigned w) { return (f32x4){(float)(w & 255u), (float)((w >> 8) & 255u), (float)((w >> 16) & 255u), (float)(w >> 24)}; }
    __device__ __forceinline__ bool operator()(f32x4 (&acc)[2][2][4][2], const pg8::Unit& un, int wr, int wc, int fr, int fq) const {
        const int b = un.aux; const bool fin = b == 2;
        const __amdgpu_buffer_rsrc_t rg = __builtin_amdgcn_make_buffer_rsrc((void*)gates, 0, 0x7fffffff, 0x00020000);
        const int vg = fr * 3072 + 8 * fq, sg = (un.pm * 256 + wr * 64) * 3072 + b * 1024 + un.pn * 256 + wc * 32, db = fin ? 0 : 1024;
        v2u ga[2][2], gb[2][2];
#define EPI3_LD(g) do { const int so_ = sg + ((g >> 2) * 128 + (g & 3) * 16) * 3072; _Pragma("unroll") for (int bj = 0; bj < 2; ++bj) { \
            ga[(g) & 1][bj] = __builtin_amdgcn_raw_buffer_load_b64(rg, vg, so_ + bj * 128, 0); gb[(g) & 1][bj] = __builtin_amdgcn_raw_buffer_load_b64(rg, vg, so_ + bj * 128 + db, 0); } } while (0)
        EPI3_LD(0);
#pragma unroll
        for (int g = 0; g < 8; ++g) {
            if (g + 1 < 8) EPI3_LD(g + 1);
#pragma unroll
            for (int bj = 0; bj < 2; ++bj) {
                f32x4 s0 = ub4(ga[g & 1][bj].x), s1 = ub4(ga[g & 1][bj].y); const f32x4 d0 = ub4(gb[g & 1][bj].x), d1 = ub4(gb[g & 1][bj].y);
#pragma unroll
                for (int e = 0; e < 4; ++e) { s0[e] *= fin ? (1.f / 255.f) : __builtin_amdgcn_rcpf(d0[e]); s1[e] *= fin ? (1.f / 255.f) : __builtin_amdgcn_rcpf(d1[e]); }
                acc[g >> 2][bj][g & 3][0] *= s0; acc[g >> 2][bj][g & 3][1] *= s1; }
            __builtin_amdgcn_sched_barrier(0); }
#undef EPI3_LD
        if (fin) {
            const __amdgpu_buffer_rsrc_t rm = __builtin_amdgcn_make_buffer_rsrc((void*)merged, 0, 0x7fffffff, 0x00020000);
            const int vm = fr * 2048 + 16 * fq, sm = (un.pm * 256 + wr * 64) * 2048 + (un.pn * 256 + wc * 32) * 2;
#pragma unroll
            for (int ai = 0; ai < 2; ++ai)
#pragma unroll
                for (int m = 0; m < 4; ++m)
#pragma unroll
                    for (int bj = 0; bj < 2; ++bj)
                        __builtin_amdgcn_raw_buffer_store_b128(pack8(acc[ai][bj][m][0], acc[ai][bj][m][1]), rm, vm, sm + (ai * 128 + m * 16) * 2048 + bj * 256, 0);
        }
        return fin;
    }
};

struct SchedP4 {
    __device__ __forceinline__ void a_ready(const pg8::Unit&) const {}
    int G, c; const char* A; const char* W;
    __device__ __forceinline__ bool next(int i, pg8::Unit& u) const {
        const int L = i * G + c; int pm, pn; if (!pg8::static_tile(L, 64, 4, pm, pn)) return false;
        u.pm = pm; u.pn = pn; u.aux = 0; u.ksplit = 1 << 30; u.ridx = nullptr; u.A = A + (size_t)pm * 256 * 2048; u.B0 = W + (size_t)pn * 256 * 2048; u.B1 = u.B0; return true;
    }
};
struct EpiP4 {
    static constexpr bool PERM = false, AFTER_DRAIN = false, PREFETCH = false;
    const float* x; float* out;
    __device__ __forceinline__ bool operator()(f32x4 (&acc)[2][2][4][2], const pg8::Unit& un, int wr, int wc, int fr, int fq) const {
        const int row0 = un.pm * 256 + wr * 64 + fr, col0 = un.pn * 256 + wc * 32 + 4 * fq;
#pragma unroll
        for (int ai = 0; ai < 2; ++ai)
#pragma unroll
            for (int m = 0; m < 4; ++m) { const size_t off = (size_t)(row0 + ai * 128 + m * 16) * 1024 + col0;
#pragma unroll
                for (int bj = 0; bj < 2; ++bj)
#pragma unroll
                    for (int n = 0; n < 2; ++n) *(f32x4*)(out + off + bj * 128 + n * 16) = *(const f32x4*)(x + off + bj * 128 + n * 16) + acc[ai][bj][m][n]; }
        return true;
    }
};
constexpr size_t RT_TOKC = 0, RT_SWT = 1536 * 1024;
constexpr int CW_CCNT = 1024, CCNT_STRIDE = 64;
constexpr int TB_TOTAL = TAB_OFF, TB_TAB = TAB_OFF + 256;
constexpr int TB_ORD = TAB_OFF + 768, TB_AUX = TAB_OFF + 1536;
typedef float f32x2v __attribute__((ext_vector_type(2)));
constexpr int WST = 2064;
__device__ __forceinline__ void route_token(const LAS float* lg, const float* bg, const float* br, int& cls, float& wa, float& wb) {
    float l0 = lg[0] + bg[0], l1 = lg[1] + bg[1], l2 = lg[2] + bg[2], l3 = lg[3] + bg[3];
    int gi = 0; float gm = l0;
    if (l1 > gm) { gm = l1; gi = 1; } if (l2 > gm) { gm = l2; gi = 2; } if (l3 > gm) { gm = l3; gi = 3; }
    const float pg = 1.f / (__expf(l0 - gm) + __expf(l1 - gm) + __expf(l2 - gm) + __expf(l3 - gm));
    const float e0 = lg[4 + gi * 4 + 0] + br[gi * 4 + 0], e1 = lg[4 + gi * 4 + 1] + br[gi * 4 + 1], e2 = lg[4 + gi * 4 + 2] + br[gi * 4 + 2], e3 = lg[4 + gi * 4 + 3] + br[gi * 4 + 3];
    int i1 = 0; float v1 = e0;
    if (e1 > v1) { v1 = e1; i1 = 1; } if (e2 > v1) { v1 = e2; i1 = 2; } if (e3 > v1) { v1 = e3; i1 = 3; }
    int i2 = -1; float v2 = -3.0e38f;
    if (i1 != 0 && e0 > v2) { v2 = e0; i2 = 0; } if (i1 != 1 && e1 > v2) { v2 = e1; i2 = 1; } if (i1 != 2 && e2 > v2) { v2 = e2; i2 = 2; } if (i1 != 3 && e3 > v2) { v2 = e3; i2 = 3; }
    const float q2 = __expf(v2 - v1), p1 = 1.f / (1.f + q2), p2 = q2 * p1;
    const int a = i1 < i2 ? i1 : i2, b = i1 < i2 ? i2 : i1;
    wa = pg * (i1 < i2 ? p1 : p2); wb = pg * (i1 < i2 ? p2 : p1);
    cls = gi * 6 + (a * (7 - a)) / 2 + (b - a - 1);
}
constexpr size_t WS_WRT = WS_ROUTE + 2 * MiB;
constexpr size_t WS_PART = WS_ACTS;
constexpr int CW_PCNT = 2600, CW_WDT = 2700;
#ifndef MK_GT
#define MK_GT -1
#endif
#define P4_TMARK(cat) do { if (MK_GT >= 0) { if (tid == 0) { LAS unsigned long long* ts_ = (LAS unsigned long long*)(lds - RING_OFF + PARG_OFF + 256); if (ts_[2]) { const unsigned long long t_ = __builtin_amdgcn_s_memrealtime(); ts_[4 + (cat)] += t_ - ts_[3]; ts_[3] = t_; } } } } while (0)
constexpr int WR_LST = 528;
struct EpiP4F {
    static constexpr bool PERM = false, AFTER_DRAIN = true, PREFETCH = false;
    __device__ __forceinline__ void prefetch(const pg8::Unit&, LAS unsigned char*, int) const {}
    const bf16* h; const float* rinv; bf16* h2; const float* g2; const bf16* WR; float* gpart; unsigned* ctl; const float* bg; const float* br; int* rtokc; f32x4* swt; const float* g1;
    __device__ __forceinline__ bool operator()(f32x4 (&)[2][2][4][2], const pg8::Unit&, int, int, int, int) const { return true; }
    __device__ __forceinline__ void fused(f32x4 (&acc)[2][2][4][2], const pg8::Unit& un, int wr, int wc, int fr, int fq, LAS unsigned char* lds, int wid, int lane) const {
        const int tid = wid * 64 + lane;
        const int row0 = un.pm * 256 + wr * 64 + fr, col0 = un.pn * 256 + wc * 32 + 4 * fq;
        {
          const __amdgpu_buffer_rsrc_t rx = __builtin_amdgcn_make_buffer_rsrc((void*)h, 0, 0x7fffffff, 0x00020000), rh = __builtin_amdgcn_make_buffer_rsrc((void*)h2, 0, 0x7fffffff, 0x00020000);
          const int vh = fr * 2048 + (wc * 32 + 4 * fq) * 2, sh = ((un.pm * 256 + wr * 64) * 1024 + un.pn * 256) * 2;
          v2u xb[4][2][2];
#define EPI4_LD(g) do { _Pragma("unroll") for (int bj = 0; bj < 2; ++bj) _Pragma("unroll") for (int n = 0; n < 2; ++n) \
              xb[(g) & 3][bj][n] = __builtin_amdgcn_raw_buffer_load_b64(rx, vh + bj * 256 + n * 32, sh + (((g) >> 2) * 128 + ((g) & 3) * 16) * 2048, 0); } while (0)
          EPI4_LD(0); EPI4_LD(1); EPI4_LD(2); EPI4_LD(3);
          v4u wt[4]; const v4u* src = (const v4u*)(WR + (size_t)un.pn * (2 * 32 * 256));
#pragma unroll
          for (int i = 0; i < 4; ++i) wt[i] = src[tid + 512 * i];
          f32x4 g2v[2][2], gi1[2][2]; float ri[8];
#pragma unroll
          for (int bj = 0; bj < 2; ++bj)
#pragma unroll
              for (int n = 0; n < 2; ++n) { g2v[bj][n] = *(const f32x4*)(g2 + col0 + bj * 128 + n * 16); gi1[bj][n] = *(const f32x4*)(g1 + col0 + bj * 128 + n * 16); }
#pragma unroll
          for (int g = 0; g < 8; ++g) ri[g] = rinv[row0 + (g >> 2) * 128 + (g & 3) * 16];
          __builtin_amdgcn_sched_barrier(0);
#pragma unroll
          for (int i = 0; i < 4; ++i) { const int L = tid + 512 * i; *(LAS v4u*)(lds + (L >> 5) * WR_LST + (L & 31) * 16) = wt[i]; }
#pragma unroll
          for (int bj = 0; bj < 2; ++bj)
#pragma unroll
              for (int n = 0; n < 2; ++n) { const f32x4 g = gi1[bj][n]; gi1[bj][n] = (f32x4){1.f / g[0], 1.f / g[1], 1.f / g[2], 1.f / g[3]}; }
#pragma unroll
          for (int g = 0; g < 8; ++g) { const int ai = g >> 2, m = g & 3;
#pragma unroll
              for (int bj = 0; bj < 2; ++bj)
#pragma unroll
                  for (int n = 0; n < 2; ++n) { const v2u hx = xb[g & 3][bj][n];
                      const f32x4 v = (f32x4){bflo(hx.x), bfhi(hx.x), bflo(hx.y), bfhi(hx.y)} * gi1[bj][n] * ri[g] + acc[ai][bj][m][n]; acc[ai][bj][m][n] = v;
                      const f32x4 hv = v * g2v[bj][n];
                      v2u w; w.x = pg8::cvt_pk_bf16(hv[0], hv[1]); w.y = pg8::cvt_pk_bf16(hv[2], hv[3]);
                      __builtin_amdgcn_raw_buffer_store_b64(w, rh, vh + bj * 256 + n * 32, sh + (ai * 128 + m * 16) * 2048, 0); }
              if (g + 4 < 8) EPI4_LD(g + 4);
              __builtin_amdgcn_sched_barrier(0); }
#undef EPI4_LD
        }
        __syncthreads(); P4_TMARK(8);
        LAS float* P = (LAS float*)(lds + 36864);
#pragma unroll
        for (int ai = 0; ai < 2; ++ai)
#pragma unroll
            for (int m = 0; m < 4; ++m) { float ss = 0.f; f32x4 l0 = (f32x4){0.f, 0.f, 0.f, 0.f}, l1 = l0;
#pragma unroll
                for (int bj = 0; bj < 2; ++bj) { const f32x4 v0 = acc[ai][bj][m][0], v1 = acc[ai][bj][m][1];
                    ss += (v0[0] * v0[0] + v0[1] * v0[1]) + (v0[2] * v0[2] + v0[3] * v0[3]) + (v1[0] * v1[0] + v1[1] * v1[1]) + (v1[2] * v1[2] + v1[3] * v1[3]);
                    const v4u hi = pack8(v0, v1);
                    const v4u lo = pack8(v0 - (f32x4){bflo(hi.x), bfhi(hi.x), bflo(hi.y), bfhi(hi.y)}, v1 - (f32x4){bflo(hi.z), bfhi(hi.z), bflo(hi.w), bfhi(hi.w)});
                    const bf16x8 Bh = __builtin_bit_cast(bf16x8, hi), Bl = __builtin_bit_cast(bf16x8, lo);
                    const LAS unsigned char* wp = lds + fr * WR_LST + (bj * 4 + wc) * 64 + fq * 16;
                    const bf16x8 Ah0 = *(const LAS bf16x8*)wp, Ah1 = *(const LAS bf16x8*)(wp + 16 * WR_LST), Al0 = *(const LAS bf16x8*)(wp + 32 * WR_LST), Al1 = *(const LAS bf16x8*)(wp + 48 * WR_LST);
                    l0 = __builtin_amdgcn_mfma_f32_16x16x32_bf16(Ah0, Bh, l0, 0, 0, 0); l0 = __builtin_amdgcn_mfma_f32_16x16x32_bf16(Ah0, Bl, l0, 0, 0, 0); l0 = __builtin_amdgcn_mfma_f32_16x16x32_bf16(Al0, Bh, l0, 0, 0, 0);
                    l1 = __builtin_amdgcn_mfma_f32_16x16x32_bf16(Ah1, Bh, l1, 0, 0, 0); l1 = __builtin_amdgcn_mfma_f32_16x16x32_bf16(Ah1, Bl, l1, 0, 0, 0); l1 = __builtin_amdgcn_mfma_f32_16x16x32_bf16(Al1, Bh, l1, 0, 0, 0); }
                ss += shx(ss, 16); ss += shx(ss, 32);
                LAS float* pr = P + (ai * 128 + wr * 64 + m * 16 + fr) * 100 + wc * 24;
                *(LAS f32x4*)(pr + 4 * fq) = l0;
                if (fq == 0) *(LAS f32x4*)(pr + 16) = l1;
                if (fq == 1) *(LAS f32x4*)(pr + 20) = (f32x4){ss, 0.f, 0.f, 0.f}; }
        __syncthreads(); P4_TMARK(9);
        float* gp = gpart + (size_t)(un.pm * 4 + un.pn) * (256 * 24);
        { const int row = tid >> 1, half = tid & 1;
#pragma unroll
          for (int q = 0; q < 3; ++q) { const LAS float* pr = P + row * 100 + half * 12 + 4 * q;
              const f32x4 s = ((*(const LAS f32x4*)pr + *(const LAS f32x4*)(pr + 24)) + *(const LAS f32x4*)(pr + 48)) + *(const LAS f32x4*)(pr + 72);
              unsigned long long* g8 = (unsigned long long*)(gp + row * 24 + half * 12 + 4 * q);
              __hip_atomic_store(g8, ((unsigned long long)__float_as_uint(s[1]) << 32) | __float_as_uint(s[0]), __ATOMIC_RELAXED, __HIP_MEMORY_SCOPE_AGENT);
              __hip_atomic_store(g8 + 1, ((unsigned long long)__float_as_uint(s[3]) << 32) | __float_as_uint(s[2]), __ATOMIC_RELAXED, __HIP_MEMORY_SCOPE_AGENT); } }
        asm volatile("s_waitcnt vmcnt(0)" ::: "memory");
        __syncthreads(); P4_TMARK(10);
        if (tid == 0) {
            const unsigned old = __hip_atomic_fetch_add(ctl + CW_PCNT + un.pm, 1u, __ATOMIC_RELAXED, __HIP_MEMORY_SCOPE_AGENT);
            if (old == 3u) { __builtin_amdgcn_fence(__ATOMIC_ACQUIRE, "agent"); asm volatile("s_waitcnt vmcnt(0)" ::: "memory"); }
            *(LAS unsigned*)lds = old; }
        __syncthreads();
        const unsigned old = (unsigned)__builtin_amdgcn_readfirstlane((int)*(const LAS unsigned*)lds);
        __syncthreads(); P4_TMARK(11);
        if (old == 3u) {
            LAS int* hist = (LAS int*)(lds + 512); LAS int* cbase = (LAS int*)(lds + 768);
            if (tid < 32) hist[tid] = 0;
            __syncthreads();
            int cls = 0, rank = 0; float wa = 0.f, wb = 0.f, r = 0.f;
            if (tid < 256) {
                f32x4 s[6];
#pragma unroll
                for (int q = 0; q < 6; ++q) s[q] = (f32x4){0.f, 0.f, 0.f, 0.f};
                const float* pp = gpart + (size_t)(un.pm * 4) * (256 * 24) + tid * 24;
#pragma unroll
                for (int t4 = 0; t4 < 4; ++t4)
#pragma unroll
                    for (int q = 0; q < 6; ++q) s[q] += *(const f32x4*)(pp + (size_t)t4 * (256 * 24) + 4 * q);
                r = rsqrtf(s[5][0] * (1.f / 1024.f) + 1e-6f);
                LAS float* lg = (LAS float*)(lds + 1024) + tid * 24;
#pragma unroll
                for (int q = 0; q < 5; ++q) *(LAS f32x4*)(lg + 4 * q) = s[q] * r;
                route_token(lg, bg, br, cls, wa, wb);
                rank = __hip_atomic_fetch_add(hist + cls, 1, __ATOMIC_RELAXED, __HIP_MEMORY_SCOPE_WORKGROUP);
            }
            __syncthreads();
            if (tid < 24) cbase[tid] = (int)__hip_atomic_fetch_add(ctl + CW_CCNT + CCNT_STRIDE * tid, (unsigned)hist[tid], __ATOMIC_RELAXED, __HIP_MEMORY_SCOPE_AGENT);
            __syncthreads();
            if (tid < 256) { const int token = un.pm * 256 + tid; rtokc[cls * T + cbase[cls] + rank] = token; swt[token] = (f32x4){wa, wb, r, 0.f}; } P4_TMARK(12);
        }
    }
};
__device__ __forceinline__ void class_experts(int c, int& ea, int& eb) {
    const int g = c / 6, p = c - 6 * g; const int a = p < 3 ? 0 : (p < 5 ? 1 : 2), b = p < 3 ? p + 1 : (p < 5 ? p - 1 : 3); ea = g * 4 + a; eb = g * 4 + b;
}
__device__ __forceinline__ void moe_tables(Frame& F) {
    const int tid_ = F.ftid();
    LAS int* total = (LAS int*)(F.lds + TB_TOTAL); LAS int* tab = (LAS int*)(F.lds + TB_TAB); LAS int* ord = (LAS int*)(F.lds + TB_ORD); LAS int* aux = (LAS int*)(F.lds + TB_AUX);
    LAS int* ntl = aux; LAS int* cbase = aux + 32; LAS int* nel = aux + 64; LAS int* ebase = aux + 96;
    if (tid_ < 24) { const int t = (int)__hip_atomic_load((unsigned*)(F.ws() + WS_CTL) + CW_CCNT + CCNT_STRIDE * tid_, __ATOMIC_RELAXED, __HIP_MEMORY_SCOPE_AGENT); total[tid_] = t; ntl[tid_] = (t + 255) >> 8; }
    __syncthreads();
    if (tid_ < 32) {
        int bs = 0; for (int k = 0; k < 24; ++k) bs += (k < tid_) ? ntl[k] : 0;
        if (tid_ <= 24) cbase[tid_] = bs;
        if (tid_ < 24) { const int n = ntl[tid_]; for (int r = 0; r < n; ++r) tab[1 + bs + r] = tid_ | (r << 8); }
        if (tid_ == 24) tab[0] = bs;
        if (tid_ < 16) { const int g = tid_ >> 2; int n = 0;
            for (int p = 0; p < 6; ++p) { int ea, eb; class_experts(6 * g + p, ea, eb); if (ea == tid_ || eb == tid_) n += ntl[6 * g + p]; }
            nel[tid_] = n; }
    }
    __syncthreads();
    if (tid_ < 17) { int bs = 0; for (int k = 0; k < 16; ++k) bs += (k < tid_) ? nel[k] : 0; ebase[tid_] = bs;
        if (tid_ < 16) { const int g = tid_ >> 2; int o = bs;
            for (int p = 0; p < 6; ++p) { const int c = 6 * g + p; int ea, eb; class_experts(c, ea, eb);
                if (ea == tid_ || eb == tid_) { const int n = ntl[c], cb = cbase[c], sl = (eb == tid_) ? 1 : 0; for (int r = 0; r < n; ++r) ord[o + r] = (cb + r) | (sl << 16); o += n; } } } }
    __syncthreads();
    if (tid_ == 0) {
        const int R = cbase[24], G = F.G, m7 = 8 * R > 2 * G ? 8 * R - 2 * G : 0;
        int ed = 0; while (ed < 16 && ebase[ed + 1] * 4 <= 2 * G) ++ed;
        const int rdone = cbase[6 * (ed >> 2)]; int ny = G - m7; if (ny > 4 * rdone) ny = 4 * rdone; if (ny < 0) ny = 0; aux[128] = ny; }
    __syncthreads();
}
constexpr int CW_RT = 16384, RT_STRIDE = 64;
struct SchedP7 {
    __device__ __forceinline__ void a_ready(const pg8::Unit&) const {}
    int G, vcu; const LAS int* tab; const LAS int* total; const char* h2; const char* Wgu; const int* rtokc; int first, nmax;
    __device__ __forceinline__ bool next(int i, pg8::Unit& u) const {
        const int L = first + i * G + vcu, R = tab[0]; if (i >= nmax || L >= R * 8) return false;
        const int ov = ((const LAS int*)((const LAS char*)tab + (TB_ORD - TB_TAB)))[L >> 2], r = ov & 0xffff, pn = (ov >> 16) * 4 + (L & 3), tv = tab[1 + r], c = tv & 255, rp = tv >> 8; int ea, eb; class_experts(c, ea, eb); const int e = pn < 4 ? ea : eb;
        const int nv = total[c] - 256 * rp;
        u.pm = r; u.pn = pn; u.aux = nv < 256 ? nv : 256; u.ksplit = 1 << 30; u.A = h2; u.ridx = rtokc + c * T + 256 * rp;
        u.B0 = Wgu + (size_t)e * (1024 * 2048) + (size_t)(pn & 3) * 256 * 2048; u.B1 = u.B0; return true;
    }
};
struct EpiP7 {
    static constexpr bool PERM = true, AFTER_DRAIN = false, PREFETCH = false;
    bf16* hid; const f32x4* swt; unsigned* ctl;
    __device__ __forceinline__ bool operator()(f32x4 (&acc)[2][2][4][2], const pg8::Unit& un, int wr, int wc, int fr, int fq) const {
        const int rl0 = wr * 64 + fr, sel = un.pn >> 2, col0 = sel * 512 + 128 * (un.pn & 3) + 16 * wc + 4 * fq, last = un.aux - 1;
        const __amdgpu_buffer_rsrc_t rs = __builtin_amdgcn_make_buffer_rsrc((void*)swt, 0, 0x7fffffff, 0x00020000);
        int tok[8]; float w[8], r[8];
#pragma unroll
        for (int g = 0; g < 8; ++g) { const int rl = rl0 + (g >> 2) * 128 + (g & 3) * 16; tok[g] = un.ridx[rl < last ? rl : last]; }
#pragma unroll
        for (int g = 0; g < 8; ++g) { w[g] = __builtin_bit_cast(float, __builtin_amdgcn_raw_buffer_load_b32(rs, tok[g] * 16, sel * 4, 0)); r[g] = __builtin_bit_cast(float, __builtin_amdgcn_raw_buffer_load_b32(rs, tok[g] * 16 + 8, 0, 0)); }
        __builtin_amdgcn_sched_barrier(0);
#pragma unroll
        for (int g = 0; g < 8; ++g) { const int ai = g >> 2, m = g & 3, rl = rl0 + ai * 128 + m * 16; const bool ok = rl <= last; const float rr = ok ? r[g] : 0.f, rw = ok ? r[g] * w[g] : 0.f;
#pragma unroll
            for (int bj = 0; bj < 2; ++bj) { const f32x4 gv = acc[ai][bj][m][0] * rr, uv = acc[ai][bj][m][1] * rw; f32x4 hh;
#pragma unroll
                for (int e = 0; e < 4; ++e) hh[e] = gv[e] * fsigmoid(gv[e]) * uv[e];
                v2u o; o.x = pg8::cvt_pk_bf16(hh[0], hh[1]); o.y = pg8::cvt_pk_bf16(hh[2], hh[3]);
                *(v2u*)(hid + (size_t)(un.pm * 256 + rl) * 1024 + col0 + 64 * bj) = o; } }
        return true;
    }
};
struct SchedP8 {
    int G, vcu; const LAS int* tab; const LAS int* total; const char* hid; const char* WdT; const int* rtokc; unsigned* ctl; int first, nmax;
    __device__ __forceinline__ bool next(int i, pg8::Unit& u) const {
        const int L = first + i * G + vcu, R = tab[0]; if (i >= nmax || L < 0 || L >= R * 4) return false;
        const int r = L >> 2, pn = L & 3, tv = tab[1 + r], c = tv & 255, rp = tv >> 8; int ea, eb; class_experts(c, ea, eb);
        const int nv = total[c] - 256 * rp;
        u.pm = r; u.pn = pn; u.aux = nv < 256 ? nv : 256; u.ksplit = 8; u.A = hid + (size_t)r * 256 * 2048; u.ridx = rtokc + c * T + 256 * rp;
        u.B0 = WdT + (size_t)ea * (1024 * 1024) + (size_t)pn * 256 * 1024; u.B1 = WdT + (size_t)eb * (1024 * 1024) + (size_t)pn * 256 * 1024; return true;
    }
    __device__ __forceinline__ void a_ready(const pg8::Unit&) const {}
};
struct EpiP8 {
    static constexpr bool PERM = false, AFTER_DRAIN = false, PREFETCH = false;
    float* out; const bf16* h2; const float* g2;
    __device__ __forceinline__ bool operator()(f32x4 (&acc)[2][2][4][2], const pg8::Unit& un, int wr, int wc, int fr, int fq) const {
        const int rl0 = wr * 64 + fr, col0 = un.pn * 256 + wc * 32 + 4 * fq, last = un.aux - 1;
        const __amdgpu_buffer_rsrc_t rh = __builtin_amdgcn_make_buffer_rsrc((void*)h2, 0, 0x7fffffff, 0x00020000), ro = __builtin_amdgcn_make_buffer_rsrc((void*)out, 0, T * 1024 * 4, 0x00020000);
        int tok[8];
#pragma unroll
        for (int g = 0; g < 8; ++g) { const int rl = rl0 + (g >> 2) * 128 + (g & 3) * 16; tok[g] = un.ridx[rl < last ? rl : last]; }
        f32x4 gi[2][2];
#pragma unroll
        for (int bj = 0; bj < 2; ++bj)
#pragma unroll
            for (int n = 0; n < 2; ++n) { const f32x4 g = *(const f32x4*)(g2 + col0 + bj * 128 + n * 16); gi[bj][n] = (f32x4){1.f / g[0], 1.f / g[1], 1.f / g[2], 1.f / g[3]}; }
        v2u hw[2][2][2];
#define EPI8_LD(g) do { const int vo_ = tok[g] * 2048 + col0 * 2; _Pragma("unroll") for (int bj = 0; bj < 2; ++bj) _Pragma("unroll") for (int n = 0; n < 2; ++n) \
            hw[(g) & 1][bj][n] = __builtin_amdgcn_raw_buffer_load_b64(rh, vo_ + bj * 256 + n * 32, 0, 0); } while (0)
        EPI8_LD(0);
#pragma unroll
        for (int g = 0; g < 8; ++g) { const int ai = g >> 2, m = g & 3, rl = rl0 + ai * 128 + m * 16;
            if (g + 1 < 8) EPI8_LD(g + 1);
            const int so = rl <= last ? tok[g] * 4096 + col0 * 4 : 0x70000000;
#pragma unroll
            for (int bj = 0; bj < 2; ++bj)
#pragma unroll
                for (int n = 0; n < 2; ++n) { const v2u h = hw[g & 1][bj][n];
                    const f32x4 xm = (f32x4){bflo(h.x), bfhi(h.x), bflo(h.y), bfhi(h.y)} * gi[bj][n] + acc[ai][bj][m][n];
                    __builtin_amdgcn_raw_buffer_store_b128(__builtin_bit_cast(v4u, xm), ro, so + bj * 512 + n * 64, 0, 0); }
            __builtin_amdgcn_sched_barrier(0); }
#undef EPI8_LD
        return true;
    }
};
constexpr int KST64 = 144, KST128 = 272, VST = 528;
template <int DH, bool SWA>
__device__ __forceinline__ void attn256_mtile(const LAS unsigned char* Kl, const LAS unsigned char* Vl, const bf16x8 (&qf)[DH / 32], bf16* orow0, int ldo,
                                              float sink_l2, int i0, bool has_prev, int lane) {
    constexpr int KST = DH * 2 + 16, NKS = DH / 32, NDT = DH / 16;
    const int qi = lane & 15, g = lane >> 4;
    float ssq = 0.f;
#pragma unroll
    for (int ks = 0; ks < NKS; ++ks) {
        if (!SWA) {
#pragma unroll
            for (int e = 0; e < 8; ++e) { const float x = bf2f((bf16)qf[ks][e]); ssq += x * x; } } }
    float sc;
    if (SWA) sc = 0.125f * 1.4426950408889634f;
    else { ssq += shx(ssq, 16); ssq += shx(ssq, 32); sc = rsqrtf(ssq * (1.f / 128.f) + 1e-6f) * (0.08838834764831845f * 1.4426950408889634f); }
    f32x4 sacc[SWA ? 5 : 8][2];
    const int krow = 8 * (qi >> 2) + (qi & 3);
    constexpr int NS = SWA ? 5 : 8; const int sbase = SWA ? (i0 + 1) >> 5 : 0;
#pragma unroll
    for (int s = 0; s < NS; ++s)
#pragma unroll
        for (int h = 0; h < 2; ++h) { f32x4 c = (f32x4){0.f, 0.f, 0.f, 0.f}; const LAS unsigned char* kp = Kl + (32 * (sbase + s) + krow + 4 * h) * KST + 16 * g;
#pragma unroll
            for (int ks = 0; ks < NKS; ++ks) c = __builtin_amdgcn_mfma_f32_16x16x32_bf16(*(const LAS bf16x8*)(kp + 64 * ks), qf[ks], c, 0, 0, 0);
            sacc[s][h] = c; if (h == 1) __builtin_amdgcn_sched_barrier(0); }
    float mr = -3.0e38f;
#pragma unroll
    for (int s = 0; s < NS; ++s) {
        if (SWA && (s == 0 || s == NS - 1 || !has_prev)) {
#pragma unroll
            for (int h = 0; h < 2; ++h)
#pragma unroll
                for (int r = 0; r < 4; ++r) { const int kb = 32 * (sbase + s) + 8 * g + 4 * h + r, delta = 128 + i0 + qi - kb; const bool ok = (delta >= 0) && (delta < 128) && (has_prev || kb >= 128);
                    sacc[s][h][r] = ok ? sacc[s][h][r] : -1.0e30f; } }
#pragma unroll
        for (int h = 0; h < 2; ++h) mr = fmaxf(fmaxf(mr, fmaxf(sacc[s][h][0], sacc[s][h][1])), fmaxf(sacc[s][h][2], sacc[s][h][3])); }
    mr = fmaxf(mr, shx(mr, 16)); mr = fmaxf(mr, shx(mr, 32));
    float m = mr * sc; if (SWA) m = fmaxf(m, sink_l2);
    float sum = 0.f;
#pragma unroll
    for (int s = 0; s < NS; ++s)
#pragma unroll
        for (int h = 0; h < 2; ++h)
#pragma unroll
            for (int r = 0; r < 4; ++r) { const float p = __builtin_amdgcn_exp2f(__builtin_fmaf(sacc[s][h][r], sc, -m)); sacc[s][h][r] = p; sum += p; }
    sum += shx(sum, 16); sum += shx(sum, 32);
    if (SWA) sum += __builtin_amdgcn_exp2f(sink_l2 - m);
    const float inv = 1.f / sum;
    bf16x8 pf[NS];
#pragma unroll
    for (int s = 0; s < NS; ++s) { v4u w; w.x = pg8::cvt_pk_bf16(sacc[s][0][0], sacc[s][0][1]); w.y = pg8::cvt_pk_bf16(sacc[s][0][2], sacc[s][0][3]);
        w.z = pg8::cvt_pk_bf16(sacc[s][1][0], sacc[s][1][1]); w.w = pg8::cvt_pk_bf16(sacc[s][1][2], sacc[s][1][3]); pf[s] = __builtin_bit_cast(bf16x8, w); }
#pragma unroll
    for (int dt = 0; dt < NDT; dt += 2) { f32x4 o0 = (f32x4){0.f, 0.f, 0.f, 0.f}, o1 = o0;
        const LAS unsigned char* vp = Vl + (16 * dt + qi) * VST + 16 * g + 64 * sbase;
#pragma unroll
        for (int s = 0; s < NS; ++s) { o0 = __builtin_amdgcn_mfma_f32_16x16x32_bf16(*(const LAS bf16x8*)(vp + 64 * s), pf[s], o0, 0, 0, 0);
            o1 = __builtin_amdgcn_mfma_f32_16x16x32_bf16(*(const LAS bf16x8*)(vp + 16 * VST + 64 * s), pf[s], o1, 0, 0, 0); }
        v2u w; w.x = pg8::cvt_pk_bf16(o0[0] * inv, o0[1] * inv); w.y = pg8::cvt_pk_bf16(o0[2] * inv, o0[3] * inv);
        *(v2u*)(orow0 + (size_t)qi * ldo + 16 * dt + 4 * g) = w;
        w.x = pg8::cvt_pk_bf16(o1[0] * inv, o1[1] * inv); w.y = pg8::cvt_pk_bf16(o1[2] * inv, o1[3] * inv);
        *(v2u*)(orow0 + (size_t)qi * ldo + 16 * dt + 16 + 4 * g) = w; __builtin_amdgcn_sched_barrier(0); }
}
template <int DH>
__device__ __forceinline__ void vt_load(v4u (&va)[DH / 32], v4u (&vb)[DH / 32], const bf16* vsrc, int ldv, int kmin, int tid) {
    constexpr int NC = DH / 8;
#pragma unroll
    for (int i = 0; i < DH / 32; ++i) { const int id = tid + 512 * i, c = id % NC, kp = id / NC; const bool ok = 2 * kp >= kmin; const int r = ok ? 2 * kp : kmin;
        const v4u a = *(const v4u*)(vsrc + (long)r * ldv + 8 * c), b = *(const v4u*)(vsrc + (long)(r + 1) * ldv + 8 * c);
        va[i] = ok ? a : (v4u){0u, 0u, 0u, 0u}; vb[i] = ok ? b : (v4u){0u, 0u, 0u, 0u}; }
}
template <int DH>
__device__ __forceinline__ void vt_store(LAS unsigned char* Vl, const v4u (&va)[DH / 32], const v4u (&vb)[DH / 32], int tid) {
    constexpr int NC = DH / 8;
#pragma unroll
    for (int i = 0; i < DH / 32; ++i) { const int id = tid + 512 * i, c = id % NC, kp = id / NC; LAS unsigned char* dst = Vl + (8 * c) * VST + 4 * kp;
        const unsigned aw[4] = {va[i].x, va[i].y, va[i].z, va[i].w}, bw[4] = {vb[i].x, vb[i].y, vb[i].z, vb[i].w};
#pragma unroll
        for (int e = 0; e < 4; ++e) { *(LAS unsigned*)(dst + (2 * e) * VST) = (aw[e] & 0xffffu) | (bw[e] << 16); *(LAS unsigned*)(dst + (2 * e + 1) * VST) = (aw[e] >> 16) | (bw[e] & 0xffff0000u); } }
}
struct SwaRegs { bf16x8 qa[4][2]; v4u kr[4]; v4u va[2], vb[2]; };
__device__ __forceinline__ void swa_load(Frame& F, int u, SwaRegs& R) {
    const int tid_ = F.ftid(), lane_ = tid_ & 63;
    const int hk = u & 1, n = (u >> 1) & 63, b = u >> 7;
    unsigned char* dout = (unsigned char*)F.out();
    const bf16* q = (const bf16*)(dout + DO_Q); const bf16* k = (const bf16*)(dout + DO_K); const bf16* v = (const bf16*)(dout + DO_V);
    const int rowb = b * SEQ + 128 * (n - 1), kmin = (n == 0) ? 128 : 0;
    const int hq = 4 * hk + (F.wave >> 1), r0 = 64 * (F.wave & 1);
#pragma unroll
    for (int mt = 0; mt < 4; ++mt)
#pragma unroll
        for (int ks = 0; ks < 2; ++ks) R.qa[mt][ks] = *(const bf16x8*)(q + ((size_t)b * SEQ + 128 * n + r0 + 16 * mt + (lane_ & 15)) * 512 + hq * 64 + 8 * (lane_ >> 4) + 32 * ks);
#pragma unroll
    for (int i = 0; i < 4; ++i) { const int id = tid_ + 512 * i, key = id >> 3, c = id & 7; const bool ok = key >= kmin;
        const v4u w = *(const v4u*)(k + ((long)(rowb + (ok ? key : kmin)) * 128 + hk * 64 + 8 * c)); R.kr[i] = ok ? w : (v4u){0u, 0u, 0u, 0u}; }
    vt_load<64>(R.va, R.vb, v + ((long)rowb * 128 + hk * 64), 128, kmin, tid_);
}
__device__ __forceinline__ void swa_run(Frame& F, int u, const SwaRegs& R) {
    const int tid_ = F.ftid(), lane_ = tid_ & 63;
    const int hk = u & 1, n = (u >> 1) & 63, b = u >> 7;
    bf16* acts = (bf16*)(F.ws() + WS_ACTS);
    LAS unsigned char* Kl = F.lds; LAS unsigned char* Vl = F.lds + 256 * KST64;
    const int hq = 4 * hk + (F.wave >> 1), r0 = 64 * (F.wave & 1);
#pragma unroll
    for (int i = 0; i < 4; ++i) { const int id = tid_ + 512 * i, key = id >> 3, c = id & 7; *(LAS v4u*)(Kl + key * KST64 + 16 * c) = R.kr[i]; }
    vt_store<64>(Vl, R.va, R.vb, tid_);
    __syncthreads();
    const float sink_l2 = F.in(7)[hq] * 1.4426950408889634f;
#pragma unroll
    for (int mt = 0; mt < 4; ++mt) { const int i0 = r0 + 16 * mt; const size_t tok0 = (size_t)b * SEQ + 128 * n + i0;
        attn256_mtile<64, true>(Kl, Vl, R.qa[mt], acts + tok0 * 1536 + hq * 64, 1536, sink_l2, i0, n > 0, lane_); }
    __syncthreads();
}
struct XatRegs { bf16x8 qa[2][4]; v4u kr[8]; v4u va[4], vb[4]; };
__device__ __forceinline__ void xattn_load(Frame& F, int u, XatRegs& R) {
    const int tid_ = F.ftid(), lane_ = tid_ & 63;
    const int qb = u & 31, h = (u >> 5) & 3, b = u >> 7;
    const bf16* mkv = (const bf16*)(F.ws() + WS_MKV); const bf16* xq = (const bf16*)(F.ws() + WS_XQ);
#pragma unroll
    for (int mt = 0; mt < 2; ++mt)
#pragma unroll
        for (int ks = 0; ks < 4; ++ks) R.qa[mt][ks] = *(const bf16x8*)(xq + ((size_t)b * SEQ + 256 * qb + 32 * F.wave + 16 * mt + (lane_ & 15)) * 512 + h * 128 + 8 * (lane_ >> 4) + 32 * ks);
    const int c = tid_ & 15;
#pragma unroll
    for (int i = 0; i < 8; ++i) { const int key = (tid_ >> 4) + 32 * i; R.kr[i] = *(const v4u*)(mkv + (size_t)(b * 256 + key) * 1024 + h * 128 + 8 * c); }
    vt_load<128>(R.va, R.vb, mkv + (size_t)(b * 256) * 1024 + 512 + h * 128, 1024, 0, tid_);
}
__device__ __forceinline__ void xattn_run(Frame& F, int u, const XatRegs& R) {
    const int tid_ = F.ftid(), lane_ = tid_ & 63;
    const int qb = u & 31, h = (u >> 5) & 3, b = u >> 7;
    bf16* acts = (bf16*)(F.ws() + WS_ACTS);
    LAS unsigned char* Kl = F.lds; LAS unsigned char* Vl = F.lds + 256 * KST128;
    { const int c = tid_ & 15; const f32x4 ga = *(const f32x4*)(F.in(17) + 8 * c), gb = *(const f32x4*)(F.in(17) + 8 * c + 4), qa = *(const f32x4*)(F.in(16) + 8 * c), qc = *(const f32x4*)(F.in(16) + 8 * c + 4);
      const f32x4 g0 = ga * qa, g1 = gb * qc;
#pragma unroll
      for (int i = 0; i < 8; ++i) { const int key = (tid_ >> 4) + 32 * i; const v4u w = R.kr[i];
          f32x4 x0 = (f32x4){bflo(w.x), bfhi(w.x), bflo(w.y), bfhi(w.y)}, x1 = (f32x4){bflo(w.z), bfhi(w.z), bflo(w.w), bfhi(w.w)};
          float ss = (x0[0] * x0[0] + x0[1] * x0[1]) + (x0[2] * x0[2] + x0[3] * x0[3]) + (x1[0] * x1[0] + x1[1] * x1[1]) + (x1[2] * x1[2] + x1[3] * x1[3]);
          ss += shx(ss, 1); ss += shx(ss, 2); ss += shx(ss, 4); ss += shx(ss, 8);
          const float r = rsqrtf(ss * (1.f / 128.f) + 1e-6f); x0 = x0 * r * g0; x1 = x1 * r * g1;
          *(LAS v4u*)(Kl + key * KST128 + 16 * c) = pack8(x0, x1); } }
    vt_store<128>(Vl, R.va, R.vb, tid_);
    __syncthreads();
#pragma unroll
    for (int mt = 0; mt < 2; ++mt) { const size_t tok0 = (size_t)b * SEQ + 256 * qb + 32 * F.wave + 16 * mt;
        attn256_mtile<128, false>(Kl, Vl, R.qa[mt], acts + tok0 * 1536 + 1024 + h * 128, 1536, 0.f, 0, true, lane_); }
    __syncthreads();
}
__device__ __forceinline__ void conv_load(Frame& F, int cu, v4u (&pre)[8]) {
    const int tid_ = F.ftid(); const bf16* u = (const bf16*)(F.ws() + WS_U);
    const int t0 = 32 * cu, s0 = t0 & (SEQ - 1);
#pragma unroll
    for (int i = 0; i < 8; ++i) { const int id = tid_ + 512 * i, j0 = id >> 6, c = id & 63, j = j0 < 62 ? j0 : 61; const bool ok = s0 - 30 + j >= 0;
        const v4u w = *(const v4u*)(u + (long)(t0 - 30 + (ok ? j : 30)) * 512 + 8 * c); pre[i] = ok ? w : (v4u){0u, 0u, 0u, 0u}; }
}
__device__ __forceinline__ void conv_run(Frame& F, int cu, const v4u (&pre)[8]) {
    const int tid_ = F.ftid(), lane_ = tid_ & 63;
    bf16* acts = (bf16*)(F.ws() + WS_ACTS);
    LAS unsigned char* Ul = F.lds; LAS float* Yl = (LAS float*)(F.lds + 62 * 1024);
    const int t0 = 32 * cu;
#pragma unroll
    for (int i = 0; i < 8; ++i) { const int id = tid_ + 512 * i, j = id >> 6, c = id & 63; if (id < 62 * 64) *(LAS v4u*)(Ul + j * 1024 + 16 * c) = pre[i]; }
    __syncthreads();
    { const int cp = tid_ & 255, th = tid_ >> 8;
      const float* wdw = F.in(9); const float2 bias = *(const float2*)(F.in(10) + 2 * cp);
      f32x2v w[31];
#pragma unroll
      for (int j = 0; j < 31; ++j) { const float2 t = *(const float2*)(wdw + j * 512 + 2 * cp); w[j] = (f32x2v){t.x, t.y}; }
#pragma unroll 1
      for (int ch = 0; ch < 2; ++ch) { const int i0 = 16 * th + 8 * ch;
          f32x2v acc[8];
#pragma unroll
          for (int i = 0; i < 8; ++i) acc[i] = (f32x2v){bias.x, bias.y};
#pragma unroll
          for (int r = 0; r < 38; ++r) { const unsigned x = *(const LAS unsigned*)(Ul + (i0 + r) * 1024 + 4 * cp); const f32x2v xv = (f32x2v){bflo(x), bfhi(x)};
#pragma unroll
              for (int i = 0; i < 8; ++i) { const int j = r - i; if (j >= 0 && j < 31) acc[i] = __builtin_elementwise_fma(w[j], xv, acc[i]); } }
#pragma unroll
          for (int i = 0; i < 8; ++i) *(LAS f32x2v*)(Yl + (i0 + i) * 512 + 2 * cp) = acc[i]; }
    }
    __syncthreads();
    { const int lane = lane_; const f32x4 ga = *(const f32x4*)(F.in(11) + 8 * lane), gb = *(const f32x4*)(F.in(11) + 8 * lane + 4), ba = *(const f32x4*)(F.in(12) + 8 * lane), bb = *(const f32x4*)(F.in(12) + 8 * lane + 4);
#pragma unroll
      for (int i = 0; i < 4; ++i) { const int tk = 4 * F.wave + i; const f32x4 y0 = *(const LAS f32x4*)(Yl + tk * 512 + 8 * lane), y1 = *(const LAS f32x4*)(Yl + tk * 512 + 8 * lane + 4);
          const float mean = wave_sum((y0[0] + y0[1]) + (y0[2] + y0[3]) + (y1[0] + y1[1]) + (y1[2] + y1[3])) * (1.f / 512.f);
          const f32x4 d0 = y0 - mean, d1 = y1 - mean;
          const float var = wave_sum((d0[0] * d0[0] + d0[1] * d0[1]) + (d0[2] * d0[2] + d0[3] * d0[3]) + (d1[0] * d1[0] + d1[1] * d1[1]) + (d1[2] * d1[2] + d1[3] * d1[3])) * (1.f / 512.f);
          const float rstd = rsqrtf(var + 1e-5f);
          f32x4 z0 = d0 * rstd * ga + ba, z1 = d1 * rstd * gb + bb;
#pragma unroll
          for (int e = 0; e < 4; ++e) { z0[e] = z0[e] * fsigmoid(z0[e]); z1[e] = z1[e] * fsigmoid(z1[e]); }
          *(v4u*)(acts + (size_t)(t0 + tk) * 1536 + 512 + 8 * lane) = pack8(z0, z1); } }
    __syncthreads();
}
__device__ __forceinline__ void p2_mixers(Frame& F) {
    for (int u = F.vcu; u < 256; u += F.G) {
        v4u c1[8], c2[8]; conv_load(F, 2 * u, c1); conv_load(F, 2 * u + 1, c2);
        SwaRegs S; TSUB_BEG(0) conv_run(F, 2 * u, c1); TSUB_END(0) swa_load(F, u, S);
        TSUB_BEG(1) conv_run(F, 2 * u + 1, c2); TSUB_END(1)
        XatRegs X; xattn_load(F, u, X);
        TSUB_BEG(2) swa_run(F, u, S); TSUB_END(2)
        TSUB_BEG(3) xattn_run(F, u, X); TSUB_END(3)
    }
}
__global__ void __launch_bounds__(NWAVES * 64, 2) mk_fwd(Args args) {
    extern __shared__ __attribute__((aligned(16))) unsigned char lds[];
    Frame F;
    F.lds = (LAS unsigned char*)lds;
    F.MISC = (volatile LAS unsigned*)(F.lds + MISC_OFF);
    const int tid_ = F.ftid(); F.wave = __builtin_amdgcn_readfirstlane(tid_ >> 6);
    F.G = gridDim.x; { const int bx = blockIdx.x; F.vcu = (F.G % 8 == 0) ? (bx % 8) * (F.G / 8) + bx / 8 : bx; }
    F.ctl = (gu32*)(args.ws + WS_CTL);
    for (int u = tid_; u < (LDS_BYTES - LDSCTL_OFF) / 4; u += NWAVES * 64) ((LAS unsigned*)(F.lds + LDSCTL_OFF))[u] = 0u;
    __syncthreads();
    if (tid_ < 30) ((LAS unsigned long long*)(F.lds + PARG_OFF))[tid_] = tid_ < 28 ? (unsigned long long)args.in[tid_] : (tid_ == 28 ? (unsigned long long)args.out : (unsigned long long)args.ws);
    __syncthreads();
    XcdBarrier bar = xcd_barrier_post((unsigned*)(F.ctl + CW_BAR) + args.li * XCD_BAR_WORDS, F.MISC + 8);
    const int lo = args.ph_lo, hi = args.ph_hi;
#define IN(k) (lo <= (k) && (k) < hi)
#define BOTH(k) (IN(k) && IN((k) + 1))

#ifndef MK_REP
#define MK_REP 0
#endif
#ifndef MK_XBAR
#define MK_XBAR 0
#endif
#ifndef MK_TPROBE
#define MK_TPROBE -1
#endif
    unsigned long long tp0 = 0, tp1 = 0;
#define RUN(kk, BODY) if (IN(kk)) { if (MK_TPROBE == (kk)) tp0 = __builtin_amdgcn_s_memrealtime(); BODY if (BOTH(kk) || MK_TPROBE == (kk)) xcd_barrier(bar); if (MK_TPROBE == (kk)) tp1 = __builtin_amdgcn_s_memrealtime(); }
#define PH0 { p0_prologue(F); }
#define PH1 { unsigned char* ws = F.ws(); unsigned char* dout = (unsigned char*)F.out(); SchedP1 S{F.G, (int)blockIdx.x, (const char*)(dout + DO_H), (const char*)(ws + WS_W1), (const char*)(ws + WS_MEMN), (const char*)(ws + WS_WKV)}; \
        EpiP1 E{(bf16*)(dout + DO_Q), (bf16*)(dout + DO_K), (bf16*)(dout + DO_V), (bf16*)(ws + WS_U), (bf16*)(ws + WS_XQ), (bf16*)(ws + WS_GATES), (bf16*)(ws + WS_MKV), (const float2*)(ws + WS_CS), F.in(5), F.in(6)}; \
        pg8::gemm_phase<EpiP1, SchedP1, true, false, false, 16, 2048u, 2048u>(F.lds + RING_OFF, S, E); convert_b_tail(F); }
#define PH2 { p2_mixers(F); }
#define PH3 { unsigned char* ws = F.ws(); SchedP3 S{F.G, (int)blockIdx.x, (const char*)(ws + WS_ACTS), (const char*)(ws + WS_WO3)}; EpiP3 E{(const unsigned char*)(ws + WS_GATES), (bf16*)(ws + WS_MERGED)}; \
        pg8::gemm_phase<EpiP3, SchedP3, true, false, false, 8, 3072u, 1024u>(F.lds + RING_OFF, S, E); }
#define PH4 { unsigned char* ws = F.ws(); SchedP4 S{F.G, (int)blockIdx.x, (const char*)(ws + WS_MERGED), (const char*)(ws + WS_WOUT)}; \
        EpiP4F E{(const bf16*)((unsigned char*)F.out() + DO_H), (const float*)(ws + WS_RINV), (bf16*)(ws + WS_H2), F.in(20), (const bf16*)(ws + WS_WRT), (float*)(ws + WS_PART), (unsigned*)(ws + WS_CTL), F.in(22), F.in(24), (int*)(ws + WS_ROUTE + RT_TOKC), (f32x4*)(ws + WS_ROUTE + RT_SWT), F.in(3)}; \
        pg8::gemm_phase<EpiP4F, SchedP4, false, false, false, 16, 2048u, 2048u>(F.lds + RING_OFF, S, E); }
#define PH6 { }
#define MOE_SCHEDS unsigned char* ws = F.ws(); const LAS int* tab_ = (const LAS int*)(F.lds + TB_TAB); const LAS int* tot_ = (const LAS int*)(F.lds + TB_TOTAL); \
        EpiP7 E7{(bf16*)(ws + WS_HID), (const f32x4*)(ws + WS_ROUTE + RT_SWT), (unsigned*)(ws + WS_CTL)}; EpiP8 E8{F.out(), (const bf16*)(ws + WS_H2), F.in(20)};
#define SCHED7(first, nmax) SchedP7{F.G, F.vcu, tab_, tot_, (const char*)(ws + WS_H2), (const char*)(ws + WS_WGU), (const int*)(ws + WS_ROUTE + RT_TOKC), (first), (nmax)}
#define SCHED8(first, nmax) SchedP8{F.G, F.vcu, tab_, tot_, (const char*)(ws + WS_HID), (const char*)(ws + WS_WDT), (const int*)(ws + WS_ROUTE + RT_TOKC), (unsigned*)(ws + WS_CTL), (first), (nmax)}
#define GEMM7(S) pg8::gemm_phase<EpiP7, SchedP7, true, true, false, 16, 2048u, 2048u>(F.lds + RING_OFF, S, E7)
#define GEMM8(S) pg8::gemm_phase<EpiP8, SchedP8, true, false, true, 16, 2048u, 1024u>(F.lds + RING_OFF, S, E8)
#define PH7 { moe_tables(F); convert_b2_all(F); MOE_SCHEDS const SchedP7 S = SCHED7(0, 2); GEMM7(S); }
#define PH8 { MOE_SCHEDS const int R8 = 8 * tab_[0], m7 = R8 > 2 * F.G ? R8 - 2 * F.G : 0; \
        const int nY_ = ((const LAS int*)(F.lds + TB_AUX))[128]; if (F.vcu < m7) { const SchedP7 S = SCHED7(2 * F.G, 1); GEMM7(S); } else if (F.vcu - m7 < nY_) { const SchedP8 S = SCHED8(-m7, 1); GEMM8(S); } }
#define PH9 { MOE_SCHEDS const int R8 = 8 * tab_[0], m7 = R8 > 2 * F.G ? R8 - 2 * F.G : 0; const int nY_ = ((const LAS int*)(F.lds + TB_AUX))[128]; (void)m7; const SchedP8 S = SCHED8(nY_, 1 << 20); GEMM8(S); }
    RUN(0, PH0) RUN(1, PH1) RUN(2, PH2) RUN(3, PH3) RUN(4, PH4) RUN(7, PH7) RUN(8, PH8) RUN(9, PH9)
#ifdef MK_TSUB
    if (MK_TSUB >= 0 && blockIdx.x == 0) { const unsigned long long d = (((LAS unsigned long long*)(F.lds + PARG_OFF + 256))[1] - ((LAS unsigned long long*)(F.lds + PARG_OFF + 256))[0]) * 8ull, ts = __builtin_amdgcn_s_memrealtime(); while (__builtin_amdgcn_s_memrealtime() - ts < d) __builtin_amdgcn_s_sleep(8); }
#endif
    if (MK_TPROBE >= 0 && blockIdx.x == 0) { const unsigned long long d = (tp1 - tp0) * 8ull, ts = __builtin_amdgcn_s_memrealtime(); while (__builtin_amdgcn_s_memrealtime() - ts < d) __builtin_amdgcn_s_sleep(8); }
#undef IN
#undef BOTH
}

static void launch_mk(Args a, int lo, int hi, int li, int grid, hipStream_t stream) {
    a.ph_lo = lo; a.ph_hi = hi; a.li = li; a.pad = 0;
    hipLaunchKernelGGL(mk_fwd, dim3(grid), dim3(NWAVES * 64), LDS_BYTES, stream, a);
}
extern "C" void kernel_launch(void* const* d_in, const int* in_sizes, int n_in, void* d_out, int out_size, void* d_ws, size_t ws_size, hipStream_t stream) {
    static int grid = 0;
    if (grid == 0) {
        int dev = 0, cus = 0, per_cu = 0;
        if (n_in != 28 || out_size != T * D || ws_size < WS_END || hipGetDevice(&dev) != hipSuccess || hipDeviceGetAttribute(&cus, hipDeviceAttributeMultiprocessorCount, dev) != hipSuccess) {
            fprintf(stderr, "kernel_launch: built for 28 inputs, %d outputs and >= %zu bytes of workspace (n_in %d, out %d, ws %zu); nothing launched\n", T * D, (size_t)WS_END, n_in, out_size, ws_size); grid = -1; return; }
        if (hipFuncSetAttribute((const void*)mk_fwd, hipFuncAttributeMaxDynamicSharedMemorySize, LDS_BYTES) != hipSuccess) { fprintf(stderr, "kernel_launch: hipFuncSetAttribute failed\n"); grid = -1; return; }
        if (hipOccupancyMaxActiveBlocksPerMultiprocessor(&per_cu, (const void*)mk_fwd, NWAVES * 64, LDS_BYTES) != hipSuccess || per_cu < 1) { fprintf(stderr, "kernel_launch: occupancy query reports %d workgroups per CU; nothing launched\n", per_cu); grid = -1; (void)hipGetLastError(); return; }
        grid = cus;
        if (grid != 256) fprintf(stderr, "kernel_launch: note: tuned for 256 CUs, running on %d\n", grid);
    }
    if (grid < 0) return;
    if (hipMemsetAsync((char*)d_ws + WS_CTL, 0, CTL_ZERO_BYTES, stream) != hipSuccess) { fprintf(stderr, "kernel_launch: hipMemsetAsync failed\n"); return; }
    Args a{};
    for (int i = 0; i < 28; ++i) a.in[i] = (const float*)d_in[i];
    a.out = (float*)d_out; a.ws = (unsigned char*)d_ws;
    launch_mk(a, 0, 10, 0, grid, stream);
}
```

```cpp
#include <hip/hip_runtime.h>
#include <cstdint>
#include <cstdio>
#define MK_LEVEL 4
#define MK_GTB 0
#define MK_SPLIT_HI 9
#define MK_SPLIT_LO 9
#define MK_MIXN 0
#define MK_SPLIT01 0
constexpr int NWAVES = 8;
constexpr int T = 16384, SEQ = 8192, D = 1024, INW = 5376;
constexpr size_t MiB = 1u << 20;
constexpr size_t WS_CTL = 0, CTL_ZERO_BYTES = 1 * MiB;
constexpr size_t WS_W1 = 1 * MiB;
constexpr size_t WS_WO3 = 12 * MiB;
constexpr size_t WS_WOUT = 15 * MiB;
constexpr size_t WS_WKV = 17 * MiB;
constexpr size_t WS_WGU = 19 * MiB;
constexpr size_t WS_WDT = 51 * MiB;
constexpr size_t WS_CS = 67 * MiB;
constexpr size_t WS_MEMN = 71 * MiB;
constexpr size_t WS_MKV = 72 * MiB;
constexpr size_t WS_ROUTE = 73 * MiB;
constexpr size_t WS_RINV = WS_ROUTE + 1792 * 1024;
constexpr size_t WS_U = 76 * MiB;
constexpr size_t WS_XQ = 92 * MiB;
constexpr size_t WS_MERGED = 156 * MiB;
constexpr size_t WS_GATES = 108 * MiB;
constexpr size_t WS_H2 = 76 * MiB;
constexpr size_t WS_HID = 156 * MiB;
constexpr size_t WS_ACTS = 204 * MiB;
constexpr size_t WS_END = 252 * MiB;
constexpr size_t DO_H = 0, DO_Q = 32 * MiB, DO_K = 48 * MiB, DO_V = 52 * MiB;
constexpr size_t RT_CLS = 0;
constexpr size_t RT_W = 64 * 1024;
constexpr size_t RT_CNT = 192 * 1024;
constexpr size_t RT_TOK = 256 * 1024;
constexpr size_t RT_SW = 384 * 1024;
constexpr int CW_TMO = 0, CW_BAR = 4096;
constexpr int RING_OFF = 0, RING_BYTES = 131072;
constexpr int LDS_BYTES = 147456;
constexpr int LDSCTL_OFF = LDS_BYTES - 4096, MISC_OFF = LDSCTL_OFF + 320;
constexpr int TAB_OFF = LDSCTL_OFF + 1024;

#define GAS __attribute__((address_space(1)))
#define LAS __attribute__((address_space(3)))
typedef unsigned short bf16;
typedef unsigned v4u __attribute__((ext_vector_type(4)));
typedef unsigned v2u __attribute__((ext_vector_type(2)));
typedef float f32x4 __attribute__((ext_vector_type(4)));
typedef short bf16x8 __attribute__((ext_vector_type(8)));
typedef GAS unsigned gu32;
#define RLX_AGENT __ATOMIC_RELAXED, __HIP_MEMORY_SCOPE_AGENT
#define LDS_WAIT() asm volatile("s_waitcnt lgkmcnt(0)" ::: "memory")
#define VM_WAIT() asm volatile("s_waitcnt vmcnt(0)" ::: "memory")
__device__ __forceinline__ unsigned f2bf(float f) { unsigned u = __builtin_bit_cast(unsigned, f); return (u + 0x7fffu + ((u >> 16) & 1u)) >> 16; }
__device__ __forceinline__ unsigned pk2(float lo, float hi) { return f2bf(lo) | (f2bf(hi) << 16); }
__device__ __forceinline__ float bf2f(bf16 v) { return __uint_as_float((unsigned)v << 16); }
__device__ __forceinline__ float bflo(unsigned w) { return __uint_as_float(w << 16); }
__device__ __forceinline__ float bfhi(unsigned w) { return __uint_as_float(w & 0xffff0000u); }
__device__ __forceinline__ float shx(float v, int mask) { int l = threadIdx.x; asm volatile("" : "+v"(l));
    return __builtin_bit_cast(float, __builtin_amdgcn_ds_bpermute(((l ^ mask) & 63) << 2, __builtin_bit_cast(int, v))); }
__device__ __forceinline__ float wave_sum(float v) {
    v += __builtin_bit_cast(float, __builtin_amdgcn_update_dpp(0, __builtin_bit_cast(int, v), 0xB1, 0xF, 0xF, true));
    v += __builtin_bit_cast(float, __builtin_amdgcn_update_dpp(0, __builtin_bit_cast(int, v), 0x4E, 0xF, 0xF, true));
    v += __builtin_bit_cast(float, __builtin_amdgcn_update_dpp(0, __builtin_bit_cast(int, v), 0x141, 0xF, 0xF, true));
    v += __builtin_bit_cast(float, __builtin_amdgcn_update_dpp(0, __builtin_bit_cast(int, v), 0x140, 0xF, 0xF, true));
    v += shx(v, 16); v += shx(v, 32);
    return v;
}
__device__ __forceinline__ float wave_max(float v) {
#pragma unroll
    for (int o = 1; o < 64; o <<= 1) v = fmaxf(v, shx(v, o));
    return v;
}
__device__ __forceinline__ float fsigmoid(float x) { return __builtin_amdgcn_rcpf(1.f + __expf(-x)); }
template <int N> __device__ __forceinline__ void sigmoid_n(float (&x)[N]) {
#pragma unroll
    for (int k = 0; k < N; ++k) x[k] = __builtin_amdgcn_exp2f(x[k] * -1.4426950408889634f);
    __builtin_amdgcn_sched_barrier(0);
#pragma unroll
    for (int k = 0; k < N; ++k) x[k] = __builtin_amdgcn_rcpf(1.f + x[k]);
    __builtin_amdgcn_sched_barrier(0);
}

#define XB_TMO      128
#define XB_XCNT(j)  (256  + 64 * (j))
#define XB_XSUB(j)  (1280 + 64 * (j))
#define XB_XGEN(j)  (2304 + 64 * (j))
#define XB_TOP      3328
#define XB_TOPGEN   3392
#define XCD_BAR_WORDS 3456
#define XB_SPIN_CAP (1u << 18)
__device__ __forceinline__ unsigned xb_ld(unsigned* p)              { return __hip_atomic_load(p, __ATOMIC_RELAXED, __HIP_MEMORY_SCOPE_AGENT); }
__device__ __forceinline__ unsigned xb_add(unsigned* p, unsigned v) { return __hip_atomic_fetch_add(p, v, __ATOMIC_RELAXED, __HIP_MEMORY_SCOPE_AGENT); }
__device__ __forceinline__ unsigned xb_xcc_id() { return (unsigned)__builtin_amdgcn_s_getreg((3 << 11) | 20) & 0xFu; }
#define XB_SPIN(cond, bar) do { unsigned _sp = 0; while (cond) { __builtin_amdgcn_s_sleep(1); \
    if ((++_sp & 255u) == 0u) { if (xb_ld(&(bar)[XB_TMO])) break; if (_sp > XB_SPIN_CAP) { atomicAdd(&(bar)[XB_TMO], 1u); break; } } } } while (0)
struct XcdBarrier { unsigned* bar; unsigned x; volatile LAS unsigned* st; };
__device__ __forceinline__ XcdBarrier xcd_barrier_post(unsigned* bar, volatile LAS unsigned* st) {
    XcdBarrier b; b.bar = bar; b.x = xb_xcc_id(); b.st = st;
    if (threadIdx.x == 0) st[2] = xb_add(&bar[XB_XCNT(b.x)], 1u);
    return b;
}
__device__ __forceinline__ void xcd_barrier_complete(unsigned* bar, unsigned x, unsigned& nloc, unsigned& nx) {
    const unsigned G = gridDim.x * gridDim.y * gridDim.z;
    unsigned sum, cnt, mine, sp = 0u;
    for (;;) {
        sum = 0u; cnt = 0u; mine = 0u;
#pragma unroll
        for (unsigned j = 0; j < 16; ++j) { const unsigned c = xb_ld(&bar[XB_XCNT(j)]); sum += c; cnt += (c > 0u) ? 1u : 0u; mine = (j == x) ? c : mine; }
        if (sum == G) break;
        __builtin_amdgcn_s_sleep(1);
        if ((++sp & 255u) == 0u) { if (xb_ld(&bar[XB_TMO])) break; if (sp > XB_SPIN_CAP) { atomicAdd(&bar[XB_TMO], 1u); break; } }
    }
    nloc = mine > 0u ? mine : 1u; nx = cnt > 0u ? cnt : 1u;
}
__device__ __forceinline__ void xcd_barrier(const XcdBarrier& b) {
    asm volatile("s_waitcnt vmcnt(0)" ::: "memory");
    __syncthreads();
    if (threadIdx.x == 0) {
        unsigned* bar = b.bar;
        __builtin_amdgcn_s_waitcnt(0);
        unsigned nloc = b.st[0], nx = b.st[1];
        if (nloc == 0u) { xcd_barrier_complete(bar, b.x, nloc, nx); b.st[0] = nloc; b.st[1] = nx; }
        const unsigned old = xb_add(&bar[XB_XSUB(b.x)], 1u);
        const unsigned gen = old / nloc;
        if (old + 1u == (gen + 1u) * nloc) {
            __builtin_amdgcn_fence(__ATOMIC_RELEASE, "agent");
            asm volatile("s_waitcnt vmcnt(0)" ::: "memory");
            const unsigned og = xb_add(&bar[XB_TOP], 1u);
            const unsigned tg = og / nx;
            if (og + 1u == (tg + 1u) * nx) {
#pragma unroll
                for (unsigned j = 0; j < 16; ++j) __hip_atomic_fetch_add(&bar[XB_XGEN(j)], 1u, __ATOMIC_RELAXED, __HIP_MEMORY_SCOPE_AGENT);
            }
        }
        XB_SPIN(xb_ld(&bar[XB_XGEN(b.x)]) == gen, bar);
        __builtin_amdgcn_fence(__ATOMIC_ACQUIRE, "agent");
        asm volatile("s_waitcnt vmcnt(0)" ::: "memory");
    }
    __syncthreads();
}

constexpr int CW_XL = 15000;
__device__ __forceinline__ void xcd_local_barrier(unsigned* ctl, unsigned* bar, unsigned x, unsigned k, unsigned n) {
    asm volatile("s_waitcnt vmcnt(0)" ::: "memory");
    __syncthreads();
    if (threadIdx.x == 0) {
        __builtin_amdgcn_s_waitcnt(0);
        unsigned* c = ctl + CW_XL + 64 * (16 * k + x);
        (void)xb_add(c, 1u);
        XB_SPIN(xb_ld(c) < n, bar);
        __builtin_amdgcn_fence(__ATOMIC_ACQUIRE, "agent");
        asm volatile("s_waitcnt vmcnt(0)" ::: "memory");
    }
    __syncthreads();
}
__device__ __forceinline__ bool xcd_uniform_32x8(unsigned* bar) {
    bool u = gridDim.x == 256;
#pragma unroll
    for (unsigned j = 0; j < 16; ++j) { const unsigned c = xb_ld(&bar[XB_XCNT(j)]); u = u && (c == (j < 8u ? 32u : 0u)); }
    return u;
}

struct Args { const float* in[28]; float* out; unsigned char* ws; int ph_lo, ph_hi, li, pad; };
constexpr int PARG_OFF = LDSCTL_OFF + 512;
struct Frame {
    LAS unsigned char* lds; volatile LAS unsigned* MISC; gu32* ctl;
    int wave, vcu, G;
    __device__ __forceinline__ int ftid() const { int t = threadIdx.x; asm volatile("" : "+v"(t)); return t; }
    __device__ __forceinline__ unsigned long long ldp(int i) const { const unsigned long long v = ((const LAS unsigned long long*)(lds + PARG_OFF))[i];
        const unsigned lo = __builtin_amdgcn_readfirstlane((unsigned)v), hi = __builtin_amdgcn_readfirstlane((unsigned)(v >> 32)); return ((unsigned long long)hi << 32) | lo; }
    __device__ __forceinline__ const float* in(int i) const { return (const float*)(const GAS float*)ldp(i); }
    __device__ __forceinline__ float* out() const { return (float*)(GAS float*)ldp(28); }
    __device__ __forceinline__ unsigned char* ws() const { return (unsigned char*)(GAS unsigned char*)ldp(29); }
};
namespace pg8 {
#define PG8_LAS __attribute__((address_space(3)))
typedef unsigned short bf16_t;
typedef short bf16x8 __attribute__((ext_vector_type(8)));
typedef float f32x4 __attribute__((ext_vector_type(4)));
typedef unsigned u32x4 __attribute__((ext_vector_type(4)));
typedef unsigned u32x2 __attribute__((ext_vector_type(2)));
constexpr int BM = 256, BK = 64, HALF = 128, HTB = HALF * BK * 2  , STAGE_BYTES = 8 * HTB, NXCD = 8, WGM = 8;

__host__ __device__ __forceinline__ int lds_byte(int r, int c) { const int st = (r >> 4) * 2 + (c >> 5), rr = r & 15, cc = c & 31, ob = rr * 64 + cc * 2; return st * 1024 + (ob ^ (((ob >> 9) & 1) << 5)); }
__host__ __device__ __forceinline__ void stage_rc(int b, int& R, int& C) { const int st = b / 1024, sb = b % 1024, swz = sb ^ (((sb >> 9) & 1) << 5); R = (st >> 1) * 16 + swz / 64; C = (st & 1) * 32 + (swz % 64) / 2; }
__host__ __device__ __forceinline__ int perm32(int rho) { const int n = rho >> 4, i = rho & 15; return 8 * (i >> 2) + 4 * n + (i & 3); }

struct Unit { int pm, pn, aux, ksplit; const char* A; const char* B0; const char* B1; const int* ridx; };

typedef float f32x2_t __attribute__((ext_vector_type(2))); typedef __bf16 bf16x2_t __attribute__((ext_vector_type(2)));
__device__ __forceinline__ unsigned cvt_pk_bf16(float lo, float hi) { f32x2_t v = {lo, hi}; bf16x2_t b = __builtin_convertvector(v, bf16x2_t); return __builtin_bit_cast(unsigned, b); }

__device__ __forceinline__ bool static_tile(int L, int nM, int nN, int& pm, int& pn) {
    const int nwg = nM * nN; if (L >= nwg) return false;
    int wgid = L; { const int q = nwg / NXCD, r = nwg % NXCD, xcd = wgid % NXCD, off = wgid / NXCD; wgid = (xcd < r ? xcd * (q + 1) : r * (q + 1) + (xcd - r) * q) + off; }
    const int nig = WGM * nN, gid = wgid / nig, fm = gid * WGM, gsz = (nM - fm) < WGM ? (nM - fm) : WGM;
    pm = fm + ((wgid % nig) % gsz); pn = (wgid % nig) / gsz; return true;
}

template <class Epi, class Sched, bool ALIGN_EPI, bool GATHER, bool SPLIT, int nt, unsigned lda, unsigned ldb>
__device__ __forceinline__ void gemm_phase(PG8_LAS unsigned char* lds, const Sched& S, const Epi& E) {
    const int tid = threadIdx.x, wid = __builtin_amdgcn_readfirstlane(tid >> 6), lane = tid & 63, wr = wid >> 2, wc = wid & 3, fr = lane & 15, fq = lane >> 4;
    unsigned voffA[2], voffB[2];
#pragma unroll
    for (int i = 0; i < 2; ++i) { int R, C; stage_rc(tid * 16 + i * 8192, R, C); const int Rb = Epi::PERM ? ((R & ~31) + perm32(R & 31)) : R;
        voffA[i] = (unsigned)R * lda + (unsigned)C * 2u; voffB[i] = (unsigned)Rb * ldb + (unsigned)C * 2u; }
    const size_t kstep = (size_t)(BK * 2);
    const size_t hstepA = (size_t)HALF * lda, hstepB = (size_t)HALF * ldb;
    const unsigned ldsw = (unsigned)wid * 1024u;
    const int aoff = lds_byte(wr * 64 + fr, fq * 8), boff = lds_byte(wc * 32 + fr, fq * 8);
#define PG8_SA(b, h) (((b) * 2 + (h)) * HTB)
#define PG8_SB(b, h) ((4 + (b) * 2 + (h)) * HTB)
#define PG8_STAGE(bufoff, gbase, voff) do { const __amdgpu_buffer_rsrc_t _rs = __builtin_amdgcn_make_buffer_rsrc((void*)(gbase), 0, 0x7fffffff, 0x00020000); _Pragma("unroll") for (int _i = 0; _i < 2; ++_i) \
        __builtin_amdgcn_raw_ptr_buffer_load_lds(_rs, (PG8_LAS unsigned*)(lds + (bufoff) + ldsw + _i * 8192), 16, (int)(voff)[_i], 0, 0, 0); } while (0)
#define PG8_LDA(dst, b, h) do { _Pragma("unroll") for (int m = 0; m < 4; ++m) _Pragma("unroll") for (int k = 0; k < 2; ++k) dst[m][k] = *(const PG8_LAS bf16x8*)(lds + PG8_SA(b, h) + aoff + m * 2048 + k * 1024); } while (0)
#define PG8_LDB(dst, b, h) do { _Pragma("unroll") for (int n = 0; n < 2; ++n) _Pragma("unroll") for (int k = 0; k < 2; ++k) dst[n][k] = *(const PG8_LAS bf16x8*)(lds + PG8_SB(b, h) + boff + n * 2048 + k * 1024); } while (0)
#define PG8_MMA(ai, bj, At, Bt) do { __builtin_amdgcn_s_setprio(1); _Pragma("unroll") for (int m = 0; m < 4; ++m) _Pragma("unroll") for (int n = 0; n < 2; ++n) _Pragma("unroll") for (int k = 0; k < 2; ++k) \
        acc[ai][bj][m][n] = __builtin_amdgcn_mfma_f32_16x16x32_bf16(Bt[n][k], At[m][k], acc[ai][bj][m][n], 0, 0, 0); __builtin_amdgcn_s_setprio(0); } while (0)
#define PG8_WAIT_V(n) asm volatile("s_waitcnt vmcnt(" #n ")" ::: "memory")
#define PG8_WAIT_L(n) asm volatile("s_waitcnt lgkmcnt(" #n ")" ::: "memory")
#define PG8_BAR __builtin_amdgcn_s_barrier()
#define PG8_SCHED __builtin_amdgcn_sched_barrier(0)
#ifndef MK_GT
#define MK_GT -1
#endif
#define PG8_TMARK(cat) do { if (MK_GT >= 0) { if (tid == 0) { PG8_LAS unsigned long long* ts_ = (PG8_LAS unsigned long long*)(lds - RING_OFF + PARG_OFF + 256); if (ts_[2]) { const unsigned long long t_ = __builtin_amdgcn_s_memrealtime(); ts_[4 + (cat)] += t_ - ts_[3]; ts_[3] = t_; } } } } while (0)
#define PG8_APTR(u, h, t) ((u).A + (GATHER ? (size_t)0 : (size_t)(h) * hstepA) + (size_t)(t) * kstep)
#define PG8_BPTR(u, h, t) ((SPLIT ? ((t) < (u).ksplit ? (u).B0 + (size_t)(t) * kstep : (u).B1 + (size_t)((t) - (u).ksplit) * kstep) : (u).B0 + (size_t)(t) * kstep) + (size_t)(h) * hstepB)
#define PG8_STAGE_A(bufoff, u, g, h, t) do { if (GATHER) { PG8_STAGE(bufoff, PG8_APTR(u, h, t), (g)[h]); } else PG8_STAGE(bufoff, PG8_APTR(u, h, t), voffA); } while (0)
#define PG8_STAGE_B(bufoff, u, h, t) PG8_STAGE(bufoff, PG8_BPTR(u, h, t), voffB)
#define PG8_GIDX(g, u) do { if (GATHER) { _Pragma("unroll") for (int _h = 0; _h < 2; ++_h) _Pragma("unroll") for (int _i = 0; _i < 2; ++_i) { int _R, _C; stage_rc(tid * 16 + _i * 8192, _R, _C); \
            const int _j = _h * HALF + _R, _t = (u).ridx[_j < (u).aux ? _j : (u).aux - 1]; (g)[_h][_i] = (unsigned)_t * lda + (unsigned)_C * 2u; } } } while (0)
    PG8_TMARK(0);
    Unit cur, nxt; int ui = 0;
    if (!S.next(0, cur)) return;
    f32x4 acc[2][2][4][2];
#pragma unroll
    for (int a = 0; a < 2; ++a)
#pragma unroll
        for (int b = 0; b < 2; ++b)
#pragma unroll
            for (int m = 0; m < 4; ++m)
#pragma unroll
                for (int n = 0; n < 2; ++n) acc[a][b][m][n] = (f32x4){0.f, 0.f, 0.f, 0.f};
    bf16x8 At[4][2], B0[2][2], B1[2][2];
    u32x2 keep[8][2];
#pragma unroll
    for (int a = 0; a < 8; ++a) { keep[a][0] = (u32x2){0u, 0u}; keep[a][1] = (u32x2){0u, 0u}; }
    unsigned gC[2][2] = {{0u, 0u}, {0u, 0u}}, gN[2][2] = {{0u, 0u}, {0u, 0u}};
    S.a_ready(cur);
    PG8_GIDX(gC, cur);
    if constexpr (Epi::PREFETCH) E.prefetch(cur, lds + STAGE_BYTES + wid * 256, tid);
    PG8_STAGE_B(PG8_SB(0, 0), cur, 0, 0); PG8_STAGE_B(PG8_SB(0, 1), cur, 1, 0); PG8_STAGE_A(PG8_SA(0, 0), cur, gC, 0, 0); PG8_STAGE_A(PG8_SA(0, 1), cur, gC, 1, 0);
    if (wr == 1) PG8_BAR;
    PG8_WAIT_V(2); PG8_BAR;
    PG8_STAGE_B(PG8_SB(1, 0), cur, 0, 1); PG8_STAGE_A(PG8_SA(1, 0), cur, gC, 0, 1); PG8_STAGE_B(PG8_SB(1, 1), cur, 1, 1);
    PG8_WAIT_V(6); PG8_BAR;
    PG8_TMARK(1);
    for (;;) {
        const bool has_next = S.next(ui + 1, nxt);
        if (!has_next) nxt = cur;
        if (GATHER) { if (has_next) { PG8_GIDX(gN, nxt); } else { gN[0][0] = gC[0][0]; gN[0][1] = gC[0][1]; gN[1][0] = gC[1][0]; gN[1][1] = gC[1][1]; } }
        for (int t = 0; t < nt; t += 2) {
            const bool last = (t == nt - 2);
            if (last && has_next) S.a_ready(nxt);
            PG8_LDB(B0, 0, 0); PG8_LDB(B1, 0, 1); PG8_SCHED; PG8_LDA(At, 0, 0); PG8_STAGE_A(PG8_SA(1, 1), cur, gC, 1, t + 1);
            PG8_WAIT_V(8); PG8_WAIT_L(0); PG8_BAR; PG8_MMA(0, 0, At, B0); PG8_MMA(0, 1, At, B1); PG8_BAR; PG8_SCHED;
            PG8_LDA(At, 0, 1);
            if (!last) { PG8_STAGE_B(PG8_SB(0, 0), cur, 0, t + 2); PG8_STAGE_B(PG8_SB(0, 1), cur, 1, t + 2); PG8_STAGE_A(PG8_SA(0, 0), cur, gC, 0, t + 2); }
            else       { PG8_STAGE_B(PG8_SB(0, 0), nxt, 0, 0);     PG8_STAGE_B(PG8_SB(0, 1), nxt, 1, 0);     PG8_STAGE_A(PG8_SA(0, 0), nxt, gN, 0, 0); }
            PG8_WAIT_V(8); PG8_WAIT_L(0); PG8_BAR; PG8_MMA(1, 0, At, B0); PG8_MMA(1, 1, At, B1); PG8_BAR; PG8_SCHED;
            PG8_LDB(B0, 1, 0); PG8_LDB(B1, 1, 1); PG8_SCHED; PG8_LDA(At, 1, 0);
            if (!last) { PG8_STAGE_A(PG8_SA(0, 1), cur, gC, 1, t + 2); } else { PG8_STAGE_A(PG8_SA(0, 1), nxt, gN, 1, 0); }
            PG8_WAIT_V(8); PG8_WAIT_L(0); PG8_BAR; PG8_MMA(0, 0, At, B0); PG8_MMA(0, 1, At, B1); PG8_BAR; PG8_SCHED;
            PG8_LDA(At, 1, 1);
            if (!last) { PG8_STAGE_B(PG8_SB(1, 0), cur, 0, t + 3); PG8_STAGE_B(PG8_SB(1, 1), cur, 1, t + 3); PG8_STAGE_A(PG8_SA(1, 0), cur, gC, 0, t + 3); }
            else       { PG8_STAGE_B(PG8_SB(1, 0), nxt, 0, 1);     PG8_STAGE_B(PG8_SB(1, 1), nxt, 1, 1);     PG8_STAGE_A(PG8_SA(1, 0), nxt, gN, 0, 1); }
            PG8_WAIT_V(8); PG8_WAIT_L(0); PG8_BAR; PG8_MMA(1, 0, At, B0); PG8_MMA(1, 1, At, B1); PG8_BAR; PG8_SCHED;
        }
        if constexpr (ALIGN_EPI) { if (wr == 0) PG8_BAR; }
        PG8_TMARK(2);
        int fr_ = fr, fq_ = fq; asm volatile("" : "+v"(fr_), "+v"(fq_));
        bool zero = true;
        asm volatile("" ::: "memory");
        if constexpr (!Epi::AFTER_DRAIN) { if constexpr (Epi::KEEP) zero = E(acc, cur, wr, wc, fr_, fq_, keep); else zero = E(acc, cur, wr, wc, fr_, fq_); }
        asm volatile("" ::: "memory");
        PG8_TMARK(3);
        if (!has_next) break;
        if (zero) {
#pragma unroll
            for (int a = 0; a < 2; ++a)
#pragma unroll
                for (int b = 0; b < 2; ++b)
#pragma unroll
                    for (int m = 0; m < 4; ++m)
#pragma unroll
                        for (int n = 0; n < 2; ++n) acc[a][b][m][n] = (f32x4){0.f, 0.f, 0.f, 0.f};
        }
        cur = nxt; ++ui;
        if constexpr (Epi::PREFETCH) E.prefetch(cur, lds + STAGE_BYTES + wid * 256, tid);
        if (GATHER) { gC[0][0] = gN[0][0]; gC[0][1] = gN[0][1]; gC[1][0] = gN[1][0]; gC[1][1] = gN[1][1]; }
        if constexpr (ALIGN_EPI) { if (wr == 1) PG8_BAR; }
        PG8_TMARK(4);
    }
    PG8_WAIT_V(0);
    if constexpr (!ALIGN_EPI) { if (wr == 0) PG8_BAR; }
    PG8_BAR;
    PG8_TMARK(5);
    if constexpr (Epi::AFTER_DRAIN) { int fr_ = fr, fq_ = fq; asm volatile("" : "+v"(fr_), "+v"(fq_)); E.fused(acc, cur, wr, wc, fr_, fq_, lds, wid, lane); }
    PG8_TMARK(6);
#undef PG8_SA
#undef PG8_SB
#undef PG8_STAGE
#undef PG8_LDA
#undef PG8_LDB
#undef PG8_MMA
#undef PG8_WAIT_V
#undef PG8_WAIT_L
#undef PG8_BAR
#undef PG8_SCHED
#undef PG8_APTR
#undef PG8_BPTR
#undef PG8_STAGE_A
#undef PG8_STAGE_B
#undef PG8_GIDX
#undef PG8_TMARK
}
}
#ifndef MK_TSUB
#define MK_TSUB -1
#endif
#ifndef TSUB_BEG
#define TSUB_BEG(k) if (MK_TSUB == (k)) { __syncthreads(); if (threadIdx.x == 0) ((LAS unsigned long long*)(F.lds + PARG_OFF + 256))[0] = __builtin_amdgcn_s_memrealtime(); }
#define TSUB_END(k) if (MK_TSUB == (k)) { __syncthreads(); if (threadIdx.x == 0) ((LAS unsigned long long*)(F.lds + PARG_OFF + 256))[1] = __builtin_amdgcn_s_memrealtime(); }
#endif
__device__ __forceinline__ int map_win(int n) {
    if (n < 512) { const int hq = n >> 6, d = n & 63; return 256 * (hq >> 2) + (d >> 5) * 128 + 32 * (hq & 3) + (d & 31); }
    if (n < 768) { const int j = n - 512, hh = j >> 6, d = j & 63; return 512 + (d >> 5) * 128 + 32 * hh + (d & 31); }
    if (n < 1792) { const int j = n - 768; const int c = j & 511; return 768 + 8 * (c >> 2) + (j >= 512 ? 4 : 0) + (c & 3); }
    return n;
}
__device__ __forceinline__ int map_row(int mode, int n) {
    if (mode == 1) return map_win(n);
    if (mode == 2) return 8 * (n >> 2) + (n & 3);
    if (mode == 3) return 8 * (n >> 2) + 4 + (n & 3);
    return n;
}
constexpr int TSCR = 64 * 65 * 4;
constexpr int GATE_NB0 = 2304 / 64; constexpr float GATE_WSCALE = -1.4426950408889634f;
struct CvItem { const float* W; bf16* WT; int N, ldt, mode, k0, n0; float sc; };
__device__ __forceinline__ void cv_load(const CvItem& c, int lane, float (&v)[64]) {
    const GAS float* src = (const GAS float*)c.W + (size_t)c.k0 * c.N + c.n0 + lane;
#pragma unroll
    for (int k = 0; k < 64; ++k) v[k] = src[(size_t)k * c.N];
}
constexpr int CVST = 144;
__device__ __forceinline__ void cv_store(const CvItem& c, int lane, const float (&v)[64], LAS unsigned char* scr) {
#pragma unroll
    for (int j = 0; j < 8; ++j) { const float sc = c.sc; v4u o; o.x = pg8::cvt_pk_bf16(v[8 * j] * sc, v[8 * j + 1] * sc); o.y = pg8::cvt_pk_bf16(v[8 * j + 2] * sc, v[8 * j + 3] * sc); o.z = pg8::cvt_pk_bf16(v[8 * j + 4] * sc, v[8 * j + 5] * sc); o.w = pg8::cvt_pk_bf16(v[8 * j + 6] * sc, v[8 * j + 7] * sc);
        *(LAS v4u*)(scr + lane * CVST + 16 * j) = o; }
    LDS_WAIT(); asm volatile("" ::: "memory");
    const int cc = lane & 7, nn = lane >> 3;
#pragma unroll
    for (int j = 0; j < 8; ++j) { const int n = nn + 8 * j; const v4u o = *(const LAS v4u*)(scr + n * CVST + 16 * cc);
        *(GAS v4u*)(c.WT + (size_t)map_row(c.mode, c.n0 + n) * c.ldt + c.k0 + 8 * cc) = o; }
    LDS_WAIT(); asm volatile("" ::: "memory");
}
template <class R>
__device__ __forceinline__ void cv_run(const R& resolve, int first, int step, int n, int lane, LAS unsigned char* scr) {
    if (first >= n) return;
    float va[64], vb[64]; int it = first;
    CvItem ca = resolve(it), cb = ca; cv_load(ca, lane, va);
    for (;;) {
        int nx = it + step; const bool hb = nx < n; if (hb) { cb = resolve(nx); cv_load(cb, lane, vb); }
        cv_store(ca, lane, va, scr); if (!hb) break; it = nx;
        nx = it + step; const bool ha = nx < n; if (ha) { ca = resolve(nx); cv_load(ca, lane, va); }
        cv_store(cb, lane, vb, scr); if (!ha) break; it = nx;
    }
}
constexpr int IA_WIN = 16 * 84, IA_KV = 16 * 16, NITEMS_A = IA_WIN + IA_KV;
constexpr int IB_WO = 8 * 16, IB_OUT = 16 * 16, IB_GU = 16 * 16 * 8, IB_DN = 16 * 8 * 16, NITEMS_B = 3 * IB_WO + IB_OUT + 2 * IB_GU, NITEMS_B2 = IB_DN;
__device__ __forceinline__ CvItem cv_item_a(Frame& F, unsigned char* ws, int r) {
    if (r < IA_WIN) return CvItem{F.in(4), (bf16*)(ws + WS_W1), INW, 1024, 1, 64 * (r / 84), 64 * (r % 84), (r % 84) >= GATE_NB0 ? GATE_WSCALE : 1.f};
    r -= IA_WIN; return CvItem{F.in(15), (bf16*)(ws + WS_WKV), 1024, 1024, 0, 64 * (r / 16), 64 * (r % 16), 1.f};
}
__device__ __forceinline__ CvItem cv_item_b(Frame& F, unsigned char* ws, int r) {
    if (r < 3 * IB_WO) { const int b = r / IB_WO, q = r % IB_WO; const float* W = b == 0 ? F.in(8) : (b == 1 ? F.in(13) : F.in(18));
        return CvItem{W, (bf16*)(ws + WS_WO3) + (size_t)b * 1024 * 512, 1024, 512, 0, 64 * (q / 16), 64 * (q % 16), 1.f}; } r -= 3 * IB_WO;
    if (r < IB_OUT) return CvItem{F.in(19), (bf16*)(ws + WS_WOUT), 1024, 1024, 0, 64 * (r / 16), 64 * (r % 16), 1.f}; r -= IB_OUT;
    const int up = r / IB_GU, q = r % IB_GU, e = q / 128, qq = q % 128; const float* W = (up ? F.in(26) : F.in(25)) + (size_t)e * 1024 * 512;
    return CvItem{W, (bf16*)(ws + WS_WGU) + (size_t)e * 1024 * 1024, 512, 1024, 2 + up, 64 * (qq / 8), 64 * (qq % 8), 1.f};
}
__device__ __forceinline__ CvItem cv_item_b2(Frame& F, unsigned char* ws, int r) {
    const int e = r / 128, qq = r % 128; return CvItem{F.in(27) + (size_t)e * 512 * 1024, (bf16*)(ws + WS_WDT) + (size_t)e * 1024 * 512, 1024, 512, 0, 64 * (qq / 16), 64 * (qq % 16), 1.f};
}
__device__ __forceinline__ void p0_transpose_item(const float* W, int N, bf16* WT, int ldt, int mode, LAS float* scr, int kb, int nb, int lane, float sc = 1.f) {
    const int k0 = 64 * kb, n0 = 64 * nb, kk = lane >> 4, nq = lane & 15;
    const GAS f32x4* src = (const GAS f32x4*)(W + (size_t)(k0 + kk) * N + n0 + 4 * nq);
#pragma unroll 8
    for (int i = 0; i < 16; ++i) { const f32x4 v = src[(size_t)i * N]; LAS float* d = scr + (4 * i + kk) * 65 + 4 * nq; d[0] = v[0]; d[1] = v[1]; d[2] = v[2]; d[3] = v[3]; }
    LDS_WAIT(); asm volatile("" ::: "memory");
    const int c = lane & 7, nn = lane >> 3;
#pragma unroll
    for (int j = 0; j < 8; ++j) { const int n = nn + 8 * j; const LAS float* s = scr + (8 * c) * 65 + n;
        v4u o; o.x = pk2(s[0 * 65] * sc, s[1 * 65] * sc); o.y = pk2(s[2 * 65] * sc, s[3 * 65] * sc); o.z = pk2(s[4 * 65] * sc, s[5 * 65] * sc); o.w = pk2(s[6 * 65] * sc, s[7 * 65] * sc);
        *(GAS v4u*)(WT + (size_t)map_row(mode, n0 + n) * ldt + k0 + 8 * c) = o; }
    LDS_WAIT(); asm volatile("" ::: "memory");
}
__device__ __forceinline__ void convert_item_a(Frame& F, unsigned char* ws, LAS float* scr, int r, int lane) {
    if (r < IA_WIN) { p0_transpose_item(F.in(4), INW, (bf16*)(ws + WS_W1), 1024, 1, scr, r / 84, r % 84, lane, (r % 84) >= GATE_NB0 ? GATE_WSCALE : 1.f); return; } r -= IA_WIN;
    p0_transpose_item(F.in(15), 1024, (bf16*)(ws + WS_WKV), 1024, 0, scr, r / 16, r % 16, lane);
}
__device__ __forceinline__ void convert_item_b2(Frame& F, unsigned char* ws, LAS float* scr, int r, int lane) {
    { const int e = r / 128, qq = r % 128; p0_transpose_item(F.in(27) + (size_t)e * 512 * 1024, 1024, (bf16*)(ws + WS_WDT) + (size_t)e * 1024 * 512, 512, 0, scr, qq / 16, qq % 16, lane); }
}
__device__ __forceinline__ void convert_b2_all(Frame& F) {
    const int tid_ = F.ftid(), lane_ = tid_ & 63; unsigned char* ws = F.ws();
    for (int it = F.vcu * NWAVES + F.wave; it < NITEMS_B2; it += F.G * NWAVES) convert_item_b2(F, ws, (LAS float*)(F.lds + RING_OFF + F.wave * TSCR), it, lane_);
    __syncthreads();
}
constexpr int P1_LONG = 72, CV_EARLY = 2816;
__device__ __forceinline__ void convert_b_tail(Frame& F, int when) {
    const int blk = (int)blockIdx.x, early = (blk >> 3) & 1;
    if (F.G <= P1_LONG || blk < P1_LONG) return;
    const int tid_ = F.ftid(), lane_ = tid_ & 63; unsigned char* ws = F.ws();
    if (F.G != 256) {
        if (when == 1) cv_run([&](int r) { return cv_item_b(F, ws, r); }, (blk - P1_LONG) * NWAVES + F.wave, (F.G - P1_LONG) * NWAVES, NITEMS_B, lane_, F.lds + RING_OFF + F.wave * TSCR);
        return; }
    if (early == when) return;
    const int rk = (((blk >> 3) - (early ? 9 : 10)) >> 1) * 8 + (blk & 7), ng = early ? 96 : 88, i0 = early ? 0 : CV_EARLY, i1 = early ? CV_EARLY : NITEMS_B;
    cv_run([&](int r) { return cv_item_b(F, ws, r); }, i0 + rk * NWAVES + F.wave, ng * NWAVES, i1, lane_, F.lds + RING_OFF + F.wave * TSCR);
}
template <int NR>
__device__ __forceinline__ void rms_rows_load(f32x4 (&v)[NR][4], int lane, const float* xrow, size_t stride) {
#pragma unroll
    for (int i = 0; i < NR; ++i) { const GAS f32x4* xr = (const GAS f32x4*)(xrow + i * stride) + lane;
#pragma unroll
        for (int j = 0; j < 4; ++j) v[i][j] = xr[64 * j]; }
}
template <int NR>
__device__ __forceinline__ void rms_rows_finish(const f32x4 (&v)[NR][4], int lane, size_t stride, const float* g, bf16* orow, float* rinv = nullptr, int rstride = 0) {
    float s[NR]; f32x4 gg[4];
#pragma unroll
    for (int j = 0; j < 4; ++j) gg[j] = *((const GAS f32x4*)g + lane + 64 * j);
#pragma unroll
    for (int i = 0; i < NR; ++i) { s[i] = 0.f;
#pragma unroll
        for (int j = 0; j < 4; ++j) s[i] += (v[i][j].x * v[i][j].x + v[i][j].y * v[i][j].y) + (v[i][j].z * v[i][j].z + v[i][j].w * v[i][j].w); }
#pragma unroll
    for (int i = 0; i < NR; ++i) s[i] = wave_sum(s[i]);
#pragma unroll
    for (int i = 0; i < NR; ++i) { const float r = rsqrtf(s[i] * (1.f / 1024.f) + 1e-6f); GAS unsigned long long* o8 = (GAS unsigned long long*)(orow + i * stride) + lane;
        if (rinv != nullptr && lane == 0) rinv[i * rstride] = 1.f / r;
#pragma unroll
        for (int j = 0; j < 4; ++j) o8[64 * j] = (unsigned long long)pg8::cvt_pk_bf16(v[i][j].x * r * gg[j].x, v[i][j].y * r * gg[j].y) | ((unsigned long long)pg8::cvt_pk_bf16(v[i][j].z * r * gg[j].z, v[i][j].w * r * gg[j].w) << 32); }
}
template <int NR>
__device__ __forceinline__ void rms_rows_to_bf16(int lane, const float* xrow, size_t stride, const float* g, bf16* orow) { f32x4 v[NR][4]; rms_rows_load<NR>(v, lane, xrow, stride); rms_rows_finish<NR>(v, lane, stride, g, orow); }
__device__ __forceinline__ void p0_rope(Frame& F, int gw, int NGW, int lane) {
    typedef const __attribute__((address_space(4))) int* cint_p;
    const unsigned long long pa = (unsigned long long)F.in(2);
    const cint_p pos = (cint_p)(((unsigned long long)(unsigned)__builtin_amdgcn_readfirstlane((int)(pa >> 32)) << 32) | (unsigned)__builtin_amdgcn_readfirstlane((int)pa));
    float2* cs = (float2*)(F.ws() + WS_CS);
    const int i = lane & 31; const float inv = 1.0f / powf(10000.f, (float)(2 * i) / 64.f);
    for (int p = gw; p < T / 2; p += NGW) { const int tb = __builtin_amdgcn_readfirstlane(2 * p); const int p0 = pos[tb], p1 = pos[tb + 1];
        const float ang = (float)(lane < 32 ? p0 : p1) * inv; float s, c; sincosf(ang, &s, &c); cs[(size_t)(tb + (lane >> 5)) * 32 + i] = make_float2(c, s); }
}
__device__ __forceinline__ void p0_prologue(Frame& F) {
    const int tid_ = F.ftid(), lane_ = tid_ & 63; (void)lane_;
    const int gw = F.vcu * NWAVES + F.wave, NGW = F.G * NWAVES;
    unsigned char* ws = F.ws();
    if (T == 8 * NGW) {
        f32x4 v[8][4]; rms_rows_load<8>(v, lane_, F.in(0) + (size_t)gw * D, (size_t)NGW * D);
        for (int it = gw; it < NITEMS_A; it += NGW) convert_item_a(F, ws, (LAS float*)(F.lds + RING_OFF + F.wave * TSCR), it, lane_);
        p0_rope(F, gw, NGW, lane_);
        rms_rows_finish<8>(v, lane_, (size_t)NGW * D, F.in(3), (bf16*)((unsigned char*)F.out() + DO_H) + (size_t)gw * D, (float*)(ws + WS_RINV) + gw, NGW);
    } else {
        cv_run([&](int r) { return cv_item_a(F, ws, r); }, gw, NGW, NITEMS_A, lane_, F.lds + RING_OFF + F.wave * TSCR);
        p0_rope(F, gw, NGW, lane_);
        for (int m = gw; m < T; m += NGW) { f32x4 v1[1][4]; rms_rows_load<1>(v1, lane_, F.in(0) + (size_t)m * D, 0); rms_rows_finish<1>(v1, lane_, 0, F.in(3), (bf16*)((unsigned char*)F.out() + DO_H) + (size_t)m * D, (float*)(ws + WS_RINV) + m, 0); }
    }
    for (int m = gw; m < 512; m += NGW) rms_rows_to_bf16<1>(lane_, F.in(1) + (size_t)m * D, 0, F.in(14), (bf16*)(ws + WS_MEMN) + (size_t)m * D);
    {
        const float* g2 = F.in(20); const float* wg = F.in(21); const float* wrt = F.in(23); bf16* WR = (bf16*)(ws + WS_ROUTE + 2 * MiB);
        const int gt = F.vcu * 512 + tid_, NT_ = F.G * 512;
        for (int id = gt; id < 4 * 32 * 256; id += NT_) { const int pn = id >> 13, n = (id >> 8) & 31, s = id & 255, gidx = s >> 5, kg = (s >> 3) & 3, j = s & 7;
            const int col = 256 * pn + 128 * (gidx >> 2) + 32 * (gidx & 3) + (j < 4 ? 4 * kg + j : 16 + 4 * kg + j - 4); float w = 0.f;
            if (n < 20) w = g2[col] * (n < 4 ? wg[col * 4 + n] : wrt[col * 16 + (n - 4)]);
            const unsigned hi = f2bf(w), lo = f2bf(w - __uint_as_float(hi << 16));
            WR[(size_t)((pn * 2 + 0) * 32 + n) * 256 + s] = (bf16)hi; WR[(size_t)((pn * 2 + 1) * 32 + n) * 256 + s] = (bf16)lo; }
    }
}

struct SchedP1 {
    __device__ __forceinline__ void a_ready(const pg8::Unit&) const {}
    int G, c; const char* Ah; const char* W1; const char* Amem; const char* Wkv;
    __device__ __forceinline__ bool next(int i, pg8::Unit& u) const {
        const int L = i * G + c; u.ksplit = 1 << 30; u.ridx = nullptr;
        if (L < 64 * 21) { int pm, pn; pg8::static_tile(L, 64, 21, pm, pn); u.pm = pm; u.pn = pn; u.aux = 0; u.A = Ah + (size_t)pm * 256 * 2048; u.B0 = W1 + (size_t)pn * 256 * 2048; u.B1 = u.B0; return true; }
        const int j = L - 64 * 21; if (j >= 8) return false;
        u.pm = j & 1; u.pn = j >> 1; u.aux = 1; u.A = Amem + (size_t)u.pm * 256 * 2048; u.B0 = Wkv + (size_t)u.pn * 256 * 2048; u.B1 = u.B0; return true;
    }
};
__device__ __forceinline__ v4u pack8(const f32x4 a, const f32x4 b) { v4u w; w.x = pg8::cvt_pk_bf16(a[0], a[1]); w.y = pg8::cvt_pk_bf16(a[2], a[3]); w.z = pg8::cvt_pk_bf16(b[0], b[1]); w.w = pg8::cvt_pk_bf16(b[2], b[3]); return w; }
struct EpiP1 {
    static constexpr bool PERM = true, AFTER_DRAIN = false, PREFETCH = false, KEEP = false;
    bf16 *q, *k, *v, *u, *xq, *gates, *mkv; const float2* cs; const float *gq, *gk;
    __device__ __forceinline__ void qk_rope(const f32x4 (&acc)[2][2][4][2], int row0, bf16* dst, int ld, int head, const float* g, int fq) const {
        f32x4 g1[2], g2[2];
#pragma unroll
        for (int n = 0; n < 2; ++n) { g1[n] = *(const f32x4*)(g + 8 * fq + 4 * n); g2[n] = *(const f32x4*)(g + 32 + 8 * fq + 4 * n); }
#pragma unroll
        for (int ai = 0; ai < 2; ++ai)
#pragma unroll
            for (int m = 0; m < 4; ++m) {
                const int row = row0 + ai * 128 + m * 16;
                float ss = 0.f;
#pragma unroll
                for (int bj = 0; bj < 2; ++bj)
#pragma unroll
                    for (int n = 0; n < 2; ++n) { const f32x4 x = acc[ai][bj][m][n]; ss += (x[0] * x[0] + x[1] * x[1]) + (x[2] * x[2] + x[3] * x[3]); }
                ss += shx(ss, 16); ss += shx(ss, 32);
                const float r = rsqrtf(ss * (1.f / 64.f) + 1e-6f);
                const f32x4* cp = (const f32x4*)(cs + (size_t)row * 32 + 8 * fq);
                f32x4 o1[2], o2[2];
#pragma unroll
                for (int n = 0; n < 2; ++n) { const f32x4 ca = cp[2 * n], cb = cp[2 * n + 1];
                    const f32x4 y1 = acc[ai][0][m][n] * r * g1[n], y2 = acc[ai][1][m][n] * r * g2[n];
                    o1[n] = (f32x4){y1[0] * ca[0] - y2[0] * ca[1], y1[1] * ca[2] - y2[1] * ca[3], y1[2] * cb[0] - y2[2] * cb[1], y1[3] * cb[2] - y2[3] * cb[3]};
                    o2[n] = (f32x4){y2[0] * ca[0] + y1[0] * ca[1], y2[1] * ca[2] + y1[1] * ca[3], y2[2] * cb[0] + y1[2] * cb[1], y2[3] * cb[2] + y1[3] * cb[3]}; }
                bf16* p = dst + (size_t)row * ld + head * 64 + 8 * fq;
                *(v4u*)p = pack8(o1[0], o1[1]); *(v4u*)(p + 32) = pack8(o2[0], o2[1]);
            }
    }
    __device__ __forceinline__ bool operator()(f32x4 (&acc)[2][2][4][2], const pg8::Unit& un, int wr, int wc, int fr, int fq) const {
        const int row0 = un.pm * 256 + wr * 64 + fr;
        if (un.aux == 1) {
#pragma unroll
            for (int ai = 0; ai < 2; ++ai)
#pragma unroll
                for (int m = 0; m < 4; ++m)
#pragma unroll
                    for (int bj = 0; bj < 2; ++bj) *(v4u*)(mkv + (size_t)(row0 + ai * 128 + m * 16) * 1024 + un.pn * 256 + bj * 128 + wc * 32 + 8 * fq) = pack8(acc[ai][bj][m][0], acc[ai][bj][m][1]);
            return true;
        }
        const int pn = un.pn;
        if (pn < 2) { qk_rope(acc, row0, q, 512, 4 * pn + wc, gq, fq); return true; }
        if (pn == 2) {
            if (wc < 2) { qk_rope(acc, row0, k, 128, wc, gk, fq); return true; }
#pragma unroll
            for (int ai = 0; ai < 2; ++ai)
#pragma unroll
                for (int m = 0; m < 4; ++m)
#pragma unroll
                    for (int bj = 0; bj < 2; ++bj) *(v4u*)(v + (size_t)(row0 + ai * 128 + m * 16) * 128 + (wc - 2) * 64 + bj * 32 + 8 * fq) = pack8(acc[ai][bj][m][0], acc[ai][bj][m][1]);
            return true;
        }
        if (pn < 7) {
#pragma unroll
            for (int ai = 0; ai < 2; ++ai)
#pragma unroll
                for (int m = 0; m < 4; ++m)
                    { v2u w[2];
                      float sg[8];
#pragma unroll
                      for (int k = 0; k < 8; ++k) sg[k] = acc[ai][k >> 2][m][1][k & 3];
                      sigmoid_n<8>(sg);
#pragma unroll
                      for (int bj = 0; bj < 2; ++bj) { const f32x4 av = acc[ai][bj][m][0];
                          w[bj].x = pg8::cvt_pk_bf16(av[0] * sg[4 * bj], av[1] * sg[4 * bj + 1]); w[bj].y = pg8::cvt_pk_bf16(av[2] * sg[4 * bj + 2], av[3] * sg[4 * bj + 3]); }
                      const auto sx = __builtin_amdgcn_permlane16_swap(w[0].x, w[1].x, false, false), sy = __builtin_amdgcn_permlane16_swap(w[0].y, w[1].y, false, false);
                      v4u o; o.x = sx[0]; o.y = sy[0]; o.z = sx[1]; o.w = sy[1];
                      *(v4u*)(u + (size_t)(row0 + ai * 128 + m * 16) * 512 + 128 * (pn - 3) + 64 * (fq & 1) + 16 * wc + 4 * (fq & ~1)) = o; }
            return true;
        }
        if (pn < 9) {
#pragma unroll
            for (int ai = 0; ai < 2; ++ai)
#pragma unroll
                for (int m = 0; m < 4; ++m)
#pragma unroll
                    for (int bj = 0; bj < 2; ++bj) *(v4u*)(xq + (size_t)(row0 + ai * 128 + m * 16) * 512 + (pn - 7) * 256 + bj * 128 + wc * 32 + 8 * fq) = pack8(acc[ai][bj][m][0], acc[ai][bj][m][1]);
            return true;
        }
        unsigned char* g8 = (unsigned char*)gates;
#pragma unroll
        for (int ai = 0; ai < 2; ++ai)
#pragma unroll
            for (int m = 0; m < 4; ++m)
                { v2u w[2];
                  float gq[16];
#pragma unroll
                  for (int k = 0; k < 16; ++k) gq[k] = __builtin_amdgcn_exp2f(acc[ai][k >> 3][m][(k >> 2) & 1][k & 3]);
                  __builtin_amdgcn_sched_barrier(0);
#pragma unroll
                  for (int k = 0; k < 16; ++k) gq[k] = __builtin_amdgcn_rcpf(__builtin_fmaf(gq[k], 1.f / 255.f, 1.f / 255.f));
                  __builtin_amdgcn_sched_barrier(0);
#pragma unroll
                  for (int bj = 0; bj < 2; ++bj) { w[bj].x = 0u; w[bj].y = 0u;
#pragma unroll
                    for (int e = 0; e < 4; ++e) { w[bj].x = __builtin_amdgcn_cvt_pk_u8_f32(fmaxf(gq[8 * bj + e], 1.f), e, w[bj].x); w[bj].y = __builtin_amdgcn_cvt_pk_u8_f32(fmaxf(gq[8 * bj + 4 + e], 1.f), e, w[bj].y); } }
                  const auto sx = __builtin_amdgcn_permlane16_swap(w[0].x, w[1].x, false, false), sy = __builtin_amdgcn_permlane16_swap(w[0].y, w[1].y, false, false);
                  v4u o; o.x = sx[0]; o.y = sy[0]; o.z = sx[1]; o.w = sy[1];
                  *(v4u*)(g8 + (size_t)(row0 + ai * 128 + m * 16) * 3072 + (pn - 9) * 256 + (fq & 1) * 128 + wc * 32 + 8 * (fq & ~1)) = o; }
        return true;
    }
};

struct SchedP3 {
    __device__ __forceinline__ void a_ready(const pg8::Unit&) const {}
    int G, c; const char* acts; const char* Wo3;
    __device__ __forceinline__ bool next(int i, pg8::Unit& u) const {
        const int j = i / 3, b = i - 3 * j; const int L = j * G + c; int pm, pn;
        if (!pg8::static_tile(L, 64, 4, pm, pn)) return false;
        u.pm = pm; u.pn = pn; u.aux = b; u.ksplit = 1 << 30; u.ridx = nullptr;
        u.A = acts + (size_t)pm * 256 * 3072 + (size_t)b * 1024; u.B0 = Wo3 + (size_t)b * (1024 * 1024) + (size_t)pn * 256 * 1024; u.B1 = u.B0; return true;
    }
};
struct EpiP3 {
    static constexpr bool PERM = true, AFTER_DRAIN = false, PREFETCH = false, KEEP = true;
    const unsigned char* gates; bf16* merged;
    __device__ __forceinline__ void prefetch(const pg8::Unit&, LAS unsigned char*, int) const {}
    static __device__ __forceinline__ f32x4 ub4(unsigned w) { return (f32x4){(float)(w & 255u), (float)((w >> 8) & 255u), (float)((w >> 16) & 255u), (float)(w >> 24)}; }
    __device__ __forceinline__ bool operator()(f32x4 (&acc)[2][2][4][2], const pg8::Unit& un, int wr, int wc, int fr, int fq, pg8::u32x2 (&keep)[8][2]) const {
        const int b = un.aux; const bool fin = b == 2, first = b == 0;
        const __amdgpu_buffer_rsrc_t rg = __builtin_amdgcn_make_buffer_rsrc((void*)gates, 0, 0x7fffffff, 0x00020000);
        const int vg = fin ? 0 : fr * 3072 + 8 * fq, sg = fin ? 0 : (un.pm * 256 + wr * 64) * 3072 + (b + 1) * 1024 + un.pn * 256 + wc * 32, da = first ? -1024 : 0, rs = fin ? 0 : 3072;
        v2u ga[2][2], gb[2][2];
#define EPI3_LD(g) do { const int so_ = sg + ((g >> 2) * 128 + (g & 3) * 16) * rs; _Pragma("unroll") for (int bj = 0; bj < 2; ++bj) { const int sb_ = fin ? 0 : so_ + bj * 128; \
            gb[(g) & 1][bj] = __builtin_amdgcn_raw_buffer_load_b64(rg, vg, sb_, 0); ga[(g) & 1][bj] = __builtin_amdgcn_raw_buffer_load_b64(rg, vg, sb_ + da, 0); } } while (0)
        EPI3_LD(0);
#pragma unroll
        for (int g = 0; g < 8; ++g) {
            if (g + 1 < 8) EPI3_LD(g + 1);
#pragma unroll
            for (int bj = 0; bj < 2; ++bj) {
                const v2u num = first ? ga[g & 1][bj] : keep[g][bj]; keep[g][bj] = gb[g & 1][bj];
                const unsigned dx = fin ? 0xffffffffu : gb[g & 1][bj].x, dy = fin ? 0xffffffffu : gb[g & 1][bj].y;
                f32x4 s0 = ub4(num.x), s1 = ub4(num.y); const f32x4 d0 = ub4(dx), d1 = ub4(dy);
#pragma unroll
                for (int e = 0; e < 4; ++e) { s0[e] *= __builtin_amdgcn_rcpf(d0[e]); s1[e] *= __builtin_amdgcn_rcpf(d1[e]); }
                acc[g >> 2][bj][g & 3][0] *= s0; acc[g >> 2][bj][g & 3][1] *= s1; }
            __builtin_amdgcn_sched_barrier(0); }
#undef EPI3_LD
        if (fin) {
            const __amdgpu_buffer_rsrc_t rm = __builtin_amdgcn_make_buffer_rsrc((void*)merged, 0, 0x7fffffff, 0x00020000);
            const int vm = fr * 2048 + 16 * fq, sm = (un.pm * 256 + wr * 64) * 2048 + (un.pn * 256 + wc * 32) * 2;
#pragma unroll
            for (int ai = 0; ai < 2; ++ai)
#pragma unroll
                for (int m = 0; m < 4; ++m)
#pragma unroll
                    for (int bj = 0; bj < 2; ++bj)
                        __builtin_amdgcn_raw_buffer_store_b128(pack8(acc[ai][bj][m][0], acc[ai][bj][m][1]), rm, vm, sm + (ai * 128 + m * 16) * 2048 + bj * 256, 0);
        }
        return fin;
    }
};

struct SchedP4 {
    __device__ __forceinline__ void a_ready(const pg8::Unit&) const {}
    int G, c; const char* A; const char* W;
    __device__ __forceinline__ bool next(int i, pg8::Unit& u) const {
        const int L = i * G + c; int pm, pn; if (!pg8::static_tile(L, 64, 4, pm, pn)) return false;
        u.pm = pm; u.pn = pn; u.aux = 0; u.ksplit = 1 << 30; u.ridx = nullptr; u.A = A + (size_t)pm * 256 * 2048; u.B0 = W + (size_t)pn * 256 * 2048; u.B1 = u.B0; return true;
    }
};
struct EpiP4 {
    static constexpr bool PERM = false, AFTER_DRAIN = false, PREFETCH = false, KEEP = false;
    const float* x; float* out;
    __device__ __forceinline__ bool operator()(f32x4 (&acc)[2][2][4][2], const pg8::Unit& un, int wr, int wc, int fr, int fq) const {
        const int row0 = un.pm * 256 + wr * 64 + fr, col0 = un.pn * 256 + wc * 32 + 4 * fq;
#pragma unroll
        for (int ai = 0; ai < 2; ++ai)
#pragma unroll
            for (int m = 0; m < 4; ++m) { const size_t off = (size_t)(row0 + ai * 128 + m * 16) * 1024 + col0;
#pragma unroll
                for (int bj = 0; bj < 2; ++bj)
#pragma unroll
                    for (int n = 0; n < 2; ++n) *(f32x4*)(out + off + bj * 128 + n * 16) = *(const f32x4*)(x + off + bj * 128 + n * 16) + acc[ai][bj][m][n]; }
        return true;
    }
};
constexpr size_t RT_TOKC = 0, RT_SWT = 1536 * 1024;
constexpr int CW_CCNT = 1024, CCNT_STRIDE = 64;
constexpr int TB_TOTAL = TAB_OFF, TB_TAB = TAB_OFF + 256;
constexpr int TB_ORD = TAB_OFF + 768, TB_AUX = TAB_OFF + 1536;
typedef float f32x2v __attribute__((ext_vector_type(2)));
constexpr int WST = 2064;
__device__ __forceinline__ void route_token(const LAS float* lg, const float* bg, const float* br, int& cls, float& wa, float& wb) {
    float l0 = lg[0] + bg[0], l1 = lg[1] + bg[1], l2 = lg[2] + bg[2], l3 = lg[3] + bg[3];
    int gi = 0; float gm = l0;
    if (l1 > gm) { gm = l1; gi = 1; } if (l2 > gm) { gm = l2; gi = 2; } if (l3 > gm) { gm = l3; gi = 3; }
    const float pg = 1.f / (__expf(l0 - gm) + __expf(l1 - gm) + __expf(l2 - gm) + __expf(l3 - gm));
    const float e0 = lg[4 + gi * 4 + 0] + br[gi * 4 + 0], e1 = lg[4 + gi * 4 + 1] + br[gi * 4 + 1], e2 = lg[4 + gi * 4 + 2] + br[gi * 4 + 2], e3 = lg[4 + gi * 4 + 3] + br[gi * 4 + 3];
    int i1 = 0; float v1 = e0;
    if (e1 > v1) { v1 = e1; i1 = 1; } if (e2 > v1) { v1 = e2; i1 = 2; } if (e3 > v1) { v1 = e3; i1 = 3; }
    int i2 = -1; float v2 = -3.0e38f;
    if (i1 != 0 && e0 > v2) { v2 = e0; i2 = 0; } if (i1 != 1 && e1 > v2) { v2 = e1; i2 = 1; } if (i1 != 2 && e2 > v2) { v2 = e2; i2 = 2; } if (i1 != 3 && e3 > v2) { v2 = e3; i2 = 3; }
    const float q2 = __expf(v2 - v1), p1 = 1.f / (1.f + q2), p2 = q2 * p1;
    const int a = i1 < i2 ? i1 : i2, b = i1 < i2 ? i2 : i1;
    wa = pg * (i1 < i2 ? p1 : p2); wb = pg * (i1 < i2 ? p2 : p1);
    cls = gi * 6 + (a * (7 - a)) / 2 + (b - a - 1);
}
constexpr size_t WS_WRT = WS_ROUTE + 2 * MiB;
constexpr size_t DO_PART = DO_Q;
constexpr int CW_PCNT = 2600, CW_WDT = 2700;
#ifndef MK_GT
#define MK_GT -1
#endif
#define P4_TMARK(cat) do { if (MK_GT >= 0) { if (tid == 0) { LAS unsigned long long* ts_ = (LAS unsigned long long*)(lds - RING_OFF + PARG_OFF + 256); if (ts_[2]) { const unsigned long long t_ = __builtin_amdgcn_s_memrealtime(); ts_[4 + (cat)] += t_ - ts_[3]; ts_[3] = t_; } } } } while (0)
constexpr int WR_LST = 528;
struct EpiP4F {
    static constexpr bool PERM = false, AFTER_DRAIN = true, PREFETCH = false, KEEP = false;
    __device__ __forceinline__ void prefetch(const pg8::Unit&, LAS unsigned char*, int) const {}
    const bf16* h; const float* rinv; bf16* h2; const float* g2; const bf16* WR; float* gpart; unsigned* ctl; const float* bg; const float* br; int* rtokc; f32x4* swt; const float* g1;
    __device__ __forceinline__ bool operator()(f32x4 (&)[2][2][4][2], const pg8::Unit&, int, int, int, int) const { return true; }
    __device__ __forceinline__ void fused(f32x4 (&acc)[2][2][4][2], const pg8::Unit& un, int wr, int wc, int fr, int fq, LAS unsigned char* lds, int wid, int lane) const {
        const int tid = wid * 64 + lane;
        const int row0 = un.pm * 256 + wr * 64 + fr, col0 = un.pn * 256 + wc * 32 + 4 * fq;
        {
          const __amdgpu_buffer_rsrc_t rx = __builtin_amdgcn_make_buffer_rsrc((void*)h, 0, 0x7fffffff, 0x00020000), rh = __builtin_amdgcn_make_buffer_rsrc((void*)h2, 0, 0x7fffffff, 0x00020000);
          const int vh = fr * 2048 + (wc * 32 + 4 * fq) * 2, sh = ((un.pm * 256 + wr * 64) * 1024 + un.pn * 256) * 2; const int vh2 = fr * 2048 + (wc * 32 + 16 * (fq & 1) + 4 * (fq & ~1)) * 2;
          v2u xb[4][2][2];
#define EPI4_LD(g) do { _Pragma("unroll") for (int bj = 0; bj < 2; ++bj) _Pragma("unroll") for (int n = 0; n < 2; ++n) \
              xb[(g) & 3][bj][n] = __builtin_amdgcn_raw_buffer_load_b64(rx, vh + bj * 256 + n * 32, sh + (((g) >> 2) * 128 + ((g) & 3) * 16) * 2048, 0); } while (0)
          EPI4_LD(0); EPI4_LD(1); EPI4_LD(2); EPI4_LD(3);
          v4u wt[4]; const v4u* src = (const v4u*)(WR + (size_t)un.pn * (2 * 32 * 256));
#pragma unroll
          for (int i = 0; i < 4; ++i) wt[i] = src[tid + 512 * i];
          f32x4 g2v[2][2], gi1[2][2]; float ri[8];
#pragma unroll
          for (int bj = 0; bj < 2; ++bj)
#pragma unroll
              for (int n = 0; n < 2; ++n) { g2v[bj][n] = *(const f32x4*)(g2 + col0 + bj * 128 + n * 16); gi1[bj][n] = *(const f32x4*)(g1 + col0 + bj * 128 + n * 16); }
#pragma unroll
          for (int g = 0; g < 8; ++g) ri[g] = rinv[row0 + (g >> 2) * 128 + (g & 3) * 16];
          __builtin_amdgcn_sched_barrier(0);
#pragma unroll
          for (int i = 0; i < 4; ++i) { const int L = tid + 512 * i; *(LAS v4u*)(lds + (L >> 5) * WR_LST + (L & 31) * 16) = wt[i]; }
#pragma unroll
          for (int bj = 0; bj < 2; ++bj)
#pragma unroll
              for (int n = 0; n < 2; ++n) { const f32x4 g = gi1[bj][n]; gi1[bj][n] = (f32x4){__builtin_amdgcn_rcpf(g[0]), __builtin_amdgcn_rcpf(g[1]), __builtin_amdgcn_rcpf(g[2]), __builtin_amdgcn_rcpf(g[3])}; }
#pragma unroll
          for (int g = 0; g < 8; ++g) { const int ai = g >> 2, m = g & 3;
#pragma unroll
              for (int bj = 0; bj < 2; ++bj) { v2u w[2];
#pragma unroll
                  for (int n = 0; n < 2; ++n) { const v2u hx = xb[g & 3][bj][n];
                      const f32x4 v = (f32x4){bflo(hx.x), bfhi(hx.x), bflo(hx.y), bfhi(hx.y)} * gi1[bj][n] * ri[g] + acc[ai][bj][m][n]; acc[ai][bj][m][n] = v;
                      const f32x4 hv = v * g2v[bj][n];
                      w[n].x = pg8::cvt_pk_bf16(hv[0], hv[1]); w[n].y = pg8::cvt_pk_bf16(hv[2], hv[3]); }
                  const auto sx = __builtin_amdgcn_permlane16_swap(w[0].x, w[1].x, false, false), sy = __builtin_amdgcn_permlane16_swap(w[0].y, w[1].y, false, false);
                  v4u o; o.x = sx[0]; o.y = sy[0]; o.z = sx[1]; o.w = sy[1];
                  __builtin_amdgcn_raw_buffer_store_b128(o, rh, vh2 + bj * 256, sh + (ai * 128 + m * 16) * 2048, 0); }
              if (g + 4 < 8) EPI4_LD(g + 4);
              __builtin_amdgcn_sched_barrier(0); }
#undef EPI4_LD
        }
        __syncthreads(); P4_TMARK(8);
        LAS float* P = (LAS float*)(lds + 36864);
#pragma unroll
        for (int ai = 0; ai < 2; ++ai)
#pragma unroll
            for (int m = 0; m < 4; ++m) { float ss = 0.f; f32x4 l0 = (f32x4){0.f, 0.f, 0.f, 0.f}, l1 = l0;
#pragma unroll
                for (int bj = 0; bj < 2; ++bj) { const f32x4 v0 = acc[ai][bj][m][0], v1 = acc[ai][bj][m][1];
                    ss += (v0[0] * v0[0] + v0[1] * v0[1]) + (v0[2] * v0[2] + v0[3] * v0[3]) + (v1[0] * v1[0] + v1[1] * v1[1]) + (v1[2] * v1[2] + v1[3] * v1[3]);
                    const v4u hi = pack8(v0, v1);
                    const v4u lo = pack8(v0 - (f32x4){bflo(hi.x), bfhi(hi.x), bflo(hi.y), bfhi(hi.y)}, v1 - (f32x4){bflo(hi.z), bfhi(hi.z), bflo(hi.w), bfhi(hi.w)});
                    const bf16x8 Bh = __builtin_bit_cast(bf16x8, hi), Bl = __builtin_bit_cast(bf16x8, lo);
                    const LAS unsigned char* wp = lds + fr * WR_LST + (bj * 4 + wc) * 64 + fq * 16;
                    const bf16x8 Ah0 = *(const LAS bf16x8*)wp, Ah1 = *(const LAS bf16x8*)(wp + 16 * WR_LST), Al0 = *(const LAS bf16x8*)(wp + 32 * WR_LST), Al1 = *(const LAS bf16x8*)(wp + 48 * WR_LST);
                    l0 = __builtin_amdgcn_mfma_f32_16x16x32_bf16(Ah0, Bh, l0, 0, 0, 0); l0 = __builtin_amdgcn_mfma_f32_16x16x32_bf16(Ah0, Bl, l0, 0, 0, 0); l0 = __builtin_amdgcn_mfma_f32_16x16x32_bf16(Al0, Bh, l0, 0, 0, 0);
                    l1 = __builtin_amdgcn_mfma_f32_16x16x32_bf16(Ah1, Bh, l1, 0, 0, 0); l1 = __builtin_amdgcn_mfma_f32_16x16x32_bf16(Ah1, Bl, l1, 0, 0, 0); l1 = __builtin_amdgcn_mfma_f32_16x16x32_bf16(Al1, Bh, l1, 0, 0, 0); }
                ss += shx(ss, 16); ss += shx(ss, 32);
                LAS float* pr = P + (ai * 128 + wr * 64 + m * 16 + fr) * 100 + wc * 24;
                *(LAS f32x4*)(pr + 4 * fq) = l0;
                if (fq == 0) *(LAS f32x4*)(pr + 16) = l1;
                if (fq == 1) *(LAS f32x4*)(pr + 20) = (f32x4){ss, 0.f, 0.f, 0.f}; }
        __syncthreads(); P4_TMARK(9);
        float* gp = gpart + (size_t)(un.pm * 4 + un.pn) * (256 * 24);
        const __amdgpu_buffer_rsrc_t rgp = __builtin_amdgcn_make_buffer_rsrc((void*)gp, 0, 256 * 24 * 4, 0x00020000);
        { const int row = tid >> 1, half = tid & 1;
#pragma unroll
          for (int q = 0; q < 3; ++q) { const LAS float* pr = P + row * 100 + half * 12 + 4 * q;
              const f32x4 s = ((*(const LAS f32x4*)pr + *(const LAS f32x4*)(pr + 24)) + *(const LAS f32x4*)(pr + 48)) + *(const LAS f32x4*)(pr + 72);
              __builtin_amdgcn_raw_buffer_store_b128(__builtin_bit_cast(v4u, s), rgp, (row * 24 + half * 12 + 4 * q) * 4, 0, 16); } }
        asm volatile("s_waitcnt vmcnt(0)" ::: "memory");
        __syncthreads(); P4_TMARK(10);
        if (tid == 0) {
            const unsigned old = __hip_atomic_fetch_add(ctl + CW_PCNT + un.pm, 1u, __ATOMIC_RELAXED, __HIP_MEMORY_SCOPE_AGENT);
            if (old == 3u) { __builtin_amdgcn_fence(__ATOMIC_ACQUIRE, "agent"); asm volatile("s_waitcnt vmcnt(0)" ::: "memory"); }
            *(LAS unsigned*)lds = old; }
        __syncthreads();
        const unsigned old = (unsigned)__builtin_amdgcn_readfirstlane((int)*(const LAS unsigned*)lds);
        __syncthreads(); P4_TMARK(11);
        if (old == 3u) {
            LAS int* hist = (LAS int*)(lds + 512); LAS int* cbase = (LAS int*)(lds + 768);
            if (tid < 32) hist[tid] = 0;
            __syncthreads();
            int cls = 0, rank = 0; float wa = 0.f, wb = 0.f, r = 0.f;
            if (tid < 256) {
                f32x4 s[6];
#pragma unroll
                for (int q = 0; q < 6; ++q) s[q] = (f32x4){0.f, 0.f, 0.f, 0.f};
                const float* pp = gpart + (size_t)(un.pm * 4) * (256 * 24) + tid * 24;
#pragma unroll
                for (int t4 = 0; t4 < 4; ++t4)
#pragma unroll
                    for (int q = 0; q < 6; ++q) s[q] += *(const f32x4*)(pp + (size_t)t4 * (256 * 24) + 4 * q);
                r = rsqrtf(s[5][0] * (1.f / 1024.f) + 1e-6f);
                LAS float* lg = (LAS float*)(lds + 1024) + tid * 24;
#pragma unroll
                for (int q = 0; q < 5; ++q) *(LAS f32x4*)(lg + 4 * q) = s[q] * r;
                route_token(lg, bg, br, cls, wa, wb);
                rank = __hip_atomic_fetch_add(hist + cls, 1, __ATOMIC_RELAXED, __HIP_MEMORY_SCOPE_WORKGROUP);
            }
            __syncthreads();
            if (tid < 24) cbase[tid] = (int)__hip_atomic_fetch_add(ctl + CW_CCNT + CCNT_STRIDE * tid, (unsigned)hist[tid], __ATOMIC_RELAXED, __HIP_MEMORY_SCOPE_AGENT);
            __syncthreads();
            if (tid < 256) { const int token = un.pm * 256 + tid; rtokc[cls * T + cbase[cls] + rank] = token; swt[token] = (f32x4){wa, wb, r, 0.f}; } P4_TMARK(12);
        }
    }
};
__device__ __forceinline__ void class_experts(int c, int& ea, int& eb) {
    const int g = c / 6, p = c - 6 * g; const int a = p < 3 ? 0 : (p < 5 ? 1 : 2), b = p < 3 ? p + 1 : (p < 5 ? p - 1 : 3); ea = g * 4 + a; eb = g * 4 + b;
}
__device__ __forceinline__ void moe_tables(Frame& F) {
    const int tid_ = F.ftid();
    LAS int* total = (LAS int*)(F.lds + TB_TOTAL); LAS int* tab = (LAS int*)(F.lds + TB_TAB); LAS int* ord = (LAS int*)(F.lds + TB_ORD); LAS int* aux = (LAS int*)(F.lds + TB_AUX);
    LAS int* ntl = aux; LAS int* cbase = aux + 32; LAS int* nel = aux + 64; LAS int* ebase = aux + 96;
    if (tid_ < 24) { const int t = (int)__hip_atomic_load((unsigned*)(F.ws() + WS_CTL) + CW_CCNT + CCNT_STRIDE * tid_, __ATOMIC_RELAXED, __HIP_MEMORY_SCOPE_AGENT); total[tid_] = t; ntl[tid_] = (t + 255) >> 8; }
    __syncthreads();
    if (tid_ < 32) {
        int bs = 0; for (int k = 0; k < 24; ++k) bs += (k < tid_) ? ntl[k] : 0;
        if (tid_ <= 24) cbase[tid_] = bs;
        if (tid_ < 24) { const int n = ntl[tid_]; for (int r = 0; r < n; ++r) tab[1 + bs + r] = tid_ | (r << 8); }
        if (tid_ == 24) tab[0] = bs;
        if (tid_ < 16) { const int g = tid_ >> 2; int n = 0;
            for (int p = 0; p < 6; ++p) { int ea, eb; class_experts(6 * g + p, ea, eb); if (ea == tid_ || eb == tid_) n += ntl[6 * g + p]; }
            nel[tid_] = n; }
    }
    __syncthreads();
    if (tid_ < 17) { int bs = 0; for (int k = 0; k < 16; ++k) bs += (k < tid_) ? nel[k] : 0; ebase[tid_] = bs;
        if (tid_ < 16) { const int g = tid_ >> 2; int o = bs;
            for (int p = 0; p < 6; ++p) { const int c = 6 * g + p; int ea, eb; class_experts(c, ea, eb);
                if (ea == tid_ || eb == tid_) { const int n = ntl[c], cb = cbase[c], sl = (eb == tid_) ? 1 : 0; for (int r = 0; r < n; ++r) ord[o + r] = (cb + r) | (sl << 16); o += n; } } } }
    __syncthreads();
    if (tid_ == 0) {
        const int R = cbase[24], G = F.G, m7 = 8 * R > 2 * G ? 8 * R - 2 * G : 0;
        int ed = 0; while (ed < 16 && ebase[ed + 1] * 4 <= 2 * G) ++ed;
        const int rdone = cbase[6 * (ed >> 2)]; int ny = G - m7; if (ny > 4 * rdone) ny = 4 * rdone; if (ny < 0) ny = 0; aux[128] = ny; }
    __syncthreads();
}
constexpr int CW_RT = 16384, RT_STRIDE = 64;
struct SchedP7 {
    __device__ __forceinline__ void a_ready(const pg8::Unit&) const {}
    int G, vcu; const LAS int* tab; const LAS int* total; const char* h2; const char* Wgu; const int* rtokc; int first, nmax;
    __device__ __forceinline__ bool next(int i, pg8::Unit& u) const {
        const int L = first + i * G + vcu, R = tab[0]; if (i >= nmax || L >= R * 8) return false;
        const int ov = ((const LAS int*)((const LAS char*)tab + (TB_ORD - TB_TAB)))[L >> 2], r = ov & 0xffff, pn = (ov >> 16) * 4 + (L & 3), tv = tab[1 + r], c = tv & 255, rp = tv >> 8; int ea, eb; class_experts(c, ea, eb); const int e = pn < 4 ? ea : eb;
        const int nv = total[c] - 256 * rp;
        u.pm = r; u.pn = pn; u.aux = nv < 256 ? nv : 256; u.ksplit = 1 << 30; u.A = h2; u.ridx = rtokc + c * T + 256 * rp;
        u.B0 = Wgu + (size_t)e * (1024 * 2048) + (size_t)(pn & 3) * 256 * 2048; u.B1 = u.B0; return true;
    }
};
struct EpiP7 {
    static constexpr bool PERM = true, AFTER_DRAIN = false, PREFETCH = false, KEEP = false;
    bf16* hid; const f32x4* swt; unsigned* ctl;
    __device__ __forceinline__ bool operator()(f32x4 (&acc)[2][2][4][2], const pg8::Unit& un, int wr, int wc, int fr, int fq) const {
        const int rl0 = wr * 64 + fr, sel = un.pn >> 2, col0 = sel * 512 + 128 * (un.pn & 3) + 16 * wc + 4 * fq, last = un.aux - 1;
        const __amdgpu_buffer_rsrc_t rs = __builtin_amdgcn_make_buffer_rsrc((void*)swt, 0, 0x7fffffff, 0x00020000);
        int tok[8]; float w[8], r[8];
#pragma unroll
        for (int g = 0; g < 8; ++g) { const int rl = rl0 + (g >> 2) * 128 + (g & 3) * 16; tok[g] = un.ridx[rl < last ? rl : last]; }
#pragma unroll
        for (int g = 0; g < 8; ++g) { w[g] = __builtin_bit_cast(float, __builtin_amdgcn_raw_buffer_load_b32(rs, tok[g] * 16, sel * 4, 0)); r[g] = __builtin_bit_cast(float, __builtin_amdgcn_raw_buffer_load_b32(rs, tok[g] * 16 + 8, 0, 0)); }
        __builtin_amdgcn_sched_barrier(0);
#pragma unroll
        for (int g = 0; g < 8; ++g) { const int ai = g >> 2, m = g & 3, rl = rl0 + ai * 128 + m * 16; const bool ok = rl <= last; const float rr = ok ? r[g] : 0.f, rw = ok ? r[g] * w[g] : 0.f;
            v2u w2[2];
            float sg[8];
#pragma unroll
            for (int k = 0; k < 8; ++k) sg[k] = acc[ai][k >> 2][m][0][k & 3] * rr;
            sigmoid_n<8>(sg);
#pragma unroll
            for (int bj = 0; bj < 2; ++bj) { const f32x4 gv = acc[ai][bj][m][0] * rr, uv = acc[ai][bj][m][1] * rw; f32x4 hh;
#pragma unroll
                for (int e = 0; e < 4; ++e) hh[e] = gv[e] * sg[4 * bj + e] * uv[e];
                w2[bj].x = pg8::cvt_pk_bf16(hh[0], hh[1]); w2[bj].y = pg8::cvt_pk_bf16(hh[2], hh[3]); }
            const auto sx = __builtin_amdgcn_permlane16_swap(w2[0].x, w2[1].x, false, false), sy = __builtin_amdgcn_permlane16_swap(w2[0].y, w2[1].y, false, false);
            v4u o; o.x = sx[0]; o.y = sy[0]; o.z = sx[1]; o.w = sy[1];
            *(v4u*)(hid + (size_t)(un.pm * 256 + rl) * 1024 + sel * 512 + 128 * (un.pn & 3) + 16 * wc + 4 * (fq & ~1) + 64 * (fq & 1)) = o; }
        return true;
    }
};
struct SchedP8 {
    int G, vcu; const LAS int* tab; const LAS int* total; const char* hid; const char* WdT; const int* rtokc; unsigned* ctl; int first, nmax;
    __device__ __forceinline__ bool next(int i, pg8::Unit& u) const {
        const int L = first + i * G + vcu, R = tab[0]; if (i >= nmax || L < 0 || L >= R * 4) return false;
        const int r = L >> 2, pn = L & 3, tv = tab[1 + r], c = tv & 255, rp = tv >> 8; int ea, eb; class_experts(c, ea, eb);
        const int nv = total[c] - 256 * rp;
        u.pm = r; u.pn = pn; u.aux = nv < 256 ? nv : 256; u.ksplit = 8; u.A = hid + (size_t)r * 256 * 2048; u.ridx = rtokc + c * T + 256 * rp;
        u.B0 = WdT + (size_t)ea * (1024 * 1024) + (size_t)pn * 256 * 1024; u.B1 = WdT + (size_t)eb * (1024 * 1024) + (size_t)pn * 256 * 1024; return true;
    }
    __device__ __forceinline__ void a_ready(const pg8::Unit&) const {}
};
struct EpiP8 {
    static constexpr bool PERM = false, AFTER_DRAIN = false, PREFETCH = false, KEEP = false;
    float* out; const bf16* h2; const float* g2;
    __device__ __forceinline__ bool operator()(f32x4 (&acc)[2][2][4][2], const pg8::Unit& un, int wr, int wc, int fr, int fq) const {
        const int rl0 = wr * 64 + fr, col0 = un.pn * 256 + wc * 32 + 4 * fq, last = un.aux - 1;
        const __amdgpu_buffer_rsrc_t rh = __builtin_amdgcn_make_buffer_rsrc((void*)h2, 0, 0x7fffffff, 0x00020000), ro = __builtin_amdgcn_make_buffer_rsrc((void*)out, 0, T * 1024 * 4, 0x00020000);
        int tok[8];
#pragma unroll
        for (int g = 0; g < 8; ++g) { const int rl = rl0 + (g >> 2) * 128 + (g & 3) * 16; tok[g] = un.ridx[rl < last ? rl : last]; }
        f32x4 gi[2][2];
#pragma unroll
        for (int bj = 0; bj < 2; ++bj)
#pragma unroll
            for (int n = 0; n < 2; ++n) { const f32x4 g = *(const f32x4*)(g2 + col0 + bj * 128 + n * 16); gi[bj][n] = (f32x4){__builtin_amdgcn_rcpf(g[0]), __builtin_amdgcn_rcpf(g[1]), __builtin_amdgcn_rcpf(g[2]), __builtin_amdgcn_rcpf(g[3])}; }
        v2u hw[2][2][2];
#define EPI8_LD(g) do { const int vo_ = tok[g] * 2048 + col0 * 2; _Pragma("unroll") for (int bj = 0; bj < 2; ++bj) _Pragma("unroll") for (int n = 0; n < 2; ++n) \
            hw[(g) & 1][bj][n] = __builtin_amdgcn_raw_buffer_load_b64(rh, vo_ + bj * 256 + n * 32, 0, 0); } while (0)
        EPI8_LD(0);
#pragma unroll
        for (int g = 0; g < 8; ++g) { const int ai = g >> 2, m = g & 3, rl = rl0 + ai * 128 + m * 16;
            if (g + 1 < 8) EPI8_LD(g + 1);
            const int so = rl <= last ? tok[g] * 4096 + col0 * 4 : 0x70000000;
#pragma unroll
            for (int bj = 0; bj < 2; ++bj)
#pragma unroll
                for (int n = 0; n < 2; ++n) { const v2u h = hw[g & 1][bj][n];
                    const f32x4 xm = (f32x4){bflo(h.x), bfhi(h.x), bflo(h.y), bfhi(h.y)} * gi[bj][n] + acc[ai][bj][m][n];
                    __builtin_amdgcn_raw_buffer_store_b128(__builtin_bit_cast(v4u, xm), ro, so + bj * 512 + n * 64, 0, 0); }
            __builtin_amdgcn_sched_barrier(0); }
#undef EPI8_LD
        return true;
    }
};
constexpr int KST64 = 144, KST128 = 272, VST = 528;
template <int DH> __device__ __forceinline__ int vrow_off(int row, int ch) { return DH == 128 ? 256 * row + 16 * (ch ^ (((row & 3) << 2) | ((row >> 2) & 3))) : 128 * row + 16 * (ch ^ ((((row >> 1) & 1) << 1) | (((row >> 3) & 1) << 2))); }
template <int DH> __device__ __forceinline__ int kswz(int row) { return DH == 64 ? (((row >> 1) & 1) | (((row >> 3) & 3) << 1)) : ((row & 3) | (((row >> 3) & 3) << 2)); }
template <int DH, bool SWA>
__device__ __forceinline__ void attn256_mtile(const LAS unsigned char* Kl, const LAS unsigned char* Vl, const bf16x8 (&qf)[DH / 32], bf16* orow0, int ldo,
                                              float sink_l2, int i0, bool has_prev, int lane) {
    constexpr int KST = DH * 2, NKS = DH / 32, NDT = DH / 16;
    const int qi = lane & 15, g = lane >> 4;
    float ssq = 0.f;
#pragma unroll
    for (int ks = 0; ks < NKS; ++ks) {
        if (!SWA) {
#pragma unroll
            for (int e = 0; e < 8; ++e) { const float x = bf2f((bf16)qf[ks][e]); ssq += x * x; } } }
    float sc;
    if (SWA) sc = 0.125f * 1.4426950408889634f;
    else { ssq += shx(ssq, 16); ssq += shx(ssq, 32); sc = rsqrtf(ssq * (1.f / 128.f) + 1e-6f) * (0.08838834764831845f * 1.4426950408889634f); }
    f32x4 sacc[SWA ? 5 : 8][2];
    const int krow = 8 * (qi >> 2) + (qi & 3);
    constexpr int NS = SWA ? 5 : 8; const int sbase = SWA ? (i0 + 1) >> 5 : 0;
    const int fl = DH == 64 ? (((qi >> 1) & 1) | (((qi >> 2) & 1) << 1)) : (qi & 3), fh = DH == 64 ? ((qi >> 3) & 1) : (qi >> 2);
    const LAS unsigned char* kb0 = Kl + (32 * sbase + krow) * KST + 16 * (g ^ fl);
    int kof[NKS];
#pragma unroll
    for (int ks = 0; ks < NKS; ++ks) kof[ks] = 64 * (ks ^ fh);
#pragma unroll
    for (int s = 0; s < NS; ++s)
#pragma unroll
        for (int h = 0; h < 2; ++h) { f32x4 c = (f32x4){0.f, 0.f, 0.f, 0.f}; const LAS unsigned char* kp = kb0 + (32 * s + 4 * h) * KST;
#pragma unroll
            for (int ks = 0; ks < NKS; ++ks) c = __builtin_amdgcn_mfma_f32_16x16x32_bf16(*(const LAS bf16x8*)(kp + kof[ks]), qf[ks], c, 0, 0, 0);
            sacc[s][h] = c; if (h == 1) __builtin_amdgcn_sched_barrier(0); }
    float mr = -3.0e38f;
#pragma unroll
    for (int s = 0; s < NS; ++s) {
        if (SWA && (s == 0 || s == NS - 1 || !has_prev)) {
#pragma unroll
            for (int h = 0; h < 2; ++h)
#pragma unroll
                for (int r = 0; r < 4; ++r) { const int kb = 32 * (sbase + s) + 8 * g + 4 * h + r, delta = 128 + i0 + qi - kb; const bool ok = (delta >= 0) && (delta < 128) && (has_prev || kb >= 128);
                    sacc[s][h][r] = ok ? sacc[s][h][r] : -1.0e30f; } }
#pragma unroll
        for (int h = 0; h < 2; ++h) mr = fmaxf(fmaxf(mr, fmaxf(sacc[s][h][0], sacc[s][h][1])), fmaxf(sacc[s][h][2], sacc[s][h][3])); }
    mr = fmaxf(mr, shx(mr, 16)); mr = fmaxf(mr, shx(mr, 32));
    float m = mr * sc; if (SWA) m = fmaxf(m, sink_l2);
    float sum = 0.f;
#pragma unroll
    for (int s = 0; s < NS; ++s)
#pragma unroll
        for (int h = 0; h < 2; ++h)
#pragma unroll
            for (int r = 0; r < 4; ++r) { const float p = __builtin_amdgcn_exp2f(__builtin_fmaf(sacc[s][h][r], sc, -m)); sacc[s][h][r] = p; sum += p; }
    sum += shx(sum, 16); sum += shx(sum, 32);
    if (SWA) sum += __builtin_amdgcn_exp2f(sink_l2 - m);
    const float inv = __builtin_amdgcn_rcpf(sum);
    bf16x8 pf[NS];
#pragma unroll
    for (int s = 0; s < NS; ++s) { v4u w; w.x = pg8::cvt_pk_bf16(sacc[s][0][0], sacc[s][0][1]); w.y = pg8::cvt_pk_bf16(sacc[s][0][2], sacc[s][0][3]);
        w.z = pg8::cvt_pk_bf16(sacc[s][1][0], sacc[s][1][1]); w.w = pg8::cvt_pk_bf16(sacc[s][1][2], sacc[s][1][3]); pf[s] = __builtin_bit_cast(bf16x8, w); }
#pragma unroll
    for (int dt = 0; dt < NDT; dt += 2) { f32x4 o0 = (f32x4){0.f, 0.f, 0.f, 0.f}, o1 = o0;
        {
            typedef short s16x4 __attribute__((ext_vector_type(4)));
            constexpr int RB = 2 * DH;
            const int q4 = qi >> 2, p4 = qi & 3;
            const LAS unsigned char* rb = Vl + RB * (32 * sbase + 8 * g + q4) + 8 * (p4 & 1);
            const LAS unsigned char* ad[2][2];
#pragma unroll
            for (int dl = 0; dl < 2; ++dl)
#pragma unroll
                for (int t = 0; t < 2; ++t) { const int xs = DH == 128 ? 4 * q4 + ((2 * g + t) & 3) : 2 * ((q4 >> 1) & 1) + 4 * (g & 1);
                    ad[dl][t] = rb + 4 * RB * t + 16 * ((2 * (dt + dl) + (p4 >> 1)) ^ xs); }
#pragma unroll
            for (int s = 0; s < NS; ++s) {
                const s16x4 a00 = __builtin_amdgcn_ds_read_tr16_b64_v4i16((LAS s16x4*)(ad[0][0] + 32 * RB * s)), a01 = __builtin_amdgcn_ds_read_tr16_b64_v4i16((LAS s16x4*)(ad[0][1] + 32 * RB * s));
                const s16x4 a10 = __builtin_amdgcn_ds_read_tr16_b64_v4i16((LAS s16x4*)(ad[1][0] + 32 * RB * s)), a11 = __builtin_amdgcn_ds_read_tr16_b64_v4i16((LAS s16x4*)(ad[1][1] + 32 * RB * s));
                const bf16x8 A0 = __builtin_shufflevector(a00, a01, 0, 1, 2, 3, 4, 5, 6, 7), A1 = __builtin_shufflevector(a10, a11, 0, 1, 2, 3, 4, 5, 6, 7);
                o0 = __builtin_amdgcn_mfma_f32_16x16x32_bf16(A0, pf[s], o0, 0, 0, 0); o1 = __builtin_amdgcn_mfma_f32_16x16x32_bf16(A1, pf[s], o1, 0, 0, 0); }
        }
        v2u w0, w1; w0.x = pg8::cvt_pk_bf16(o0[0] * inv, o0[1] * inv); w0.y = pg8::cvt_pk_bf16(o0[2] * inv, o0[3] * inv);
        w1.x = pg8::cvt_pk_bf16(o1[0] * inv, o1[1] * inv); w1.y = pg8::cvt_pk_bf16(o1[2] * inv, o1[3] * inv);
        const auto sx = __builtin_amdgcn_permlane16_swap(w0.x, w1.x, false, false), sy = __builtin_amdgcn_permlane16_swap(w0.y, w1.y, false, false);
        v4u ow; ow.x = sx[0]; ow.y = sy[0]; ow.z = sx[1]; ow.w = sy[1];
        *(v4u*)(orow0 + (size_t)qi * ldo + 16 * (dt + (g & 1)) + 8 * (g >> 1)) = ow; __builtin_amdgcn_sched_barrier(0); }
}
template <int DH>
__device__ __forceinline__ void vt_load(v4u (&va)[DH / 32], v4u (&vb)[DH / 32], const bf16* vsrc, int ldv, int kmin, int tid) {
    constexpr int NC = DH / 8;
#pragma unroll
    for (int i = 0; i < DH / 32; ++i) { const int id = tid + 512 * i, c = id % NC, kp = id / NC; const bool ok = 2 * kp >= kmin; const int r = ok ? 2 * kp : kmin;
        const v4u a = *(const v4u*)(vsrc + (long)r * ldv + 8 * c), b = *(const v4u*)(vsrc + (long)(r + 1) * ldv + 8 * c);
        va[i] = ok ? a : (v4u){0u, 0u, 0u, 0u}; vb[i] = ok ? b : (v4u){0u, 0u, 0u, 0u}; }
}
template <int DH>
__device__ __forceinline__ void vt_store(LAS unsigned char* Vl, const v4u (&va)[DH / 32], const v4u (&vb)[DH / 32], int tid) {
    constexpr int NC = DH / 8;
#pragma unroll
    for (int i = 0; i < DH / 32; ++i) { const int id = tid + 512 * i, c = id % NC, kp = id / NC; LAS unsigned char* dst = Vl + (8 * c) * VST + 4 * kp;
        const unsigned aw[4] = {va[i].x, va[i].y, va[i].z, va[i].w}, bw[4] = {vb[i].x, vb[i].y, vb[i].z, vb[i].w};
#pragma unroll
        for (int e = 0; e < 4; ++e) { *(LAS unsigned*)(dst + (2 * e) * VST) = (aw[e] & 0xffffu) | (bw[e] << 16); *(LAS unsigned*)(dst + (2 * e + 1) * VST) = (aw[e] >> 16) | (bw[e] & 0xffff0000u); } }
}
struct SwaRegs { bf16x8 qa[4][2]; v4u kr[4]; v4u va[2], vb[2]; };
__device__ __forceinline__ void swa_load(Frame& F, int u, SwaRegs& R) {
    const int tid_ = F.ftid(), lane_ = tid_ & 63;
    const int hk = u & 1, n = (u >> 1) & 63, b = u >> 7;
    unsigned char* dout = (unsigned char*)F.out();
    const bf16* q = (const bf16*)(dout + DO_Q); const bf16* k = (const bf16*)(dout + DO_K); const bf16* v = (const bf16*)(dout + DO_V);
    const int rowb = b * SEQ + 128 * (n - 1), kmin = (n == 0) ? 128 : 0;
    const int hq = 4 * hk + (F.wave >> 1), r0 = 64 * (F.wave & 1);
#pragma unroll
    for (int mt = 0; mt < 4; ++mt)
#pragma unroll
        for (int ks = 0; ks < 2; ++ks) R.qa[mt][ks] = *(const bf16x8*)(q + ((size_t)b * SEQ + 128 * n + r0 + 16 * mt + (lane_ & 15)) * 512 + hq * 64 + 8 * (lane_ >> 4) + 32 * ks);
#pragma unroll
    for (int i = 0; i < 4; ++i) { const int id = tid_ + 512 * i, key = id >> 3, c = id & 7; const bool ok = key >= kmin;
        const v4u w = *(const v4u*)(k + ((long)(rowb + (ok ? key : kmin)) * 128 + hk * 64 + 8 * c)); R.kr[i] = ok ? w : (v4u){0u, 0u, 0u, 0u}; }
#pragma unroll
    for (int i = 0; i < 4; ++i) { const int id = tid_ + 512 * i, key = id >> 3, ch = id & 7; const bool ok = key >= kmin;
        const v4u w = *(const v4u*)(v + ((long)(rowb + (ok ? key : kmin)) * 128 + hk * 64 + 8 * ch)); const v4u z = ok ? w : (v4u){0u, 0u, 0u, 0u}; if (i < 2) R.va[i] = z; else R.vb[i - 2] = z; }
}
__device__ __forceinline__ void swa_run(Frame& F, int u, const SwaRegs& R) {
    const int tid_ = F.ftid(), lane_ = tid_ & 63;
    const int hk = u & 1, n = (u >> 1) & 63, b = u >> 7;
    bf16* acts = (bf16*)(F.ws() + WS_ACTS);
    LAS unsigned char* Kl = F.lds; LAS unsigned char* Vl = F.lds + 256 * KST64;
    const int hq = 4 * hk + (F.wave >> 1), r0 = 64 * (F.wave & 1);
#pragma unroll
    for (int i = 0; i < 4; ++i) { const int id = tid_ + 512 * i, key = id >> 3, c = id & 7; *(LAS v4u*)(Kl + key * 128 + 16 * (c ^ kswz<64>(key))) = R.kr[i]; }
#pragma unroll
    for (int i = 0; i < 4; ++i) { const int id = tid_ + 512 * i, key = id >> 3, ch = id & 7; *(LAS v4u*)(Vl + vrow_off<64>(key, ch)) = i < 2 ? R.va[i] : R.vb[i - 2]; }
    __syncthreads();
    const float sink_l2 = F.in(7)[hq] * 1.4426950408889634f;
#pragma unroll
    for (int mt = 0; mt < 4; ++mt) { const int i0 = r0 + 16 * mt; const size_t tok0 = (size_t)b * SEQ + 128 * n + i0;
        attn256_mtile<64, true>(Kl, Vl, R.qa[mt], acts + tok0 * 1536 + hq * 64, 1536, sink_l2, i0, n > 0, lane_); }
    __syncthreads();
}
struct XatRegs { bf16x8 qa[2][4]; v4u kr[8]; v4u va[4], vb[4]; };
__device__ __forceinline__ void xattn_load(Frame& F, int u, XatRegs& R) {
    const int tid_ = F.ftid(), lane_ = tid_ & 63;
    const int qb = u & 31, h = (u >> 5) & 3, b = u >> 7;
    const bf16* mkv = (const bf16*)(F.ws() + WS_MKV); const bf16* xq = (const bf16*)(F.ws() + WS_XQ);
#pragma unroll
    for (int mt = 0; mt < 2; ++mt)
#pragma unroll
        for (int ks = 0; ks < 4; ++ks) R.qa[mt][ks] = *(const bf16x8*)(xq + ((size_t)b * SEQ + 256 * qb + 32 * F.wave + 16 * mt + (lane_ & 15)) * 512 + h * 128 + 8 * (lane_ >> 4) + 32 * ks);
    const int c = tid_ & 15;
#pragma unroll
    for (int i = 0; i < 8; ++i) { const int key = (tid_ >> 4) + 32 * i; R.kr[i] = *(const v4u*)(mkv + (size_t)(b * 256 + key) * 1024 + h * 128 + 8 * c); }
#pragma unroll
    for (int i = 0; i < 8; ++i) { const int id = tid_ + 512 * i, ch = id & 15, key = id >> 4; const v4u w = *(const v4u*)(mkv + (size_t)(b * 256 + key) * 1024 + 512 + h * 128 + 8 * ch); if (i < 4) R.va[i] = w; else R.vb[i - 4] = w; }
}
__device__ __forceinline__ void xattn_run(Frame& F, int u, const XatRegs& R) {
    const int tid_ = F.ftid(), lane_ = tid_ & 63;
    const int qb = u & 31, h = (u >> 5) & 3, b = u >> 7;
    bf16* acts = (bf16*)(F.ws() + WS_ACTS);
    LAS unsigned char* Kl = F.lds; LAS unsigned char* Vl = F.lds + 256 * KST128;
    { const int c = tid_ & 15; const f32x4 ga = *(const f32x4*)(F.in(17) + 8 * c), gb = *(const f32x4*)(F.in(17) + 8 * c + 4), qa = *(const f32x4*)(F.in(16) + 8 * c), qc = *(const f32x4*)(F.in(16) + 8 * c + 4);
      const f32x4 g0 = ga * qa, g1 = gb * qc;
#pragma unroll
      for (int i = 0; i < 8; ++i) { const int key = (tid_ >> 4) + 32 * i; const v4u w = R.kr[i];
          f32x4 x0 = (f32x4){bflo(w.x), bfhi(w.x), bflo(w.y), bfhi(w.y)}, x1 = (f32x4){bflo(w.z), bfhi(w.z), bflo(w.w), bfhi(w.w)};
          float ss = (x0[0] * x0[0] + x0[1] * x0[1]) + (x0[2] * x0[2] + x0[3] * x0[3]) + (x1[0] * x1[0] + x1[1] * x1[1]) + (x1[2] * x1[2] + x1[3] * x1[3]);
          ss += shx(ss, 1); ss += shx(ss, 2); ss += shx(ss, 4); ss += shx(ss, 8);
          const float r = rsqrtf(ss * (1.f / 128.f) + 1e-6f); x0 = x0 * r * g0; x1 = x1 * r * g1;
          *(LAS v4u*)(Kl + key * 256 + 16 * (c ^ kswz<128>(key))) = pack8(x0, x1); } }
#pragma unroll
    for (int i = 0; i < 8; ++i) { const int id = tid_ + 512 * i, ch = id & 15, key = id >> 4; *(LAS v4u*)(Vl + vrow_off<128>(key, ch)) = i < 4 ? R.va[i] : R.vb[i - 4]; }
    __syncthreads();
#pragma unroll
    for (int mt = 0; mt < 2; ++mt) { const size_t tok0 = (size_t)b * SEQ + 256 * qb + 32 * F.wave + 16 * mt;
        attn256_mtile<128, false>(Kl, Vl, R.qa[mt], acts + tok0 * 1536 + 1024 + h * 128, 1536, 0.f, 0, true, lane_); }
    __syncthreads();
}
__device__ __forceinline__ void conv_load(Frame& F, int cu, v4u (&pre)[8]) {
    const int tid_ = F.ftid(); const bf16* u = (const bf16*)(F.ws() + WS_U);
    const int t0 = 32 * cu, s0 = t0 & (SEQ - 1);
#pragma unroll
    for (int i = 0; i < 8; ++i) { const int id = tid_ + 512 * i, j0 = id >> 6, c = id & 63, j = j0 < 62 ? j0 : 61; const bool ok = s0 - 30 + j >= 0;
        const v4u w = *(const v4u*)(u + (long)(t0 - 30 + (ok ? j : 30)) * 512 + 8 * c); pre[i] = ok ? w : (v4u){0u, 0u, 0u, 0u}; }
}
__device__ __forceinline__ void conv_run(Frame& F, int cu, const v4u (&pre)[8]) {
    const int tid_ = F.ftid(), lane_ = tid_ & 63;
    bf16* acts = (bf16*)(F.ws() + WS_ACTS);
    LAS unsigned char* Ul = F.lds; LAS float* Yl = (LAS float*)(F.lds + 62 * 1024);
    const int t0 = 32 * cu;
    const int cp = tid_ & 255, th = tid_ >> 8;
    const float* wdw = F.in(9); const float2 bias = *(const float2*)(F.in(10) + 2 * cp);
    f32x2v w[31];
#pragma unroll
    for (int j = 0; j < 31; ++j) { const float2 t = *(const float2*)(wdw + j * 512 + 2 * cp); w[j] = (f32x2v){t.x, t.y}; }
#pragma unroll
    for (int i = 0; i < 8; ++i) { const int id = tid_ + 512 * i, j = id >> 6, c = id & 63; if (id < 62 * 64) *(LAS v4u*)(Ul + j * 1024 + 16 * c) = pre[i]; }
    __syncthreads();
    {
#pragma unroll 1
      for (int ch = 0; ch < 2; ++ch) { const int i0 = 16 * th + 8 * ch;
          f32x2v acc[8];
#pragma unroll
          for (int i = 0; i < 8; ++i) acc[i] = (f32x2v){bias.x, bias.y};
#pragma unroll
          for (int r = 0; r < 38; ++r) { const unsigned x = *(const LAS unsigned*)(Ul + (i0 + r) * 1024 + 4 * cp); const f32x2v xv = (f32x2v){bflo(x), bfhi(x)};
#pragma unroll
              for (int i = 0; i < 8; ++i) { const int j = r - i; if (j >= 0 && j < 31) acc[i] = __builtin_elementwise_fma(w[j], xv, acc[i]); } }
#pragma unroll
          for (int i = 0; i < 8; ++i) *(LAS f32x2v*)(Yl + (i0 + i) * 512 + 2 * cp) = acc[i]; }
    }
    __syncthreads();
    { const int lane = lane_; const f32x4 ga = *(const f32x4*)(F.in(11) + 8 * lane), gb = *(const f32x4*)(F.in(11) + 8 * lane + 4), ba = *(const f32x4*)(F.in(12) + 8 * lane), bb = *(const f32x4*)(F.in(12) + 8 * lane + 4);
#pragma unroll
      for (int i = 0; i < 4; ++i) { const int tk = 4 * F.wave + i; const f32x4 y0 = *(const LAS f32x4*)(Yl + tk * 512 + 8 * lane), y1 = *(const LAS f32x4*)(Yl + tk * 512 + 8 * lane + 4);
          const float mean = wave_sum((y0[0] + y0[1]) + (y0[2] + y0[3]) + (y1[0] + y1[1]) + (y1[2] + y1[3])) * (1.f / 512.f);
          const f32x4 d0 = y0 - mean, d1 = y1 - mean;
          const float var = wave_sum((d0[0] * d0[0] + d0[1] * d0[1]) + (d0[2] * d0[2] + d0[3] * d0[3]) + (d1[0] * d1[0] + d1[1] * d1[1]) + (d1[2] * d1[2] + d1[3] * d1[3])) * (1.f / 512.f);
          const float rstd = rsqrtf(var + 1e-5f);
          f32x4 z0 = d0 * rstd * ga + ba, z1 = d1 * rstd * gb + bb;
          { float sg[8];
#pragma unroll
            for (int e = 0; e < 4; ++e) { sg[e] = z0[e]; sg[4 + e] = z1[e]; }
            sigmoid_n<8>(sg);
#pragma unroll
            for (int e = 0; e < 4; ++e) { z0[e] *= sg[e]; z1[e] *= sg[4 + e]; } }
          *(v4u*)(acts + (size_t)(t0 + tk) * 1536 + 512 + 8 * lane) = pack8(z0, z1); } }
    __syncthreads();
}
__device__ __forceinline__ void p2_mixers(Frame& F) {
    for (int u = F.vcu; u < 256; u += F.G) {
        v4u c1[8], c2[8]; conv_load(F, 2 * u, c1); conv_load(F, 2 * u + 1, c2);
        SwaRegs S; TSUB_BEG(0) conv_run(F, 2 * u, c1); TSUB_END(0) swa_load(F, u, S);
        TSUB_BEG(1) conv_run(F, 2 * u + 1, c2); TSUB_END(1)
        XatRegs X; xattn_load(F, u, X);
        TSUB_BEG(2) swa_run(F, u, S); TSUB_END(2)
        TSUB_BEG(3) xattn_run(F, u, X); TSUB_END(3)
    }
}
__global__ void __launch_bounds__(NWAVES * 64, 2) mk_fwd(Args args) {
    extern __shared__ __attribute__((aligned(16))) unsigned char lds[];
    Frame F;
    F.lds = (LAS unsigned char*)lds;
    F.MISC = (volatile LAS unsigned*)(F.lds + MISC_OFF);
    const int tid_ = F.ftid(); F.wave = __builtin_amdgcn_readfirstlane(tid_ >> 6);
    F.G = gridDim.x; { const int bx = blockIdx.x; F.vcu = (F.G % 8 == 0) ? (bx % 8) * (F.G / 8) + bx / 8 : bx; }
    F.ctl = (gu32*)(args.ws + WS_CTL);
    for (int u = tid_; u < (LDS_BYTES - LDSCTL_OFF) / 4; u += NWAVES * 64) ((LAS unsigned*)(F.lds + LDSCTL_OFF))[u] = 0u;
    __syncthreads();
    if (tid_ < 30) ((LAS unsigned long long*)(F.lds + PARG_OFF))[tid_] = tid_ < 28 ? (unsigned long long)args.in[tid_] : (tid_ == 28 ? (unsigned long long)args.out : (unsigned long long)args.ws);
    __syncthreads();
    XcdBarrier bar = xcd_barrier_post((unsigned*)(F.ctl + CW_BAR) + args.li * XCD_BAR_WORDS, F.MISC + 8);
    const int lo = args.ph_lo, hi = args.ph_hi;
#define IN(k) (lo <= (k) && (k) < hi)
#define BOTH(k) (IN(k) && IN((k) + 1))

#ifndef MK_REP
#define MK_REP 0
#endif
#ifndef MK_XBAR
#define MK_XBAR 0
#endif
#ifndef MK_TPROBE
#define MK_TPROBE -1
#endif
    unsigned long long tp0 = 0, tp1 = 0;
#define RUN(kk, BODY) if (IN(kk)) { if (MK_TPROBE == (kk)) tp0 = __builtin_amdgcn_s_memrealtime(); BODY if (BOTH(kk) || MK_TPROBE == (kk)) { if ((kk) == 3 && xloc) xcd_local_barrier((unsigned*)F.ctl, bar.bar, bar.x, 0u, 32u); else xcd_barrier(bar); } if (MK_TPROBE == (kk)) tp1 = __builtin_amdgcn_s_memrealtime(); }
#define PH0 { p0_prologue(F); }
#define PH1 { unsigned char* ws = F.ws(); unsigned char* dout = (unsigned char*)F.out(); SchedP1 S{F.G, (int)blockIdx.x, (const char*)(dout + DO_H), (const char*)(ws + WS_W1), (const char*)(ws + WS_MEMN), (const char*)(ws + WS_WKV)}; \
        EpiP1 E{(bf16*)(dout + DO_Q), (bf16*)(dout + DO_K), (bf16*)(dout + DO_V), (bf16*)(ws + WS_U), (bf16*)(ws + WS_XQ), (bf16*)(ws + WS_GATES), (bf16*)(ws + WS_MKV), (const float2*)(ws + WS_CS), F.in(5), F.in(6)}; \
        convert_b_tail(F, 0); __syncthreads(); pg8::gemm_phase<EpiP1, SchedP1, true, false, false, 16, 2048u, 2048u>(F.lds + RING_OFF, S, E); convert_b_tail(F, 1); }
#define PH2 { p2_mixers(F); }
#define PH3 { unsigned char* ws = F.ws(); SchedP3 S{F.G, vb34, (const char*)(ws + WS_ACTS), (const char*)(ws + WS_WO3)}; EpiP3 E{(const unsigned char*)(ws + WS_GATES), (bf16*)(ws + WS_MERGED)}; \
        pg8::gemm_phase<EpiP3, SchedP3, true, false, false, 8, 3072u, 1024u>(F.lds + RING_OFF, S, E); }
#define PH4 { unsigned char* ws = F.ws(); SchedP4 S{F.G, vb34, (const char*)(ws + WS_MERGED), (const char*)(ws + WS_WOUT)}; \
        EpiP4F E{(const bf16*)((unsigned char*)F.out() + DO_H), (const float*)(ws + WS_RINV), (bf16*)(ws + WS_H2), F.in(20), (const bf16*)(ws + WS_WRT), (float*)((unsigned char*)F.out() + DO_PART), (unsigned*)(ws + WS_CTL), F.in(22), F.in(24), (int*)(ws + WS_ROUTE + RT_TOKC), (f32x4*)(ws + WS_ROUTE + RT_SWT), F.in(3)}; \
        pg8::gemm_phase<EpiP4F, SchedP4, false, false, false, 16, 2048u, 2048u>(F.lds + RING_OFF, S, E); }
#define PH6 { }
#define MOE_SCHEDS unsigned char* ws = F.ws(); const LAS int* tab_ = (const LAS int*)(F.lds + TB_TAB); const LAS int* tot_ = (const LAS int*)(F.lds + TB_TOTAL); \
        EpiP7 E7{(bf16*)(ws + WS_HID), (const f32x4*)(ws + WS_ROUTE + RT_SWT), (unsigned*)(ws + WS_CTL)}; EpiP8 E8{F.out(), (const bf16*)(ws + WS_H2), F.in(20)};
#define SCHED7(first, nmax) SchedP7{F.G, F.vcu, tab_, tot_, (const char*)(ws + WS_H2), (const char*)(ws + WS_WGU), (const int*)(ws + WS_ROUTE + RT_TOKC), (first), (nmax)}
#define SCHED8(first, nmax) SchedP8{F.G, F.vcu, tab_, tot_, (const char*)(ws + WS_HID), (const char*)(ws + WS_WDT), (const int*)(ws + WS_ROUTE + RT_TOKC), (unsigned*)(ws + WS_CTL), (first), (nmax)}
#define GEMM7(S) pg8::gemm_phase<EpiP7, SchedP7, true, true, false, 16, 2048u, 2048u>(F.lds + RING_OFF, S, E7)
#define GEMM8(S) pg8::gemm_phase<EpiP8, SchedP8, true, false, true, 16, 2048u, 1024u>(F.lds + RING_OFF, S, E8)
#define PH7 { moe_tables(F); convert_b2_all(F); MOE_SCHEDS const SchedP7 S = SCHED7(0, 2); GEMM7(S); }
#define PH8 { MOE_SCHEDS const int R8 = 8 * tab_[0], m7 = R8 > 2 * F.G ? R8 - 2 * F.G : 0; \
        const int nY_ = ((const LAS int*)(F.lds + TB_AUX))[128]; if (F.vcu < m7) { const SchedP7 S = SCHED7(2 * F.G, 1); GEMM7(S); } else if (F.vcu - m7 < nY_) { const SchedP8 S = SCHED8(-m7, 1); GEMM8(S); } }
#define PH9 { MOE_SCHEDS const int R8 = 8 * tab_[0], m7 = R8 > 2 * F.G ? R8 - 2 * F.G : 0; const int nY_ = ((const LAS int*)(F.lds + TB_AUX))[128]; (void)m7; const SchedP8 S = SCHED8(nY_, 1 << 20); GEMM8(S); }
    int vb34 = (int)blockIdx.x; bool xloc = false;
    RUN(0, PH0) RUN(1, PH1) RUN(2, PH2)
    if (lo == 0 && IN(3) && IN(4) && MK_TPROBE != 3) {
        if (threadIdx.x == 0) F.MISC[8 + 3] = xcd_uniform_32x8(bar.bar) ? 1u : 0u;
        __syncthreads();
        xloc = F.MISC[8 + 3] != 0u;
        if (xloc) vb34 = (int)F.MISC[8 + 2] * 8 + (int)bar.x;
    }
    RUN(3, PH3) RUN(4, PH4) RUN(7, PH7) RUN(8, PH8) RUN(9, PH9)
#ifdef MK_TSUB
    if (MK_TSUB >= 0 && blockIdx.x == 0) { const unsigned long long d = (((LAS unsigned long long*)(F.lds + PARG_OFF + 256))[1] - ((LAS unsigned long long*)(F.lds + PARG_OFF + 256))[0]) * 8ull, ts = __builtin_amdgcn_s_memrealtime(); while (__builtin_amdgcn_s_memrealtime() - ts < d) __builtin_amdgcn_s_sleep(8); }
#endif
    if (MK_TPROBE >= 0 && blockIdx.x == 0) { const unsigned long long d = (tp1 - tp0) * 8ull, ts = __builtin_amdgcn_s_memrealtime(); while (__builtin_amdgcn_s_memrealtime() - ts < d) __builtin_amdgcn_s_sleep(8); }
#undef IN
#undef BOTH
}

static void launch_mk(Args a, int lo, int hi, int li, int grid, hipStream_t stream) {
    a.ph_lo = lo; a.ph_hi = hi; a.li = li; a.pad = 0;
    hipLaunchKernelGGL(mk_fwd, dim3(grid), dim3(NWAVES * 64), LDS_BYTES, stream, a);
}
extern "C" void kernel_launch(void* const* d_in, const int* in_sizes, int n_in, void* d_out, int out_size, void* d_ws, size_t ws_size, hipStream_t stream) {
    static int grid = 0;
    if (grid == 0) {
        int dev = 0, cus = 0, per_cu = 0;
        if (n_in != 28 || out_size != T * D || ws_size < WS_END || hipGetDevice(&dev) != hipSuccess || hipDeviceGetAttribute(&cus, hipDeviceAttributeMultiprocessorCount, dev) != hipSuccess) {
            fprintf(stderr, "kernel_launch: built for 28 inputs, %d outputs and >= %zu bytes of workspace (n_in %d, out %d, ws %zu); nothing launched\n", T * D, (size_t)WS_END, n_in, out_size, ws_size); grid = -1; return; }
        if (hipFuncSetAttribute((const void*)mk_fwd, hipFuncAttributeMaxDynamicSharedMemorySize, LDS_BYTES) != hipSuccess) { fprintf(stderr, "kernel_launch: hipFuncSetAttribute failed\n"); grid = -1; return; }
        if (hipOccupancyMaxActiveBlocksPerMultiprocessor(&per_cu, (const void*)mk_fwd, NWAVES * 64, LDS_BYTES) != hipSuccess || per_cu < 1) { fprintf(stderr, "kernel_launch: occupancy query reports %d workgroups per CU; nothing launched\n", per_cu); grid = -1; (void)hipGetLastError(); return; }
        grid = cus;
        if (grid != 256) fprintf(stderr, "kernel_launch: note: tuned for 256 CUs, running on %d\n", grid);
    }
    if (grid < 0) return;
    if (hipMemsetAsync((char*)d_ws + WS_CTL, 0, CTL_ZERO_BYTES, stream) != hipSuccess) { fprintf(stderr, "kernel_launch: hipMemsetAsync failed\n"); return; }
    Args a{};
    for (int i = 0; i < 28; ++i) a.in[i] = (const float*)d_in[i];
    a.out = (float*)d_out; a.ws = (unsigned char*)d_ws;
    launch_mk(a, 0, 10, 0, grid, stream);
}
```
